# Optimizing an MI355X kernel written in HIP

```python
import math
import jax, jax.numpy as jnp
from jax import lax
import numpy as np

D_MODEL = 1024
BATCH = 2
SEQ = 8192
DEPTH = 1
DEC_BATCH = 4
DEC_SEQ = 4096
PAST_LEN = 128

HEAD_DIM = 64
NA_HEADS = 8
WG_HEADS = 8
WG_KV_HEADS = 2
WG_GROUP = WG_HEADS // WG_KV_HEADS
NA_WIDTH = NA_HEADS * HEAD_DIM
WG_WIDTH = WG_HEADS * HEAD_DIM
WG_KV_WIDTH = WG_KV_HEADS * HEAD_DIM
MIX_WIDTH = NA_WIDTH + WG_WIDTH
IN_WIDTH = 3 * NA_WIDTH + WG_WIDTH + 2 * WG_KV_WIDTH
D_FF = -(-8 * D_MODEL // (3 * 256)) * 256
GRID_W = 64
NA_WIN_ROWS = 8
NA_WIN_COLS = 16
N_META = 16
WINDOW = 128
BLOCK = 128
T5_BUCKETS = 32
T5_MAX_DIST = 128
EPS = 1e-6
NEG_INF = -1e30
SPLITS = (NA_WIDTH, 2 * NA_WIDTH, 3 * NA_WIDTH, 3 * NA_WIDTH + WG_WIDTH,
          3 * NA_WIDTH + WG_WIDTH + WG_KV_WIDTH)

kernel_name = "hybrid_na_swa_encoder"


def _rmsnorm(x, g):
    xf = x.astype(jnp.float32)
    y = xf * lax.rsqrt(jnp.mean(xf * xf, axis=-1, keepdims=True) + EPS)
    return (y * g.astype(jnp.float32)).astype(x.dtype)


def _t5_bucket(rel):
    half = T5_BUCKETS // 2
    max_exact = half // 2
    ret = jnp.where(rel > 0, half, 0)
    n = jnp.abs(rel)
    nf = jnp.maximum(n, 1).astype(jnp.float32)
    large = max_exact + (jnp.log(nf / max_exact) / math.log(T5_MAX_DIST / max_exact)
                         * (half - max_exact)).astype(jnp.int32)
    large = jnp.minimum(large, half - 1)
    return ret + jnp.where(n < max_exact, n, large)


def _softmax_with_sink(logits, sink):
    s = jnp.broadcast_to(sink, logits.shape[:-1] + (1,))
    p = jax.nn.softmax(jnp.concatenate([logits, s], axis=-1), axis=-1)
    return p[..., :-1]


def _neighbourhood_attn(q, k, v, rpb):
    B, L = q.shape[0], q.shape[1]
    N = L - N_META
    rows = N // GRID_W
    wr = min(NA_WIN_ROWS, rows)
    wc = NA_WIN_COLS
    scale = HEAD_DIM ** -0.5
    qm, km, vm = q[:, :N_META], k[:, :N_META], v[:, :N_META]
    qg = q[:, N_META:].reshape(B, rows, GRID_W, NA_HEADS, HEAD_DIM)
    kg = k[:, N_META:].reshape(B, rows, GRID_W, NA_HEADS, HEAD_DIM)
    vg = v[:, N_META:].reshape(B, rows, GRID_W, NA_HEADS, HEAD_DIM)
    row_start = jnp.clip(jnp.arange(rows) - wr // 2, 0, rows - wr)
    cols = jnp.arange(GRID_W)
    col_start = jnp.clip(cols - wc // 2, 0, GRID_W - wc)
    col_idx = col_start[:, None] + jnp.arange(wc)[None, :]
    dcol = col_idx - cols[:, None]
    rpb32 = rpb.astype(jnp.float32)

    def row_fn(r):
        rs = row_start[r]
        q_r = lax.dynamic_index_in_dim(qg, r, axis=1, keepdims=False)
        k_rows = lax.dynamic_slice_in_dim(kg, rs, wr, axis=1)
        v_rows = lax.dynamic_slice_in_dim(vg, rs, wr, axis=1)
        k_win = k_rows[:, :, col_idx]
        v_win = v_rows[:, :, col_idx]
        drow = rs + jnp.arange(wr) - r
        bias = rpb32[:, drow[None, :, None] + NA_WIN_ROWS - 1,
                     dcol[:, None, :] + NA_WIN_COLS - 1]
        s_win = jnp.einsum('bqhd,bwqchd->bhqwc', q_r, k_win).astype(jnp.float32) * scale + bias[None]
        s_meta = jnp.einsum('bqhd,bmhd->bhqm', q_r, km).astype(jnp.float32) * scale
        logits = jnp.concatenate([s_meta, s_win.reshape(B, NA_HEADS, GRID_W, wr * wc)], axis=-1)
        p = jax.nn.softmax(logits, axis=-1).astype(v.dtype)
        p_meta = p[..., :N_META]
        p_win = p[..., N_META:].reshape(B, NA_HEADS, GRID_W, wr, wc)
        return (jnp.einsum('bhqm,bmhd->bqhd', p_meta, vm)
                + jnp.einsum('bhqwc,bwqchd->bqhd', p_win, v_win))

    out = lax.map(row_fn, jnp.arange(rows))
    out = out.transpose(1, 0, 2, 3, 4).reshape(B, N, NA_WIDTH)
    s_m = jnp.einsum('bmhd,bnhd->bhmn', qm, km).astype(jnp.float32) * scale
    p_m = jax.nn.softmax(s_m, axis=-1).astype(v.dtype)
    out_m = jnp.einsum('bhmn,bnhd->bmhd', p_m, vm).reshape(B, N_META, NA_WIDTH)
    return jnp.concatenate([out_m, out], axis=1)


def _windowed_gqa(q, k, v, t5_table, sink):
    B, L = q.shape[0], q.shape[1]
    N = L - N_META
    nblk = N // BLOCK
    scale = HEAD_DIM ** -0.5
    t5 = t5_table.astype(jnp.float32)
    sink_b = sink.astype(jnp.float32).reshape(WG_KV_HEADS, WG_GROUP, 1, 1)
    qm, km, vm = q[:, :N_META], k[:, :N_META], v[:, :N_META]
    qr, kr, vr = q[:, N_META:], k[:, N_META:], v[:, N_META:]

    qb = qr.reshape(B, nblk, BLOCK, WG_KV_HEADS, WG_GROUP, HEAD_DIM)
    pad = ((0, 0), (BLOCK, BLOCK), (0, 0), (0, 0))
    kp = jnp.pad(kr, pad)
    vp = jnp.pad(vr, pad)
    band_idx = jnp.arange(nblk)[:, None] * BLOCK + jnp.arange(3 * BLOCK)[None, :]
    kb = kp[:, band_idx]
    vb = vp[:, band_idx]
    i = jnp.arange(BLOCK)
    j = jnp.arange(3 * BLOCK)
    rel_band = (j[None, :] - BLOCK) - i[:, None]
    s_idx = jnp.arange(nblk)[:, None, None] * BLOCK - BLOCK + j[None, None, :]
    mask = (s_idx >= 0) & (s_idx < N) & (jnp.abs(rel_band)[None] <= WINDOW)
    bias_band = t5[_t5_bucket(rel_band)].transpose(2, 0, 1).reshape(
        WG_KV_HEADS, WG_GROUP, BLOCK, 3 * BLOCK)
    s_band = jnp.einsum('bnihgd,bnjhd->bnhgij', qb, kb).astype(jnp.float32) * scale + bias_band
    s_band = jnp.where(mask[None, :, None, None], s_band, NEG_INF)
    t_pos = jnp.arange(nblk)[:, None] * BLOCK + i[None, :]
    rel_meta = jnp.arange(N_META)[None, None, :] - (N_META + t_pos[:, :, None])
    bias_meta = t5[_t5_bucket(rel_meta)].transpose(0, 3, 1, 2).reshape(
        nblk, WG_KV_HEADS, WG_GROUP, BLOCK, N_META)
    s_meta = jnp.einsum('bnihgd,bmhd->bnhgim', qb, km).astype(jnp.float32) * scale + bias_meta[None]
    p = _softmax_with_sink(jnp.concatenate([s_meta, s_band], axis=-1), sink_b).astype(v.dtype)
    out = (jnp.einsum('bnhgim,bmhd->bnihgd', p[..., :N_META], vm)
           + jnp.einsum('bnhgij,bnjhd->bnihgd', p[..., N_META:], vb))
    out = out.reshape(B, N, WG_WIDTH)

    qmg = qm.reshape(B, N_META, WG_KV_HEADS, WG_GROUP, HEAD_DIM)
    k_mq = jnp.concatenate([km, kr[:, :BLOCK]], axis=1)
    v_mq = jnp.concatenate([vm, vr[:, :BLOCK]], axis=1)
    qpos = jnp.arange(N_META)
    kpos = jnp.arange(N_META + BLOCK)
    rel_m = kpos[None, :] - qpos[:, None]
    mask_m = (kpos[None, :] < N_META) | (jnp.abs(rel_m) <= WINDOW)
    bias_m = t5[_t5_bucket(rel_m)].transpose(2, 0, 1).reshape(
        WG_KV_HEADS, WG_GROUP, N_META, N_META + BLOCK)
    s_m = jnp.einsum('bmhgd,bjhd->bhgmj', qmg, k_mq).astype(jnp.float32) * scale + bias_m
    s_m = jnp.where(mask_m, s_m, NEG_INF)
    p_m = _softmax_with_sink(s_m, sink_b).astype(v.dtype)
    out_m = jnp.einsum('bhgmj,bjhd->bmhgd', p_m, v_mq).reshape(B, N_META, WG_WIDTH)
    return jnp.concatenate([out_m, out], axis=1)


def _layer(x, t5_table, norm1_g, w_in, qn_a_g, kn_a_g, rpb_a, qn_b_g, kn_b_g, sink_b,
           outn_a_g, outn_b_g, w_out, norm2_g, w_gate, w_up, w_down):
    B, L = x.shape[0], x.shape[1]
    h = _rmsnorm(x, norm1_g)
    proj = h @ w_in
    qa, ka, va, qb, kb, vb = jnp.split(proj, SPLITS, axis=-1)
    qa = _rmsnorm(qa.reshape(B, L, NA_HEADS, HEAD_DIM), qn_a_g)
    ka = _rmsnorm(ka.reshape(B, L, NA_HEADS, HEAD_DIM), kn_a_g)
    va = va.reshape(B, L, NA_HEADS, HEAD_DIM)
    qb = _rmsnorm(qb.reshape(B, L, WG_HEADS, HEAD_DIM), qn_b_g)
    kb = _rmsnorm(kb.reshape(B, L, WG_KV_HEADS, HEAD_DIM), kn_b_g)
    vb = vb.reshape(B, L, WG_KV_HEADS, HEAD_DIM)
    oa = _neighbourhood_attn(qa, ka, va, rpb_a)
    ob = _windowed_gqa(qb, kb, vb, t5_table, sink_b)
    mix = jnp.concatenate([_rmsnorm(oa, outn_a_g), _rmsnorm(ob, outn_b_g)], axis=-1)
    x = x + mix @ w_out
    h = _rmsnorm(x, norm2_g)
    x = x + (jax.nn.silu(h @ w_gate) * (h @ w_up)) @ w_down
    return x


def _encode(x, meta_tokens, t5_table, norm1_g, w_in, qn_a_g, kn_a_g, rpb_a, qn_b_g, kn_b_g,
            sink_b, outn_a_g, outn_b_g, w_out, norm2_g, w_gate, w_up, w_down):
    B = x.shape[0]
    meta = jnp.broadcast_to(meta_tokens[None].astype(x.dtype), (B, N_META, x.shape[-1]))
    h = jnp.concatenate([meta, x], axis=1)
    for l in range(DEPTH):
        h = _layer(h, t5_table, norm1_g[l], w_in[l], qn_a_g[l], kn_a_g[l], rpb_a[l],
                   qn_b_g[l], kn_b_g[l], sink_b[l], outn_a_g[l], outn_b_g[l], w_out[l],
                   norm2_g[l], w_gate[l], w_up[l], w_down[l])
    return h[:, N_META:]


def setup_inputs(seed: int = 0) -> dict:
    key = jax.random.key(seed)
    ks = jax.random.split(key, 20)
    f32 = jnp.float32

    def nrm(k, shape, scale):
        return jax.random.normal(k, shape, f32) * scale

    def gain(k, shape):
        return 1.0 + 0.02 * jax.random.normal(k, shape, f32)

    return {
        "x_prompt": nrm(ks[0], (BATCH, SEQ, D_MODEL), 1.0),
        "x_sample": nrm(ks[1], (DEC_BATCH, DEC_SEQ, D_MODEL), 1.0),
        "meta_tokens": nrm(ks[2], (N_META, D_MODEL), 1.0),
        "t5_table": nrm(ks[3], (T5_BUCKETS, WG_HEADS), 0.1),
        "norm1_g": gain(ks[4], (DEPTH, D_MODEL)),
        "w_in": nrm(ks[5], (DEPTH, D_MODEL, IN_WIDTH), D_MODEL ** -0.5),
        "qn_a_g": gain(ks[6], (DEPTH, HEAD_DIM)),
        "kn_a_g": gain(ks[7], (DEPTH, HEAD_DIM)),
        "rpb_a": nrm(ks[8], (DEPTH, NA_HEADS, 2 * NA_WIN_ROWS - 1, 2 * NA_WIN_COLS - 1), 0.1),
        "qn_b_g": gain(ks[9], (DEPTH, HEAD_DIM)),
        "kn_b_g": gain(ks[10], (DEPTH, HEAD_DIM)),
        "sink_b": nrm(ks[11], (DEPTH, WG_HEADS), 0.5),
        "outn_a_g": gain(ks[12], (DEPTH, NA_WIDTH)),
        "outn_b_g": gain(ks[13], (DEPTH, WG_WIDTH)),
        "w_out": nrm(ks[14], (DEPTH, MIX_WIDTH, D_MODEL), MIX_WIDTH ** -0.5),
        "norm2_g": gain(ks[15], (DEPTH, D_MODEL)),
        "w_gate": nrm(ks[16], (DEPTH, D_MODEL, D_FF), D_MODEL ** -0.5),
        "w_up": nrm(ks[17], (DEPTH, D_MODEL, D_FF), D_MODEL ** -0.5),
        "w_down": nrm(ks[18], (DEPTH, D_FF, D_MODEL), D_FF ** -0.5),
    }


def reference(x_prompt, x_sample, meta_tokens, t5_table, norm1_g, w_in, qn_a_g, kn_a_g, rpb_a,
              qn_b_g, kn_b_g, sink_b, outn_a_g, outn_b_g, w_out, norm2_g, w_gate, w_up, w_down):
    y_prompt = _encode(x_prompt, meta_tokens, t5_table, norm1_g, w_in, qn_a_g, kn_a_g, rpb_a,
                       qn_b_g, kn_b_g, sink_b, outn_a_g, outn_b_g, w_out, norm2_g,
                       w_gate, w_up, w_down)
    y_sample = _encode(x_sample, meta_tokens, t5_table, norm1_g, w_in, qn_a_g, kn_a_g, rpb_a,
                       qn_b_g, kn_b_g, sink_b, outn_a_g, outn_b_g, w_out, norm2_g,
                       w_gate, w_up, w_down)
    return (y_prompt, y_sample)
```

```cpp
#include <hip/hip_runtime.h>
#include <cstdio>
#include <cstdint>
namespace pg8 {
#define PG8_LAS __attribute__((address_space(3)))
typedef unsigned short bf16_t;
typedef short bf16x8 __attribute__((ext_vector_type(8)));
typedef float f32x4 __attribute__((ext_vector_type(4)));
typedef unsigned u32x4 __attribute__((ext_vector_type(4)));
constexpr int BM = 256, BK = 64, HALF = 128, HTB = HALF * BK * 2  , STAGE_BYTES = 8 * HTB, NXCD = 8, WGM = 8;

__host__ __device__ __forceinline__ int lds_byte(int r, int c) { const int st = (r >> 4) * 2 + (c >> 5), rr = r & 15, cc = c & 31, ob = rr * 64 + cc * 2; return st * 1024 + (ob ^ (((ob >> 9) & 1) << 5)); }
__host__ __device__ __forceinline__ void stage_rc(int b, int& R, int& C) { const int st = b / 1024, sb = b % 1024, swz = sb ^ (((sb >> 9) & 1) << 5); R = (st >> 1) * 16 + swz / 64; C = (st & 1) * 32 + (swz % 64) / 2; }
__host__ __device__ __forceinline__ int perm32(int rho) { const int n = rho >> 4, i = rho & 15; return 8 * (i >> 2) + 4 * n + (i & 3); }

struct Unit { int pm, pn; };
struct Gemm { const bf16_t* A; const bf16_t* Bt; int M, N, K; };

struct StaticOrder {
    int nM, nN, nwg, G, c;
    __host__ __device__ void init(int M, int N, int G_, int c_) { nM = M / BM; nN = N / BM; nwg = nM * nN; G = G_; c = c_; }
    __host__ __device__ bool next(int i, Unit& u) const {
        const long L = (long)i * G + c; if (L >= nwg) return false;
        int wgid = (int)L; { const int q = nwg / NXCD, r = nwg % NXCD, xcd = wgid % NXCD, off = wgid / NXCD; wgid = (xcd < r ? xcd * (q + 1) : r * (q + 1) + (xcd - r) * q) + off; }
        const int nig = WGM * nN, gid = wgid / nig, fm = gid * WGM, gsz = (nM - fm) < WGM ? (nM - fm) : WGM;
        u.pm = fm + ((wgid % nig) % gsz); u.pn = (wgid % nig) / gsz; return true;
    }
    __device__ __forceinline__ void a_ready(const Unit&) const {}
    __device__ __forceinline__ void done(const Unit&) const {}
};

__device__ __forceinline__ unsigned cvt_pk_bf16(float lo, float hi) { unsigned r; asm volatile("v_cvt_pk_bf16_f32 %0, %1, %2" : "=v"(r) : "v"(lo), "v"(hi)); return r; }
constexpr int MP_ROWS = 33024;
constexpr float RMS_EPS = 1e-6f;
constexpr float QSCALE = 0.125f * 1.4426950408889634f;

struct EpiQKV {
    static constexpr bool PERM = true, AFTER_DRAIN = false;
    bf16_t *QA, *KA, *VAt, *QB, *KB, *VBt; const float *qna, *kna, *qnb, *knb;
    __device__ __forceinline__ void operator()(const f32x4 (&acc)[2][2][4][2], const Unit& u, int wr, int wc, int fr, int fq) const {
        const int pn = u.pn, row0 = u.pm * BM + wr * 64 + fr, sec = pn >> 1;
        bf16_t* dst; int pitch = 512, head = 4 * (pn & 1) + wc; const float* gain = nullptr; float sc = 1.f; bool isV = false;
        if (sec == 0) { dst = QA; gain = qna; sc = QSCALE; }
        else if (sec == 1) { dst = KA; gain = kna; }
        else if (sec == 2) { dst = VAt; isV = true; }
        else if (sec == 3) { dst = QB; gain = qnb; sc = QSCALE; }
        else { if (wc < 2) { dst = KB; pitch = 128; head = wc; gain = knb; } else { dst = VBt; head = wc - 2; isV = true; } }
        if (!isV) {
            f32x4 gv[2][2];
#pragma unroll
            for (int bj = 0; bj < 2; ++bj)
#pragma unroll
                for (int n = 0; n < 2; ++n) gv[bj][n] = *(const f32x4*)(gain + 32 * bj + 8 * fq + 4 * n) * sc;
#pragma unroll
            for (int ai = 0; ai < 2; ++ai)
#pragma unroll
                for (int m = 0; m < 4; ++m) {
                    float ss = 0.f;
#pragma unroll
                    for (int bj = 0; bj < 2; ++bj)
#pragma unroll
                        for (int n = 0; n < 2; ++n) { const f32x4 x = acc[ai][bj][m][n]; ss += (x[0] * x[0] + x[1] * x[1]) + (x[2] * x[2] + x[3] * x[3]); }
                    ss += __shfl_xor(ss, 16); ss += __shfl_xor(ss, 32);
                    const float r = 1.0f / sqrtf(ss * (1.0f / 64.0f) + RMS_EPS);
                    bf16_t* rowp = dst + (size_t)(row0 + ai * HALF + m * 16) * pitch + head * 64 + 8 * fq;
#pragma unroll
                    for (int bj = 0; bj < 2; ++bj) { const f32x4 v0 = acc[ai][bj][m][0] * r * gv[bj][0], v1 = acc[ai][bj][m][1] * r * gv[bj][1];
                        u32x4 w; w.x = cvt_pk_bf16(v0[0], v0[1]); w.y = cvt_pk_bf16(v0[2], v0[3]); w.z = cvt_pk_bf16(v1[0], v1[1]); w.w = cvt_pk_bf16(v1[2], v1[3]);
                        *(u32x4*)(rowp + 32 * bj) = w; }
                }
        } else {
            bf16_t* base = dst + (size_t)(head * 64) * MP_ROWS;
#pragma unroll
            for (int ai = 0; ai < 2; ++ai)
#pragma unroll
                for (int m = 0; m < 4; ++m) { const int row = row0 + ai * HALF + m * 16;
#pragma unroll
                    for (int bj = 0; bj < 2; ++bj)
#pragma unroll
                        for (int n = 0; n < 2; ++n) { const f32x4 x = acc[ai][bj][m][n]; bf16_t* p = base + (size_t)(32 * bj + 8 * fq + 4 * n) * MP_ROWS + row;
                            const unsigned w0 = cvt_pk_bf16(x[0], x[1]), w1 = cvt_pk_bf16(x[2], x[3]);
                            p[0] = (bf16_t)(w0 & 0xffffu); p[MP_ROWS] = (bf16_t)(w0 >> 16); p[2 * (size_t)MP_ROWS] = (bf16_t)(w1 & 0xffffu); p[3 * (size_t)MP_ROWS] = (bf16_t)(w1 >> 16); }
                }
        }
    }
};
struct EpiOut {
    static constexpr bool PERM = true, AFTER_DRAIN = false;
    const float *xp, *xs; bf16_t* X1B; float* SS2;
    __device__ __forceinline__ void operator()(const f32x4 (&acc)[2][2][4][2], const Unit& u, int wr, int wc, int fr, int fq) const {
        const int row0 = u.pm * BM + wr * 64 + fr, colb = u.pn * BM + wc * 32 + 8 * fq;
#pragma unroll
        for (int ai = 0; ai < 2; ++ai)
#pragma unroll
            for (int m = 0; m < 4; ++m) { const int row = row0 + ai * HALF + m * 16;
                const float* xrow = (row < 16384 ? xp + (size_t)row * 1024 : xs + (size_t)(row - 16384) * 1024) + colb;
                float ss = 0.f;
#pragma unroll
                for (int bj = 0; bj < 2; ++bj) { const f32x4 v0 = acc[ai][bj][m][0] + *(const f32x4*)(xrow + bj * HALF), v1 = acc[ai][bj][m][1] + *(const f32x4*)(xrow + bj * HALF + 4);
                    ss += (v0[0] * v0[0] + v0[1] * v0[1]) + (v0[2] * v0[2] + v0[3] * v0[3]) + (v1[0] * v1[0] + v1[1] * v1[1]) + (v1[2] * v1[2] + v1[3] * v1[3]);
                    u32x4 w; w.x = cvt_pk_bf16(v0[0], v0[1]); w.y = cvt_pk_bf16(v0[2], v0[3]); w.z = cvt_pk_bf16(v1[0], v1[1]); w.w = cvt_pk_bf16(v1[2], v1[3]);
                    *(u32x4*)(X1B + (size_t)row * 1024 + colb + bj * HALF) = w; }
                ss += __shfl_xor(ss, 16); ss += __shfl_xor(ss, 32);
                if (fq == 0) SS2[(size_t)row * 16 + 4 * u.pn + wc] = ss;
            }
    }
};
struct EpiGU {
    static constexpr bool PERM = true, AFTER_DRAIN = false;
    const float* SS2; bf16_t* H;
    __device__ __forceinline__ void operator()(const f32x4 (&acc)[2][2][4][2], const Unit& u, int wr, int wc, int fr, int fq) const {
        const int row0 = u.pm * BM + wr * 64 + fr, colb = u.pn * HALF + wc * 32 + 8 * fq;
#pragma unroll
        for (int ai = 0; ai < 2; ++ai)
#pragma unroll
            for (int m = 0; m < 4; ++m) { const int row = row0 + ai * HALF + m * 16;
                const f32x4 sv = *(const f32x4*)(SS2 + (size_t)row * 16 + 4 * fq);
                float s = (sv[0] + sv[1]) + (sv[2] + sv[3]); s += __shfl_xor(s, 16); s += __shfl_xor(s, 32);
                const float r = 1.0f / sqrtf(s * (1.0f / 1024.0f) + RMS_EPS);
                float hv[8];
#pragma unroll
                for (int n = 0; n < 2; ++n)
#pragma unroll
                    for (int i = 0; i < 4; ++i) { const float g = acc[ai][0][m][n][i] * r, up = acc[ai][1][m][n][i] * r;
                        const float e = __builtin_amdgcn_exp2f(g * -1.4426950408889634f); hv[4 * n + i] = g * up * __builtin_amdgcn_rcpf(1.0f + e); }
                u32x4 w; w.x = cvt_pk_bf16(hv[0], hv[1]); w.y = cvt_pk_bf16(hv[2], hv[3]); w.z = cvt_pk_bf16(hv[4], hv[5]); w.w = cvt_pk_bf16(hv[6], hv[7]);
                *(u32x4*)(H + (size_t)row * 2816 + colb) = w;
            }
    }
};
struct EpiDown {
    static constexpr bool PERM = true, AFTER_DRAIN = false;
    const bf16_t* X1B; float* out;
    __device__ __forceinline__ void operator()(const f32x4 (&acc)[2][2][4][2], const Unit& u, int wr, int wc, int fr, int fq) const {
        const int row0 = u.pm * BM + wr * 64 + fr, colb = u.pn * BM + wc * 32 + 8 * fq;
#pragma unroll
        for (int ai = 0; ai < 2; ++ai)
#pragma unroll
            for (int m = 0; m < 4; ++m) { const size_t off = (size_t)(row0 + ai * HALF + m * 16) * 1024 + colb;
#pragma unroll
                for (int bj = 0; bj < 2; ++bj) { const u32x4 xb = *(const u32x4*)(X1B + off + bj * HALF);
                    f32x4 x0, x1; x0[0] = __uint_as_float(xb.x << 16); x0[1] = __uint_as_float(xb.x & 0xffff0000u); x0[2] = __uint_as_float(xb.y << 16); x0[3] = __uint_as_float(xb.y & 0xffff0000u);
                    x1[0] = __uint_as_float(xb.z << 16); x1[1] = __uint_as_float(xb.z & 0xffff0000u); x1[2] = __uint_as_float(xb.w << 16); x1[3] = __uint_as_float(xb.w & 0xffff0000u);
                    *(f32x4*)(out + off + bj * HALF) = acc[ai][bj][m][0] + x0; *(f32x4*)(out + off + bj * HALF + 4) = acc[ai][bj][m][1] + x1; }
            }
    }
};

template <class Epi, class Sched, bool ALIGN_EPI = false, bool SP2 = false>
__device__ __forceinline__ void gemm_phase(PG8_LAS unsigned char* lds, const Gemm g, const Sched& S, const Epi& E) {
    const int tid = threadIdx.x, wid = __builtin_amdgcn_readfirstlane(tid >> 6), lane = tid & 63, wr = wid >> 2, wc = wid & 3, fr = lane & 15, fq = lane >> 4;
    const int K = g.K, nt = K / BK;
    unsigned voffA[2], voffB[2];
#pragma unroll
    for (int i = 0; i < 2; ++i) { int R, C; stage_rc(tid * 16 + i * 8192, R, C); const int Rb = Epi::PERM ? ((R & ~31) + perm32(R & 31)) : R;
        voffA[i] = (unsigned)(R * K + C) * 2u; voffB[i] = (unsigned)(Rb * K + C) * 2u; }
    const size_t kstep = (size_t)(BK * 2);
    const size_t hstep = (size_t)HALF * K * 2;
    const size_t tstep = 2 * hstep;
    const unsigned ldsw = (unsigned)wid * 1024u;
    const int aoff = lds_byte(wr * 64 + fr, fq * 8), boff = lds_byte(wc * 32 + fr, fq * 8);
#define PG8_SA(b, h) (((b) * 2 + (h)) * HTB)
#define PG8_SB(b, h) ((4 + (b) * 2 + (h)) * HTB)
#define PG8_STAGE(bufoff, gbase, voff) do { _Pragma("unroll") for (int _i = 0; _i < 2; ++_i) \
        __builtin_amdgcn_global_load_lds((const unsigned*)((const char*)(gbase) + (voff)[_i]), (PG8_LAS unsigned*)(lds + (bufoff) + ldsw + _i * 8192), 16, 0, 0); } while (0)
#define PG8_LDA(dst, b, h) do { _Pragma("unroll") for (int m = 0; m < 4; ++m) _Pragma("unroll") for (int k = 0; k < 2; ++k) dst[m][k] = *(const PG8_LAS bf16x8*)(lds + PG8_SA(b, h) + aoff + m * 2048 + k * 1024); } while (0)
#define PG8_LDB(dst, b, h) do { _Pragma("unroll") for (int n = 0; n < 2; ++n) _Pragma("unroll") for (int k = 0; k < 2; ++k) dst[n][k] = *(const PG8_LAS bf16x8*)(lds + PG8_SB(b, h) + boff + n * 2048 + k * 1024); } while (0)
#define PG8_MMA(ai, bj, At, Bt) do { __builtin_amdgcn_s_setprio(1); _Pragma("unroll") for (int m = 0; m < 4; ++m) _Pragma("unroll") for (int n = 0; n < 2; ++n) _Pragma("unroll") for (int k = 0; k < 2; ++k) \
        acc[ai][bj][m][n] = __builtin_amdgcn_mfma_f32_16x16x32_bf16(Bt[n][k], At[m][k], acc[ai][bj][m][n], 0, 0, 0); __builtin_amdgcn_s_setprio(0); } while (0)
#define PG8_WAIT_V(n) asm volatile("s_waitcnt vmcnt(" #n ")" ::: "memory")
#define PG8_WAIT_L(n) asm volatile("s_waitcnt lgkmcnt(" #n ")" ::: "memory")
#define PG8_BAR __builtin_amdgcn_s_barrier()
#define PG8_SCHED __builtin_amdgcn_sched_barrier(0)
    Unit cur, nxt; int ui = 0;
    if (!S.next(0, cur)) return;
    f32x4 acc[2][2][4][2];
#pragma unroll
    for (int a = 0; a < 2; ++a)
#pragma unroll
        for (int b = 0; b < 2; ++b)
#pragma unroll
            for (int m = 0; m < 4; ++m)
#pragma unroll
                for (int n = 0; n < 2; ++n) acc[a][b][m][n] = (f32x4){0.f, 0.f, 0.f, 0.f};
    bf16x8 At[4][2], B0[2][2], B1[2][2];
    const char* cA = (const char*)g.A + (size_t)cur.pm * tstep; const char* cB = (const char*)g.Bt + (size_t)cur.pn * tstep;
    S.a_ready(cur);
    if constexpr (SP2) {
        PG8_STAGE(PG8_SB(0, 0), cB, voffB); PG8_STAGE(PG8_SB(0, 1), cB + hstep, voffB); PG8_STAGE(PG8_SA(0, 0), cA, voffA); PG8_STAGE(PG8_SA(0, 1), cA + hstep, voffA);
        if (wr == 1) PG8_BAR;
        PG8_WAIT_V(2); PG8_BAR;
        PG8_STAGE(PG8_SB(1, 0), cB + kstep, voffB); PG8_STAGE(PG8_SA(1, 0), cA + kstep, voffA); PG8_STAGE(PG8_SB(1, 1), cB + hstep + kstep, voffB);
        PG8_WAIT_V(6); PG8_BAR;
    } else {
        PG8_STAGE(PG8_SB(0, 0), cB, voffB); PG8_STAGE(PG8_SA(0, 0), cA, voffA); PG8_STAGE(PG8_SB(0, 1), cB + hstep, voffB); PG8_STAGE(PG8_SA(0, 1), cA + hstep, voffA);
        if (wr == 1) PG8_BAR;
        PG8_WAIT_V(4); PG8_BAR;
        PG8_STAGE(PG8_SB(1, 0), cB + kstep, voffB); PG8_STAGE(PG8_SA(1, 0), cA + kstep, voffA); PG8_STAGE(PG8_SB(1, 1), cB + hstep + kstep, voffB);
        PG8_WAIT_V(6); PG8_BAR;
    }
    for (;;) {
        const bool has_next = S.next(ui + 1, nxt);
        const char* nA = has_next ? (const char*)g.A + (size_t)nxt.pm * tstep : cA; const char* nB = has_next ? (const char*)g.Bt + (size_t)nxt.pn * tstep : cB;
        for (int t = 0; t < nt; t += 2) {
            const bool last = (t == nt - 2);
            const char* a1 = cA + (size_t)(t + 1) * kstep;
            const char* a2 = last ? nA : cA + (size_t)(t + 2) * kstep; const char* b2 = last ? nB : cB + (size_t)(t + 2) * kstep;
            const char* a3 = a2 + kstep; const char* b3 = b2 + kstep;
            if (last && has_next) S.a_ready(nxt);
            if constexpr (SP2) {
            PG8_LDB(B0, 0, 0); PG8_LDB(B1, 0, 1); PG8_SCHED; PG8_LDA(At, 0, 0); PG8_STAGE(PG8_SA(1, 1), a1 + hstep, voffA);
            PG8_WAIT_V(8); PG8_WAIT_L(0); PG8_BAR; PG8_MMA(0, 0, At, B0); PG8_MMA(0, 1, At, B1); PG8_BAR; PG8_SCHED;
            PG8_LDA(At, 0, 1); PG8_STAGE(PG8_SB(0, 0), b2, voffB); PG8_STAGE(PG8_SB(0, 1), b2 + hstep, voffB); PG8_STAGE(PG8_SA(0, 0), a2, voffA);
            PG8_WAIT_V(8); PG8_WAIT_L(0); PG8_BAR; PG8_MMA(1, 0, At, B0); PG8_MMA(1, 1, At, B1); PG8_BAR; PG8_SCHED;
            PG8_LDB(B0, 1, 0); PG8_LDB(B1, 1, 1); PG8_SCHED; PG8_LDA(At, 1, 0); PG8_STAGE(PG8_SA(0, 1), a2 + hstep, voffA);
            PG8_WAIT_V(8); PG8_WAIT_L(0); PG8_BAR; PG8_MMA(0, 0, At, B0); PG8_MMA(0, 1, At, B1); PG8_BAR; PG8_SCHED;
            PG8_LDA(At, 1, 1); PG8_STAGE(PG8_SB(1, 0), b3, voffB); PG8_STAGE(PG8_SB(1, 1), b3 + hstep, voffB); PG8_STAGE(PG8_SA(1, 0), a3, voffA);
            PG8_WAIT_V(8); PG8_WAIT_L(0); PG8_BAR; PG8_MMA(1, 0, At, B0); PG8_MMA(1, 1, At, B1); PG8_BAR; PG8_SCHED;
            } else {
            PG8_LDB(B0, 0, 0); PG8_SCHED; PG8_LDA(At, 0, 0); PG8_STAGE(PG8_SA(1, 1), a1 + hstep, voffA);
            PG8_WAIT_L(8); PG8_BAR; PG8_WAIT_L(0); PG8_MMA(0, 0, At, B0); PG8_BAR; PG8_SCHED;
            PG8_LDB(B1, 0, 1); PG8_STAGE(PG8_SB(0, 0), b2, voffB);
            PG8_BAR; PG8_WAIT_L(0); PG8_MMA(0, 1, At, B1); PG8_BAR;
            PG8_LDA(At, 0, 1); PG8_STAGE(PG8_SA(0, 0), a2, voffA);
            PG8_BAR; PG8_WAIT_L(0); PG8_MMA(1, 0, At, B0); PG8_BAR; PG8_SCHED;
            PG8_STAGE(PG8_SB(0, 1), b2 + hstep, voffB);
            PG8_WAIT_V(6); PG8_BAR; PG8_MMA(1, 1, At, B1); PG8_BAR;
            PG8_LDB(B0, 1, 0); PG8_SCHED; PG8_LDA(At, 1, 0); PG8_STAGE(PG8_SA(0, 1), a2 + hstep, voffA);
            PG8_WAIT_L(8); PG8_BAR; PG8_WAIT_L(0); PG8_MMA(0, 0, At, B0); PG8_BAR; PG8_SCHED;
            PG8_LDB(B1, 1, 1); PG8_STAGE(PG8_SB(1, 0), b3, voffB);
            PG8_BAR; PG8_WAIT_L(0); PG8_MMA(0, 1, At, B1); PG8_BAR;
            PG8_LDA(At, 1, 1); PG8_STAGE(PG8_SA(1, 0), a3, voffA);
            PG8_BAR; PG8_WAIT_L(0); PG8_MMA(1, 0, At, B0); PG8_BAR; PG8_SCHED;
            PG8_STAGE(PG8_SB(1, 1), b3 + hstep, voffB);
            PG8_WAIT_V(6); PG8_BAR; PG8_MMA(1, 1, At, B1); PG8_BAR;
            }
        }
        if constexpr (ALIGN_EPI) { if (wr == 0) PG8_BAR; }
        if constexpr (!Epi::AFTER_DRAIN) { E(acc, cur, wr, wc, fr, fq); S.done(cur); }
        if (!has_next) break;
#pragma unroll
        for (int a = 0; a < 2; ++a)
#pragma unroll
            for (int b = 0; b < 2; ++b)
#pragma unroll
                for (int m = 0; m < 4; ++m)
#pragma unroll
                    for (int n = 0; n < 2; ++n) acc[a][b][m][n] = (f32x4){0.f, 0.f, 0.f, 0.f};
        cur = nxt; cA = nA; cB = nB; ++ui;
        if constexpr (ALIGN_EPI) { if (wr == 1) PG8_BAR; }
    }
    PG8_WAIT_V(0);
    if constexpr (!ALIGN_EPI) { if (wr == 0) PG8_BAR; }
    PG8_BAR;
    if constexpr (Epi::AFTER_DRAIN) { E.fused(acc, cur, wr, wc, fr, fq, lds, wid, lane); S.done(cur); }
#undef PG8_SA
#undef PG8_SB
#undef PG8_STAGE
#undef PG8_LDA
#undef PG8_LDB
#undef PG8_MMA
#undef PG8_WAIT_V
#undef PG8_WAIT_L
#undef PG8_BAR
#undef PG8_SCHED
}
}
constexpr int NWAVES = 8;
constexpr int DM = 1024, MTOK = 32768, MPAD = pg8::MP_ROWS, NIN = 2304, DFF = 2816, NGU = 2 * DFF;
constexpr float LOG2E = 1.4426950408889634f;
constexpr float EPS = 1e-6f;
constexpr size_t MiB = 1u << 20;
constexpr size_t WS_CTL = 0, CTL_ZERO_BYTES = 65536;
constexpr size_t WS_SS2 = 1 * MiB;
constexpr size_t WS_WDN = 3 * MiB;
constexpr size_t WS_X1B = 10 * MiB;
constexpr size_t WS_QKV = 74 * MiB;
constexpr size_t SZ_Q = (size_t)MPAD * 512 * 2, SZ_KB = (size_t)MPAD * 128 * 2;
constexpr size_t WS_QA = WS_QKV, WS_KA = WS_QA + SZ_Q, WS_VAT = WS_KA + SZ_Q, WS_QB = WS_VAT + SZ_Q, WS_KB = WS_QB + SZ_Q, WS_VBT = WS_KB + SZ_KB, WS_QKV_END = WS_VBT + SZ_KB;
constexpr size_t WS_H = 74 * MiB;
constexpr size_t WS_END = 256 * MiB;
static_assert(WS_QKV_END <= WS_END && WS_H + (size_t)MTOK * DFF * 2 <= WS_END && WS_X1B + (size_t)MTOK * DM * 2 <= WS_QKV && WS_WDN + (size_t)DM * DFF * 2 <= WS_X1B, "d_ws map");
constexpr size_t DO_XN = 0;
constexpr size_t DO_MIX = 0;
constexpr size_t DO_WGU = 96 * MiB;
constexpr size_t DO_WIN = 108 * MiB;
constexpr size_t DO_WOUT = 113 * MiB;
static_assert(DO_XN + (size_t)MPAD * DM * 2 <= DO_WGU && DO_WGU + (size_t)NGU * DM * 2 <= DO_WIN && DO_WIN + (size_t)NIN * DM * 2 <= DO_WOUT && DO_WOUT + (size_t)DM * DM * 2 <= 128 * MiB, "d_out scratch map");
constexpr int CW_TMO = 0, CW_CODE = 1, CW_BAR = 4096;
constexpr int RING_OFF = 0, RING_BYTES = 131072;
constexpr int LDSCTL_OFF = RING_BYTES, MISC_OFF = LDSCTL_OFF + 320;
constexpr int LDS_BYTES = 147456;
#define GAS __attribute__((address_space(1)))
#define LAS __attribute__((address_space(3)))
typedef unsigned short bf16;
typedef unsigned v4u __attribute__((ext_vector_type(4)));
typedef float f32x4 __attribute__((ext_vector_type(4)));
typedef short bf16x8 __attribute__((ext_vector_type(8)));
typedef GAS unsigned gu32;
typedef GAS unsigned long long gu64;
#define RLX_AGENT __ATOMIC_RELAXED, __HIP_MEMORY_SCOPE_AGENT
#define LDS_WAIT() asm volatile("s_waitcnt lgkmcnt(0)" ::: "memory")
#define VM_WAIT() asm volatile("s_waitcnt vmcnt(0)" ::: "memory")
__device__ __forceinline__ unsigned long long rt() { return __builtin_amdgcn_s_memrealtime(); }
__device__ __forceinline__ unsigned f2bf(float f) { unsigned u = __builtin_bit_cast(unsigned, f); return (u + 0x7fffu + ((u >> 16) & 1u)) >> 16; }
__device__ __forceinline__ unsigned pk2(float lo, float hi) { return f2bf(lo) | (f2bf(hi) << 16); }

#define XB_TMO      128
#define XB_XCNT(j)  (256  + 64 * (j))
#define XB_XSUB(j)  (1280 + 64 * (j))
#define XB_XGEN(j)  (2304 + 64 * (j))
#define XB_TOP      3328
#define XB_TOPGEN   3392
#define XCD_BAR_WORDS 3456
#define XB_SPIN_CAP (1u << 18)

__device__ __forceinline__ unsigned xb_ld(unsigned* p)              { return __hip_atomic_load(p, __ATOMIC_RELAXED, __HIP_MEMORY_SCOPE_AGENT); }
__device__ __forceinline__ unsigned xb_add(unsigned* p, unsigned v) { return __hip_atomic_fetch_add(p, v, __ATOMIC_RELAXED, __HIP_MEMORY_SCOPE_AGENT); }
__device__ __forceinline__ unsigned xb_xcc_id() { return (unsigned)__builtin_amdgcn_s_getreg((3 << 11) | 20) & 0xFu; }
#define XB_SPIN(cond, bar) do { unsigned _sp = 0; while (cond) { __builtin_amdgcn_s_sleep(1); \
    if ((++_sp & 255u) == 0u) { if (xb_ld(&(bar)[XB_TMO])) break; if (_sp > XB_SPIN_CAP) { atomicAdd(&(bar)[XB_TMO], 1u); break; } } } } while (0)

struct XcdBarrier {
    unsigned* bar; unsigned x;
    volatile LAS unsigned* st;
};

__device__ __forceinline__ XcdBarrier xcd_barrier_post(unsigned* bar, volatile LAS unsigned* st) {
    XcdBarrier b; b.bar = bar; b.x = xb_xcc_id(); b.st = st;
    if (threadIdx.x == 0) (void)xb_add(&bar[XB_XCNT(b.x)], 1u);
    return b;
}
__device__ __forceinline__ void xcd_barrier_complete(unsigned* bar, unsigned x, unsigned& nloc, unsigned& nx) {
    const unsigned G = gridDim.x * gridDim.y * gridDim.z;
    unsigned sum, cnt, mine, sp = 0u;
    for (;;) {
        sum = 0u; cnt = 0u; mine = 0u;
#pragma unroll
        for (unsigned j = 0; j < 16; ++j) { const unsigned c = xb_ld(&bar[XB_XCNT(j)]); sum += c; cnt += (c > 0u) ? 1u : 0u; mine = (j == x) ? c : mine; }
        if (sum == G) break;
        __builtin_amdgcn_s_sleep(1);
        if ((++sp & 255u) == 0u) { if (xb_ld(&bar[XB_TMO])) break; if (sp > XB_SPIN_CAP) { atomicAdd(&bar[XB_TMO], 1u); break; } }
    }
    nloc = mine > 0u ? mine : 1u; nx = cnt > 0u ? cnt : 1u;
}

__device__ __forceinline__ void xcd_barrier(const XcdBarrier& b) {
    asm volatile("s_waitcnt vmcnt(0)" ::: "memory");
    __syncthreads();
    if (threadIdx.x == 0) {
        unsigned* bar = b.bar;
        __builtin_amdgcn_s_waitcnt(0);
        unsigned nloc = b.st[0], nx = b.st[1];
        if (nloc == 0u) { xcd_barrier_complete(bar, b.x, nloc, nx); b.st[0] = nloc; b.st[1] = nx; }
        const unsigned old = xb_add(&bar[XB_XSUB(b.x)], 1u);
        const unsigned gen = old / nloc;
        if (old + 1u == (gen + 1u) * nloc) {
            __builtin_amdgcn_fence(__ATOMIC_RELEASE, "agent");
            asm volatile("s_waitcnt vmcnt(0)" ::: "memory");
            const unsigned og = xb_add(&bar[XB_TOP], 1u);
            const unsigned tg = og / nx;
            if (og + 1u == (tg + 1u) * nx) xb_add(&bar[XB_TOPGEN], 1u);
            else XB_SPIN(xb_ld(&bar[XB_TOPGEN]) == tg, bar);
            __builtin_amdgcn_fence(__ATOMIC_ACQUIRE, "agent");
            xb_add(&bar[XB_XGEN(b.x)], 1u);
            asm volatile("s_waitcnt vmcnt(0)" ::: "memory");
        } else {
            XB_SPIN(xb_ld(&bar[XB_XGEN(b.x)]) == gen, bar);
            __builtin_amdgcn_fence(__ATOMIC_ACQUIRE, "agent");
            asm volatile("s_waitcnt vmcnt(0)" ::: "memory");
        }
    }
    __syncthreads();
}

static_assert((CW_BAR + XCD_BAR_WORDS) * 4 <= (int)CTL_ZERO_BYTES, "barrier words inside the memset region");
typedef float f32x16 __attribute__((ext_vector_type(16)));
typedef short s16x4 __attribute__((ext_vector_type(4)));
typedef unsigned u32x2 __attribute__((ext_vector_type(2)));
typedef unsigned u32x4 __attribute__((ext_vector_type(4)));
struct Frame {
    LAS unsigned char* lds;
    volatile LAS unsigned* MISC;
    gu32* ctl;
    int tid, lane, wave;
    int vcu, G;
    const float *xp, *xs, *meta, *t5, *g1, *w_in, *qna, *kna, *rpb, *qnb, *knb, *sink, *ona, *onb, *w_out, *g2, *w_gate, *w_up, *w_down;
    float* out;
    bf16 *XN, *MIX, *WIN, *WOUT, *WGU, *WDN, *X1B, *H, *QA, *KA, *VAT, *QB, *KB, *VBT;
    float* SS2;
};
__device__ __forceinline__ float wave_sum(float v) {
#pragma unroll
    for (int o = 1; o < 64; o <<= 1) v += __shfl_xor(v, o);
    return v;
}
__device__ __forceinline__ void p0_transpose_item(const float* W, int K, int N, bf16* WT, int k0, int n0, int drow, const float* g, LAS float* scr, int lane) {
#pragma unroll 8
    for (int i = 0; i < 32; ++i) { const int kk = 2 * i + (lane >> 5); float v = W[(size_t)(k0 + kk) * N + n0 + (lane & 31)]; if (g) v *= g[k0 + kk]; scr[kk * 33 + (lane & 31)] = v; }
    LDS_WAIT(); asm volatile("" ::: "memory");
    const int c = lane & 7;
#pragma unroll
    for (int j = 0; j < 4; ++j) { const int n = (lane >> 3) + 8 * j; const LAS float* s = scr + (8 * c) * 33 + n;
        v4u o; o.x = pk2(s[0 * 33], s[1 * 33]); o.y = pk2(s[2 * 33], s[3 * 33]); o.z = pk2(s[4 * 33], s[5 * 33]); o.w = pk2(s[6 * 33], s[7 * 33]);
        *(GAS v4u*)(WT + (size_t)(drow + n) * K + k0 + 8 * c) = o; }
    LDS_WAIT(); asm volatile("" ::: "memory");
}
__device__ __forceinline__ void p0_prologue(Frame& F) {
    LAS float* scr = (LAS float*)(F.lds + RING_OFF + F.wave * 16384);
    const int gw = F.vcu * NWAVES + F.wave, NGW = F.G * NWAVES;
    constexpr int I_IN = (DM / 64) * (NIN / 32), I_OUT = (DM / 64) * (DM / 32), I_G = (DM / 64) * (DFF / 32), I_DN = (DFF / 64) * (DM / 32);
    constexpr int NITEMS = I_IN + I_OUT + 2 * I_G + I_DN;
    for (int it = gw; it < NITEMS; it += NGW) {
        int r = it;
        if (r < I_IN) { const int nb = r % (NIN / 32), kb = r / (NIN / 32), n0 = 32 * nb, g = n0 >> 6;
            const int drow = 256 * (g >> 2) + 128 * ((n0 & 63) >> 5) + 32 * (g & 3);
            p0_transpose_item(F.w_in, DM, NIN, F.WIN, 64 * kb, n0, drow, nullptr, scr, F.lane); continue; } r -= I_IN;
        if (r < I_OUT) { const int nb = r % (DM / 32), kb = r / (DM / 32); p0_transpose_item(F.w_out, DM, DM, F.WOUT, 64 * kb, 32 * nb, 32 * nb, nullptr, scr, F.lane); continue; } r -= I_OUT;
        if (r < I_G) { const int nb = r % (DFF / 32), kb = r / (DFF / 32), n0 = 32 * nb; p0_transpose_item(F.w_gate, DM, DFF, F.WGU, 64 * kb, n0, 256 * (n0 >> 7) + (n0 & 127), F.g2, scr, F.lane); continue; } r -= I_G;
        if (r < I_G) { const int nb = r % (DFF / 32), kb = r / (DFF / 32), n0 = 32 * nb; p0_transpose_item(F.w_up, DM, DFF, F.WGU, 64 * kb, n0, 256 * (n0 >> 7) + 128 + (n0 & 127), F.g2, scr, F.lane); continue; } r -= I_G;
        { const int nb = r % (DM / 32), kb = r / (DM / 32); p0_transpose_item(F.w_down, DFF, DM, F.WDN, 64 * kb, 32 * nb, 32 * nb, nullptr, scr, F.lane); }
    }
    for (int m = gw; m < MPAD; m += NGW) {
        GAS unsigned long long* o8 = (GAS unsigned long long*)(F.XN + (size_t)m * DM) + F.lane;
        if (m >= MTOK + 16) {
#pragma unroll
            for (int j = 0; j < 4; ++j) o8[64 * j] = 0ull;
            continue; }
        const float* xrow = m < 16384 ? F.xp + (size_t)m * DM : (m < MTOK ? F.xs + (size_t)(m - 16384) * DM : F.meta + (size_t)(m - MTOK) * DM);
        const GAS f32x4* xr = (const GAS f32x4*)xrow + F.lane; const GAS f32x4* gr = (const GAS f32x4*)F.g1 + F.lane;
        f32x4 v[4]; float s = 0.f;
#pragma unroll
        for (int j = 0; j < 4; ++j) { v[j] = xr[64 * j]; s += (v[j].x * v[j].x + v[j].y * v[j].y) + (v[j].z * v[j].z + v[j].w * v[j].w); }
        const float rstd = 1.f / sqrtf(wave_sum(s) * (1.f / DM) + EPS);
#pragma unroll
        for (int j = 0; j < 4; ++j) { const f32x4 g = gr[64 * j]; const f32x4 y = v[j] * rstd * g;
            o8[64 * j] = (unsigned long long)pk2(y.x, y.y) | ((unsigned long long)pk2(y.z, y.w) << 32); }
    }
}
__device__ __forceinline__ unsigned cvtpk(float lo, float hi) { unsigned r; asm volatile("v_cvt_pk_bf16_f32 %0, %1, %2" : "=v"(r) : "v"(lo), "v"(hi)); return r; }
__device__ __forceinline__ void attn_load_kv(bf16x8 (&kf)[4], bf16x8 (&vf)[2][2], const bf16* krow, const bf16* vcol) {
#pragma unroll
    for (int s = 0; s < 4; ++s) kf[s] = *(const bf16x8*)(krow + 16 * s);
#pragma unroll
    for (int db = 0; db < 2; ++db)
#pragma unroll
        for (int s = 0; s < 2; ++s) { const bf16* p = vcol + (size_t)(32 * db) * MPAD + 16 * s;
            const s16x4 lo = *(const s16x4*)p, hi = *(const s16x4*)(p + 8);
            vf[db][s] = (bf16x8){lo[0], lo[1], lo[2], lo[3], hi[0], hi[1], hi[2], hi[3]}; }
}
__device__ __forceinline__ f32x16 attn_qk(const bf16x8 (&kf)[4], const bf16x8 (&qf)[4]) {
    f32x16 S = {};
#pragma unroll
    for (int s = 0; s < 4; ++s) S = __builtin_amdgcn_mfma_f32_32x32x16_bf16(kf[s], qf[s], S, 0, 0, 0);
    return S;
}
__device__ __forceinline__ void attn_pv(f32x16 (&O)[2], const f32x16& P, const bf16x8 (&vf)[2][2]) {
#pragma unroll
    for (int s = 0; s < 2; ++s) {
        u32x4 pw; pw.x = cvtpk(P[8 * s + 0], P[8 * s + 1]); pw.y = cvtpk(P[8 * s + 2], P[8 * s + 3]); pw.z = cvtpk(P[8 * s + 4], P[8 * s + 5]); pw.w = cvtpk(P[8 * s + 6], P[8 * s + 7]);
        const bf16x8 pb = __builtin_bit_cast(bf16x8, pw);
#pragma unroll
        for (int db = 0; db < 2; ++db) O[db] = __builtin_amdgcn_mfma_f32_32x32x16_bf16(vf[db][s], pb, O[db], 0, 0, 0);
    }
}
template <bool ISB>
__device__ __forceinline__ void attn_unit(Frame& F, int t0, const LAS float* tabA, const LAS float* tabB, float sinkexp, LAS float* ssx) {
    const int lane = F.lane, w = F.wave, q = lane & 31, h = lane >> 5;
    int sb, N; if (t0 < 16384) { sb = t0 & ~8191; N = 8192; } else { sb = 16384 + ((t0 - 16384) & ~4095); N = 4096; }
    const int q0 = t0 - sb;
    const bf16* Qp = (ISB ? F.QB : F.QA) + (size_t)(t0 + q) * 512 + w * 64 + 8 * h;
    const int kpitch = ISB ? 128 : 512, khead = ISB ? (w >> 2) : w;
    const bf16* Kp = (ISB ? F.KB : F.KA) + (size_t)q * kpitch + khead * 64 + 8 * h;
    const bf16* Vp = (ISB ? F.VBT : F.VAT) + (size_t)(khead * 64 + q) * MPAD + 4 * h;
    bf16x8 qf[2][4];
#pragma unroll
    for (int qb = 0; qb < 2; ++qb)
#pragma unroll
        for (int s = 0; s < 4; ++s) qf[qb][s] = *(const bf16x8*)(Qp + (size_t)(32 * qb) * 512 + 16 * s);
    f32x16 O[2][2]; float l[2] = {0.f, 0.f};
#pragma unroll
    for (int qb = 0; qb < 2; ++qb)
#pragma unroll
        for (int db = 0; db < 2; ++db) O[qb][db] = (f32x16){};
    bf16x8 kf[4], vf[2][2];
    attn_load_kv(kf, vf, Kp + (size_t)MTOK * kpitch, Vp + MTOK);
#pragma unroll
    for (int qb = 0; qb < 2; ++qb) {
        f32x16 P = attn_qk(kf, qf[qb]); float ls = 0.f;
        const int ib = 144 - q0 - 32 * qb - q + 4 * h;
#pragma unroll
        for (int r = 0; r < 16; ++r) {
            if (r < 8) { float b = 0.f; if (ISB) { int idx = ib + (r & 3) + 8 * (r >> 2); idx = idx < 32 ? 32 : idx; b = tabB[idx]; }
                const float p = __builtin_amdgcn_exp2f(P[r] + b); P[r] = p; ls += p; }
            else P[r] = 0.f; }
        l[qb] += ls; attn_pv(O[qb], P, vf);
    }
    if (!ISB) {
        const int rows = N >> 6, r = q0 >> 6; int rs = r - 4; rs = rs < 0 ? 0 : (rs > rows - 8 ? rows - 8 : rs);
#pragma unroll 1
        for (int i = 0; i < 8; ++i) {
            const int rowoff = (rs + i - r + 7) * 32;
#pragma unroll 1
            for (int cb = 0; cb < 2; ++cb) {
                const int tb = sb + 64 * (rs + i) + 32 * cb;
                attn_load_kv(kf, vf, Kp + (size_t)tb * kpitch, Vp + tb);
#pragma unroll
                for (int qb = 0; qb < 2; ++qb) {
                    f32x16 P = attn_qk(kf, qf[qb]); float ls = 0.f;
                    const int c = 32 * qb + q; int cs = c - 8; cs = cs < 0 ? 0 : (cs > 48 ? 48 : cs);
                    const int kcb = 32 * cb + 4 * h;
#pragma unroll
                    for (int rg = 0; rg < 16; ++rg) { const int kc = kcb + (rg & 3) + 8 * (rg >> 2);
                        const float b = tabA[rowoff + ((kc - c + 15) & 31)];
                        const float p = ((unsigned)(kc - cs) < 16u) ? __builtin_amdgcn_exp2f(P[rg] + b) : 0.f; P[rg] = p; ls += p; }
                    l[qb] += ls; attn_pv(O[qb], P, vf);
                }
            }
        }
    } else {
#pragma unroll 1
        for (int j = 0; j < 10; ++j) {
            const int kp0 = q0 - 128 + 32 * j;
            if (kp0 < 0 || kp0 >= N) continue;
            attn_load_kv(kf, vf, Kp + (size_t)(sb + kp0) * kpitch, Vp + sb + kp0);
#pragma unroll
            for (int qb = 0; qb < 2; ++qb) {
                if ((qb == 0 && j == 9) || (qb == 1 && j == 0)) continue;
                f32x16 P = attn_qk(kf, qf[qb]); float ls = 0.f;
                const int ib = 32 * j - 128 - 32 * qb - q + 4 * h + 160;
#pragma unroll
                for (int rg = 0; rg < 16; ++rg) { const float b = tabB[ib + (rg & 3) + 8 * (rg >> 2)];
                    const float p = __builtin_amdgcn_exp2f(P[rg] + b); P[rg] = p; ls += p; }
                l[qb] += ls; attn_pv(O[qb], P, vf);
            }
        }
    }
    float inv[2];
#pragma unroll
    for (int qb = 0; qb < 2; ++qb) { float lt = l[qb] + __shfl_xor(l[qb], 32); if (ISB) lt += sinkexp; inv[qb] = 1.0f / lt;
        float ss = 0.f;
#pragma unroll
        for (int db = 0; db < 2; ++db)
#pragma unroll
            for (int rg = 0; rg < 16; ++rg) { const float o = O[qb][db][rg] * inv[qb]; O[qb][db][rg] = o; ss += o * o; }
        ss += __shfl_xor(ss, 32);
        if (h == 0) ssx[(32 * qb + q) * 8 + w] = ss; }
    LDS_WAIT(); __syncthreads();
    const float* gain = (ISB ? F.onb : F.ona) + w * 64 + 4 * h;
    bf16* Mp = F.MIX + (size_t)(t0 + q) * DM + (ISB ? 512 : 0) + w * 64 + 4 * h;
#pragma unroll
    for (int qb = 0; qb < 2; ++qb) {
        const f32x4 s0 = *(const LAS f32x4*)(ssx + (32 * qb + q) * 8), s1 = *(const LAS f32x4*)(ssx + (32 * qb + q) * 8 + 4);
        const float tot = ((s0[0] + s0[1]) + (s0[2] + s0[3])) + ((s1[0] + s1[1]) + (s1[2] + s1[3]));
        const float rn = 1.0f / sqrtf(tot * (1.0f / 512.0f) + EPS);
#pragma unroll
        for (int db = 0; db < 2; ++db)
#pragma unroll
            for (int g = 0; g < 4; ++g) { const f32x4 gv = *(const f32x4*)(gain + 32 * db + 8 * g);
                u32x2 o; o.x = cvtpk(O[qb][db][4 * g + 0] * rn * gv[0], O[qb][db][4 * g + 1] * rn * gv[1]); o.y = cvtpk(O[qb][db][4 * g + 2] * rn * gv[2], O[qb][db][4 * g + 3] * rn * gv[3]);
                *(u32x2*)(Mp + (size_t)(32 * qb) * DM + 32 * db + 8 * g) = o; }
    }
    LDS_WAIT(); __syncthreads();
}
__device__ __forceinline__ void attn_phase(Frame& F) {
    const int lane = F.lane, w = F.wave;
    LAS float* tabA = (LAS float*)(F.lds + RING_OFF + w * 4096);
    LAS float* tabB = tabA + 512;
    LAS float* ssx = (LAS float*)(F.lds + RING_OFF + 65536);
    for (int i = lane; i < 15 * 32; i += 64) { const int dr = i >> 5, dc = i & 31; tabA[i] = dc < 31 ? F.rpb[(w * 15 + dr) * 31 + dc] * LOG2E : 0.f; }
    for (int i = lane; i < 320; i += 64) { const int rel = i - 160, n = rel < 0 ? -rel : rel; float v = -INFINITY;
        if (n <= 128) { const int lg = n < 8 ? n : (33 - __clz(n * n)); const int bk = (rel > 0 ? 16 : 0) + (lg > 15 ? 15 : lg); v = F.t5[bk * 8 + w] * LOG2E; }
        tabB[i] = v; }
    const float sinkexp = __builtin_amdgcn_exp2f(F.sink[w] * LOG2E);
    LDS_WAIT(); __syncthreads();
    for (int u = F.vcu; u < 512; u += F.G) attn_unit<false>(F, u * 64, tabA, tabB, sinkexp, ssx);
    asm volatile("" ::: "memory");
    for (int u = F.vcu; u < 512; u += F.G) attn_unit<true>(F, u * 64, tabA, tabB, sinkexp, ssx);
}
#ifndef MK_N_LAUNCHES
#define MK_N_LAUNCHES 6
#endif
constexpr int N_LAUNCHES = MK_N_LAUNCHES;
constexpr int PER_PHASE = 6;
struct Args { const float* in[19]; float* out; unsigned char* ws; int ph_lo, ph_hi; };
__global__ void __launch_bounds__(NWAVES * 64, 2) hybrid_fwd(Args args) {
    __shared__ __attribute__((aligned(16))) unsigned char lds[LDS_BYTES];
    Frame F;
    F.lds = (LAS unsigned char*)lds;
    F.MISC = (volatile LAS unsigned*)(F.lds + MISC_OFF);
    F.tid = threadIdx.x; F.lane = F.tid & 63; F.wave = __builtin_amdgcn_readfirstlane(F.tid >> 6);
    F.G = gridDim.x; { const int bx = blockIdx.x; F.vcu = (F.G % 8 == 0) ? (bx % 8) * (F.G / 8) + bx / 8 : bx; }
    unsigned char* ws = args.ws; unsigned char* dout = (unsigned char*)args.out;
    F.ctl = (gu32*)(ws + WS_CTL);
    F.xp = args.in[0]; F.xs = args.in[1]; F.meta = args.in[2]; F.t5 = args.in[3]; F.g1 = args.in[4]; F.w_in = args.in[5]; F.qna = args.in[6]; F.kna = args.in[7];
    F.rpb = args.in[8]; F.qnb = args.in[9]; F.knb = args.in[10]; F.sink = args.in[11]; F.ona = args.in[12]; F.onb = args.in[13]; F.w_out = args.in[14]; F.g2 = args.in[15];
    F.w_gate = args.in[16]; F.w_up = args.in[17]; F.w_down = args.in[18]; F.out = args.out;
    F.XN = (bf16*)(dout + DO_XN); F.MIX = (bf16*)(dout + DO_MIX); F.WIN = (bf16*)(dout + DO_WIN); F.WOUT = (bf16*)(dout + DO_WOUT); F.WGU = (bf16*)(dout + DO_WGU);
    F.WDN = (bf16*)(ws + WS_WDN); F.X1B = (bf16*)(ws + WS_X1B); F.H = (bf16*)(ws + WS_H); F.SS2 = (float*)(ws + WS_SS2);
    F.QA = (bf16*)(ws + WS_QA); F.KA = (bf16*)(ws + WS_KA); F.VAT = (bf16*)(ws + WS_VAT); F.QB = (bf16*)(ws + WS_QB); F.KB = (bf16*)(ws + WS_KB); F.VBT = (bf16*)(ws + WS_VBT);
    for (int u = F.tid; u < (LDS_BYTES - LDSCTL_OFF) / 4; u += NWAVES * 64) ((LAS unsigned*)(F.lds + LDSCTL_OFF))[u] = 0u;
    __syncthreads();
    XcdBarrier bar; bar.bar = (unsigned*)(F.ctl + CW_BAR); bar.x = 0; bar.st = nullptr;
    if (N_LAUNCHES != PER_PHASE) bar = xcd_barrier_post((unsigned*)(F.ctl + CW_BAR), F.MISC + 8);
#define GRID_BAR() do { if (N_LAUNCHES != PER_PHASE) xcd_barrier(bar); } while (0)
    const int lo = args.ph_lo, hi = args.ph_hi;
#ifndef PH_MASK
#define PH_MASK 63
#endif
#define IN(k) (((PH_MASK >> (k)) & 1) && lo <= (k) && (k) < hi)
#define BOTH(k) (IN(k) && IN((k) + 1))
    if (IN(0)) { p0_prologue(F); if (BOTH(0)) GRID_BAR(); }
    if (IN(1)) {
        pg8::Gemm g{F.XN, F.WIN, MPAD, NIN, DM}; pg8::StaticOrder S; S.init(MPAD, NIN, F.G, (int)blockIdx.x);
        pg8::EpiQKV E{F.QA, F.KA, F.VAT, F.QB, F.KB, F.VBT, F.qna, F.kna, F.qnb, F.knb};
        pg8::gemm_phase<pg8::EpiQKV, pg8::StaticOrder, true, true>(F.lds + RING_OFF, g, S, E);
        if (BOTH(1)) GRID_BAR();
    }
    if (IN(2)) { attn_phase(F); if (BOTH(2)) GRID_BAR(); }
    if (IN(3)) {
        pg8::Gemm g{F.MIX, F.WOUT, MTOK, DM, DM}; pg8::StaticOrder S; S.init(MTOK, DM, F.G, (int)blockIdx.x);
        pg8::EpiOut E{F.xp, F.xs, F.X1B, F.SS2};
        pg8::gemm_phase<pg8::EpiOut, pg8::StaticOrder, true, true>(F.lds + RING_OFF, g, S, E);
        if (BOTH(3)) GRID_BAR();
    }
    if (IN(4)) {
        pg8::Gemm g{F.X1B, F.WGU, MTOK, NGU, DM}; pg8::StaticOrder S; S.init(MTOK, NGU, F.G, (int)blockIdx.x);
        pg8::EpiGU E{F.SS2, F.H};
        pg8::gemm_phase<pg8::EpiGU, pg8::StaticOrder, true, true>(F.lds + RING_OFF, g, S, E);
        if (BOTH(4)) GRID_BAR();
    }
    if (IN(5)) {
        pg8::Gemm g{F.H, F.WDN, MTOK, DM, DFF}; pg8::StaticOrder S; S.init(MTOK, DM, F.G, (int)blockIdx.x);
        pg8::EpiDown E{F.X1B, F.out};
        pg8::gemm_phase<pg8::EpiDown, pg8::StaticOrder, true, true>(F.lds + RING_OFF, g, S, E);
    }
#undef IN
#undef BOTH
}

extern "C" void kernel_launch(void* const* d_in, const int* in_sizes, int n_in, void* d_out, int out_size, void* d_ws, size_t ws_size, hipStream_t stream) {
    static int grid = 0;
    if (grid == 0) {
        if (n_in != 19 || out_size != MTOK * DM || ws_size < WS_END) { fprintf(stderr, "kernel_launch: unexpected shapes: n_in %d out %d ws %zu; nothing launched\n", n_in, out_size, ws_size); grid = -1; return; }
        int dev = 0, cus = 0;
        if (hipGetDevice(&dev) != hipSuccess || hipDeviceGetAttribute(&cus, hipDeviceAttributeMultiprocessorCount, dev) != hipSuccess) { grid = -1; return; }
        (void)hipGetLastError();
        grid = cus;
    }
    if (grid < 0) return;
    if (hipMemsetAsync((char*)d_ws + WS_CTL, 0, CTL_ZERO_BYTES, stream) != hipSuccess) { fprintf(stderr, "kernel_launch: memset failed\n"); return; }
    Args a{};
    for (int i = 0; i < 19; ++i) a.in[i] = (const float*)d_in[i];
    a.out = (float*)d_out; a.ws = (unsigned char*)d_ws;
    for (int li = 0; li < N_LAUNCHES; ++li) {
        a.ph_lo = (N_LAUNCHES == PER_PHASE) ? li : 0; a.ph_hi = (N_LAUNCHES == PER_PHASE) ? li + 1 : PER_PHASE;
        hipLaunchKernelGGL(hybrid_fwd, dim3(grid), dim3(NWAVES * 64), 0, stream, a);
        const hipError_t le = hipPeekAtLastError();
        if (le != hipSuccess) { fprintf(stderr, "kernel_launch: launch %d failed: %s\n", li, hipGetErrorName(le)); break; }
    }
}
```

```cpp
#include <hip/hip_runtime.h>
#include <cstdio>
#include <cstdint>
namespace pg8 {
#define PG8_LAS __attribute__((address_space(3)))
typedef unsigned short bf16_t;
typedef short bf16x8 __attribute__((ext_vector_type(8)));
typedef float f32x4 __attribute__((ext_vector_type(4)));
typedef unsigned u32x4 __attribute__((ext_vector_type(4)));
typedef int i32x4 __attribute__((ext_vector_type(4)));
constexpr int BM = 256, BK = 64, HALF = 128, HTB = HALF * BK * 2  , STAGE_BYTES = 8 * HTB, NXCD = 8, WGM = 8;

__host__ __device__ __forceinline__ int lds_byte(int r, int c) { const int st = (r >> 4) * 2 + (c >> 5), rr = r & 15, cc = c & 31, ob = rr * 64 + cc * 2; return st * 1024 + (ob ^ (((ob >> 9) & 1) << 5)); }
__host__ __device__ __forceinline__ void stage_rc(int b, int& R, int& C) { const int st = b / 1024, sb = b % 1024, swz = sb ^ (((sb >> 9) & 1) << 5); R = (st >> 1) * 16 + swz / 64; C = (st & 1) * 32 + (swz % 64) / 2; }
__host__ __device__ __forceinline__ int perm32(int rho) { const int n = rho >> 4, i = rho & 15; return 8 * (i >> 2) + 4 * n + (i & 3); }

struct Unit { int pm, pn; };
struct Gemm { const bf16_t* A; const bf16_t* Bt; int M, N, K; };

struct StaticOrder {
    int nM, nN, nwg, G, c;
    __host__ __device__ void init(int M, int N, int G_, int c_) { nM = M / BM; nN = N / BM; nwg = nM * nN; G = G_; c = c_; }
    __host__ __device__ bool next(int i, Unit& u) const {
        const long L = (long)i * G + c; if (L >= nwg) return false;
        int wgid = (int)L; { const int q = nwg / NXCD, r = nwg % NXCD, xcd = wgid % NXCD, off = wgid / NXCD; wgid = (xcd < r ? xcd * (q + 1) : r * (q + 1) + (xcd - r) * q) + off; }
        const int nig = WGM * nN, gid = wgid / nig, fm = gid * WGM, gsz = (nM - fm) < WGM ? (nM - fm) : WGM;
        u.pm = fm + ((wgid % nig) % gsz); u.pn = (wgid % nig) / gsz; return true;
    }
    __device__ __forceinline__ void a_ready(const Unit&) const {}
    __device__ __forceinline__ void done(const Unit&) const {}
};

struct XcdOrder {
    int nN, p0, cnt, nloc, rank;
    __host__ __device__ void init(int M, int N, int nloc_, int rank_, int nx, int xi) { const int nM = M / BM; nN = N / BM; p0 = (int)((long)xi * nM / nx); const int p1 = (int)((long)(xi + 1) * nM / nx); cnt = (p1 - p0) * nN; nloc = nloc_; rank = rank_; }
    __host__ __device__ bool next(int i, Unit& u) const {
        const long L = (long)i * nloc + rank; if (L >= cnt) return false;
        const int w = (int)L, np = cnt / nN, nig = WGM * nN, gid = w / nig, fm = gid * WGM, gsz = (np - fm) < WGM ? (np - fm) : WGM;
        u.pm = p0 + fm + ((w % nig) % gsz); u.pn = (w % nig) / gsz; return true;
    }
    __device__ __forceinline__ void a_ready(const Unit&) const {}
    __device__ __forceinline__ void done(const Unit&) const {}
};
struct RevOrder {
    StaticOrder s;
    __host__ __device__ void init(int M, int N, int G_, int c_) { s.init(M, N, G_, c_); }
    __host__ __device__ bool next(int i, Unit& u) const { const bool r = s.next(i, u); u.pm = s.nM - 1 - u.pm; return r; }
    __device__ __forceinline__ void a_ready(const Unit&) const {}
    __device__ __forceinline__ void done(const Unit&) const {}
};

typedef float f32x2_t __attribute__((ext_vector_type(2))); typedef __bf16 bf16x2_t __attribute__((ext_vector_type(2)));
__device__ __forceinline__ unsigned cvt_pk_bf16(float lo, float hi) { f32x2_t v = {lo, hi}; bf16x2_t b = __builtin_convertvector(v, bf16x2_t); return __builtin_bit_cast(unsigned, b); }
constexpr int MP_ROWS = 33024;
constexpr float RMS_EPS = 1e-6f;
constexpr float QSCALE = 0.125f * 1.4426950408889634f;

struct EpiQKV {
    typedef f32x4 acc_t;
    static constexpr bool PERM = true, AFTER_DRAIN = false, MIDK = false;
    unsigned char* ws; PG8_LAS unsigned char* vtl; const float *qna, *kna, *qnb, *knb;
    size_t oQA, oKA, oVAt, oQB, oKB, oVBt, oR1;
    __device__ __forceinline__ void operator()(const f32x4 (&acc)[2][2][4][2], const Unit& u, int wr, int wc, int fr, int fq) const {
        constexpr int NT = MP_ROWS / 32;
        const int pn = u.pn, row0 = u.pm * BM + wr * 64 + fr, sec = pn >> 1;
        bf16_t* dst; int head = 4 * (pn & 1) + wc; const float* gain = nullptr; float sc = 1.f; bool isV = false;
        const float* R1 = (const float*)(ws + oR1);
        if (sec == 0) { dst = (bf16_t*)(ws + oQA); gain = qna; sc = QSCALE; }
        else if (sec == 1) { dst = (bf16_t*)(ws + oKA); gain = kna; }
        else if (sec == 2) { dst = (bf16_t*)(ws + oVAt); isV = true; }
        else if (sec == 3) { dst = (bf16_t*)(ws + oQB); gain = qnb; sc = QSCALE; }
        else { if (wc < 2) { dst = (bf16_t*)(ws + oKB); head = wc; gain = knb; } else { dst = (bf16_t*)(ws + oVBt); head = wc - 2; isV = true; } }
        bf16_t* hbase = dst + (size_t)head * NT * 2048;
#define EPI_R1V() float r1v[2][4]; _Pragma("unroll") for (int ai = 0; ai < 2; ++ai) _Pragma("unroll") for (int m = 0; m < 4; ++m) r1v[ai][m] = R1[row0 + ai * HALF + m * 16]
        if (!isV) {
            EPI_R1V();
            f32x4 gv[2][2];
#pragma unroll
            for (int bj = 0; bj < 2; ++bj)
#pragma unroll
                for (int n = 0; n < 2; ++n) gv[bj][n] = *(const f32x4*)(gain + 32 * bj + 8 * fq + 4 * n) * sc;
#pragma unroll
            for (int ai = 0; ai < 2; ++ai)
#pragma unroll
                for (int m = 0; m < 4; ++m) {
                    float ss = 0.f;
#pragma unroll
                    for (int bj = 0; bj < 2; ++bj)
#pragma unroll
                        for (int n = 0; n < 2; ++n) { const f32x4 x = acc[ai][bj][m][n]; ss += (x[0] * x[0] + x[1] * x[1]) + (x[2] * x[2] + x[3] * x[3]); }
                    ss += __shfl_xor(ss, 16); ss += __shfl_xor(ss, 32);
                    const int row = row0 + ai * HALF + m * 16;
                    const float r1 = r1v[ai][m];
                    const float r = r1 * __builtin_amdgcn_rsqf(ss * (r1 * r1) * (1.0f / 64.0f) + RMS_EPS);
                    bf16_t* rowp = hbase + (size_t)(row >> 5) * 2048 + (fq >> 1) * 512 + ((fq & 1) * 32 + (row & 31)) * 8;
#pragma unroll
                    for (int bj = 0; bj < 2; ++bj) { const f32x4 v0 = acc[ai][bj][m][0] * r * gv[bj][0], v1 = acc[ai][bj][m][1] * r * gv[bj][1];
                        u32x4 w; w.x = cvt_pk_bf16(v0[0], v0[1]); w.y = cvt_pk_bf16(v0[2], v0[3]); w.z = cvt_pk_bf16(v1[0], v1[1]); w.w = cvt_pk_bf16(v1[2], v1[3]);
                        *(u32x4*)(rowp + bj * 1024) = w; }
                }
        } else {
            EPI_R1V();
            PG8_LAS unsigned short* vt = (PG8_LAS unsigned short*)(vtl + (wr * 4 + wc) * 2048);
            const int hh = (fr >> 2) & 1, jj = 4 * ((fr >> 3) & 1) + (fr & 3), wofs = (32 * hh + 8 * fq) * 8 + jj, ln = fq * 16 + fr;
#pragma unroll
            for (int ai = 0; ai < 2; ++ai)
#pragma unroll
                for (int m = 0; m < 4; ++m) { const int row = row0 + ai * HALF + m * 16; const float r1 = r1v[ai][m];
                    bf16_t* tb = hbase + (size_t)(row >> 5) * 2048 + (m & 1) * 512 + ln * 8;
#pragma unroll
                    for (int bj = 0; bj < 2; ++bj) { PG8_LAS unsigned short* buf = vt + bj * 512;
#pragma unroll
                        for (int n = 0; n < 2; ++n) { const f32x4 x = acc[ai][bj][m][n] * r1; const unsigned w0 = cvt_pk_bf16(x[0], x[1]), w1 = cvt_pk_bf16(x[2], x[3]);
                            buf[wofs + (4 * n + 0) * 8] = (unsigned short)(w0 & 0xffffu); buf[wofs + (4 * n + 1) * 8] = (unsigned short)(w0 >> 16);
                            buf[wofs + (4 * n + 2) * 8] = (unsigned short)(w1 & 0xffffu); buf[wofs + (4 * n + 3) * 8] = (unsigned short)(w1 >> 16); }
                        const u32x4 w = *(const PG8_LAS u32x4*)(buf + ln * 8);
                        *(u32x4*)(tb + bj * 1024) = w; }
                }
        }
    }
};
struct EpiOut {
    typedef i32x4 acc_t;
    static constexpr bool PERM = true, AFTER_DRAIN = false, MIDK = true;
    const bf16_t* XB; bf16_t* X1B; const float *SMA, *SMB, *SWO;
    __device__ __forceinline__ void pre(float (&rsc)[2][4], const Unit& u, int wr, int fr) const {
        const int row0 = u.pm * BM + wr * 64 + fr; float sa[2][4], sb[2][4];
#pragma unroll
        for (int ai = 0; ai < 2; ++ai)
#pragma unroll
            for (int m = 0; m < 4; ++m) { sa[ai][m] = SMA[row0 + ai * HALF + m * 16]; sb[ai][m] = SMB[row0 + ai * HALF + m * 16]; }
#pragma unroll
        for (int ai = 0; ai < 2; ++ai)
#pragma unroll
            for (int m = 0; m < 4; ++m) rsc[ai][m] = sa[ai][m] / sb[ai][m];
    }
    __device__ __forceinline__ void mid(i32x4 (&acc)[2][2][4][2], const float (&rsc)[2][4]) const {
#pragma unroll
        for (int ai = 0; ai < 2; ++ai)
#pragma unroll
            for (int bj = 0; bj < 2; ++bj)
#pragma unroll
                for (int m = 0; m < 4; ++m)
#pragma unroll
                    for (int n = 0; n < 2; ++n)
#pragma unroll
                        for (int i = 0; i < 4; ++i) acc[ai][bj][m][n][i] = (int)__builtin_rintf((float)acc[ai][bj][m][n][i] * rsc[ai][m]);
    }
    __device__ __forceinline__ void operator()(const i32x4 (&acc)[2][2][4][2], const Unit& u, int wr, int wc, int fr, int fq) const {
        const int row0 = u.pm * BM + wr * 64 + fr, colb = u.pn * BM + wc * 32 + 8 * fq;
        f32x4 swv[2][2];
#pragma unroll
        for (int bj = 0; bj < 2; ++bj)
#pragma unroll
            for (int n = 0; n < 2; ++n) swv[bj][n] = *(const f32x4*)(SWO + colb + bj * HALF + 4 * n);
#pragma unroll
        for (int ai = 0; ai < 2; ++ai) {
            u32x4 xb[4][2]; float sb[4];
#pragma unroll
            for (int m = 0; m < 4; ++m) { sb[m] = SMB[row0 + ai * HALF + m * 16];
#pragma unroll
                for (int bj = 0; bj < 2; ++bj) xb[m][bj] = __builtin_nontemporal_load((const u32x4*)(XB + (size_t)(row0 + ai * HALF + m * 16) * 1024 + colb + bj * HALF)); }
#pragma unroll
            for (int m = 0; m < 4; ++m) { const int row = row0 + ai * HALF + m * 16;
#pragma unroll
                for (int bj = 0; bj < 2; ++bj) { const u32x4 w = xb[m][bj];
                    f32x4 x0, x1; x0[0] = __uint_as_float(w.x << 16); x0[1] = __uint_as_float(w.x & 0xffff0000u); x0[2] = __uint_as_float(w.y << 16); x0[3] = __uint_as_float(w.y & 0xffff0000u);
                    x1[0] = __uint_as_float(w.z << 16); x1[1] = __uint_as_float(w.z & 0xffff0000u); x1[2] = __uint_as_float(w.w << 16); x1[3] = __uint_as_float(w.w & 0xffff0000u);
                    f32x4 v0, v1;
#pragma unroll
                    for (int i = 0; i < 4; ++i) { v0[i] = (float)acc[ai][bj][m][0][i] * (sb[m] * swv[bj][0][i]) + x0[i]; v1[i] = (float)acc[ai][bj][m][1][i] * (sb[m] * swv[bj][1][i]) + x1[i]; }
                    u32x4 o; o.x = cvt_pk_bf16(v0[0], v0[1]); o.y = cvt_pk_bf16(v0[2], v0[3]); o.z = cvt_pk_bf16(v1[0], v1[1]); o.w = cvt_pk_bf16(v1[2], v1[3]);
                    *(u32x4*)(X1B + (size_t)row * 1024 + colb + bj * HALF) = o; }
            }
        }
    }
};
struct EpiGU {
    typedef i32x4 acc_t;
    static constexpr bool PERM = true, AFTER_DRAIN = false, MIDK = false;
    const float *SS2, *SX, *SW; bf16_t* H;
    __device__ __forceinline__ void operator()(const i32x4 (&acc)[2][2][4][2], const Unit& u, int wr, int wc, int fr, int fq) const {
        const int row0 = u.pm * BM + wr * 64 + fr, colb = u.pn * HALF + wc * 32 + 8 * fq;
        float sx[2][4]; f32x4 swv[2][2];
#pragma unroll
        for (int ai = 0; ai < 2; ++ai)
#pragma unroll
            for (int m = 0; m < 4; ++m) sx[ai][m] = SX[row0 + ai * HALF + m * 16];
#pragma unroll
        for (int bj = 0; bj < 2; ++bj)
#pragma unroll
            for (int n = 0; n < 2; ++n) swv[bj][n] = *(const f32x4*)(SW + u.pn * BM + bj * HALF + wc * 32 + 8 * fq + 4 * n);
#pragma unroll
        for (int ai = 0; ai < 2; ++ai)
#pragma unroll
            for (int m = 0; m < 4; ++m) { const int row = row0 + ai * HALF + m * 16;
                const float r = sx[ai][m];
                float hv[8];
#pragma unroll
                for (int n = 0; n < 2; ++n)
#pragma unroll
                    for (int i = 0; i < 4; ++i) { const float g = (float)acc[ai][0][m][n][i] * (r * swv[0][n][i]), up = (float)acc[ai][1][m][n][i] * (r * swv[1][n][i]);
                        const float e = __builtin_amdgcn_exp2f(g * -1.4426950408889634f); hv[4 * n + i] = g * up * __builtin_amdgcn_rcpf(1.0f + e); }
                u32x4 w; w.x = cvt_pk_bf16(hv[0], hv[1]); w.y = cvt_pk_bf16(hv[2], hv[3]); w.z = cvt_pk_bf16(hv[4], hv[5]); w.w = cvt_pk_bf16(hv[6], hv[7]);
                *(u32x4*)(H + (size_t)row * 2816 + colb) = w;
            }
    }
};
struct EpiDown {
    typedef f32x4 acc_t;
    static constexpr bool PERM = true, AFTER_DRAIN = false, MIDK = false;
    const bf16_t* X1B; float* out;
    __device__ __forceinline__ void operator()(const f32x4 (&acc)[2][2][4][2], const Unit& u, int wr, int wc, int fr, int fq) const {
        const int row0 = u.pm * BM + wr * 64 + fr, colb = u.pn * BM + wc * 32 + 8 * fq;
        u32x4 xb[2][4][2];
#pragma unroll
        for (int ai = 0; ai < 2; ++ai)
#pragma unroll
            for (int m = 0; m < 4; ++m)
#pragma unroll
                for (int bj = 0; bj < 2; ++bj) xb[ai][m][bj] = __builtin_nontemporal_load((const u32x4*)(X1B + (size_t)(row0 + ai * HALF + m * 16) * 1024 + colb + bj * HALF));
#pragma unroll
        for (int ai = 0; ai < 2; ++ai)
#pragma unroll
            for (int m = 0; m < 4; ++m) { const size_t off = (size_t)(row0 + ai * HALF + m * 16) * 1024 + colb;
#pragma unroll
                for (int bj = 0; bj < 2; ++bj) { const u32x4 w = xb[ai][m][bj];
                    f32x4 x0, x1; x0[0] = __uint_as_float(w.x << 16); x0[1] = __uint_as_float(w.x & 0xffff0000u); x0[2] = __uint_as_float(w.y << 16); x0[3] = __uint_as_float(w.y & 0xffff0000u);
                    x1[0] = __uint_as_float(w.z << 16); x1[1] = __uint_as_float(w.z & 0xffff0000u); x1[2] = __uint_as_float(w.w << 16); x1[3] = __uint_as_float(w.w & 0xffff0000u);
                    *(f32x4*)(out + off + bj * HALF) = acc[ai][bj][m][0] + x0; *(f32x4*)(out + off + bj * HALF + 4) = acc[ai][bj][m][1] + x1; }
            }
    }
};

__device__ __forceinline__ f32x4 mma16(bf16x8 a, bf16x8 b, f32x4 c) { return __builtin_amdgcn_mfma_f32_16x16x32_bf16(a, b, c, 0, 0, 0); }
__device__ __forceinline__ i32x4 mma16(bf16x8 a, bf16x8 b, i32x4 c) { return __builtin_amdgcn_mfma_i32_16x16x64_i8(__builtin_bit_cast(i32x4, a), __builtin_bit_cast(i32x4, b), c, 0, 0, 0); }
template <class Epi, class Sched, bool ALIGN_EPI = false, bool SP2 = false>
__device__ __forceinline__ void gemm_phase(PG8_LAS unsigned char* lds, const Gemm g, const Sched& S, const Epi& E) {
    const int tid = threadIdx.x, wid = __builtin_amdgcn_readfirstlane(tid >> 6), lane = tid & 63, wr = wid >> 2, wc = wid & 3, fr = lane & 15, fq = lane >> 4;
    const int K = g.K, nt = K / BK;
    unsigned voffA[2], voffB[2];
#pragma unroll
    for (int i = 0; i < 2; ++i) { int R, C; stage_rc(tid * 16 + i * 8192, R, C); const int Rb = Epi::PERM ? ((R & ~31) + perm32(R & 31)) : R;
        voffA[i] = (unsigned)(R * K + C) * 2u; voffB[i] = (unsigned)(Rb * K + C) * 2u; }
    const size_t kstep = (size_t)(BK * 2);
    const size_t hstep = (size_t)HALF * K * 2;
    const size_t tstep = 2 * hstep;
    const unsigned ldsw = (unsigned)wid * 1024u;
    const int aoff = lds_byte(wr * 64 + fr, fq * 8), boff = lds_byte(wc * 32 + fr, fq * 8);
#define PG8_SA(b, h) (((b) * 2 + (h)) * HTB)
#define PG8_SB(b, h) ((4 + (b) * 2 + (h)) * HTB)
#define PG8_STAGE(bufoff, gbase, voff) do { _Pragma("unroll") for (int _i = 0; _i < 2; ++_i) \
        __builtin_amdgcn_global_load_lds((const unsigned*)((const char*)(gbase) + (voff)[_i]), (PG8_LAS unsigned*)(lds + (bufoff) + ldsw + _i * 8192), 16, 0, 0); } while (0)
#define PG8_LDA(dst, b, h) do { _Pragma("unroll") for (int m = 0; m < 4; ++m) _Pragma("unroll") for (int k = 0; k < 2; ++k) dst[m][k] = *(const PG8_LAS bf16x8*)(lds + PG8_SA(b, h) + aoff + m * 2048 + k * 1024); } while (0)
#define PG8_LDB(dst, b, h) do { _Pragma("unroll") for (int n = 0; n < 2; ++n) _Pragma("unroll") for (int k = 0; k < 2; ++k) dst[n][k] = *(const PG8_LAS bf16x8*)(lds + PG8_SB(b, h) + boff + n * 2048 + k * 1024); } while (0)
#define PG8_MMA(ai, bj, At, Bt) do { __builtin_amdgcn_s_setprio(1); _Pragma("unroll") for (int m = 0; m < 4; ++m) _Pragma("unroll") for (int n = 0; n < 2; ++n) _Pragma("unroll") for (int k = 0; k < 2; ++k) \
        acc[ai][bj][m][n] = mma16(Bt[n][k], At[m][k], acc[ai][bj][m][n]); __builtin_amdgcn_s_setprio(0); } while (0)
#define PG8_WAIT_V(n) asm volatile("s_waitcnt vmcnt(" #n ")" ::: "memory")
#define PG8_WAIT_L(n) asm volatile("s_waitcnt lgkmcnt(" #n ")" ::: "memory")
#define PG8_BAR __builtin_amdgcn_s_barrier()
#define PG8_SCHED __builtin_amdgcn_sched_barrier(0)
    Unit cur, nxt; int ui = 0;
    if (!S.next(0, cur)) return;
    typedef typename Epi::acc_t acc_t;
    acc_t acc[2][2][4][2];
#pragma unroll
    for (int a = 0; a < 2; ++a)
#pragma unroll
        for (int b = 0; b < 2; ++b)
#pragma unroll
            for (int m = 0; m < 4; ++m)
#pragma unroll
                for (int n = 0; n < 2; ++n) acc[a][b][m][n] = (acc_t){};
    bf16x8 At[4][2], B0[2][2], B1[2][2];
    const char* cA = (const char*)g.A + (size_t)cur.pm * tstep; const char* cB = (const char*)g.Bt + (size_t)cur.pn * tstep;
    S.a_ready(cur);
    if constexpr (SP2) {
        PG8_STAGE(PG8_SB(0, 0), cB, voffB); PG8_STAGE(PG8_SB(0, 1), cB + hstep, voffB); PG8_STAGE(PG8_SA(0, 0), cA, voffA); PG8_STAGE(PG8_SA(0, 1), cA + hstep, voffA);
        if (wr == 1) PG8_BAR;
        PG8_WAIT_V(2); PG8_BAR;
        PG8_STAGE(PG8_SB(1, 0), cB + kstep, voffB); PG8_STAGE(PG8_SA(1, 0), cA + kstep, voffA); PG8_STAGE(PG8_SB(1, 1), cB + hstep + kstep, voffB);
        PG8_WAIT_V(6); PG8_BAR;
    } else {
        PG8_STAGE(PG8_SB(0, 0), cB, voffB); PG8_STAGE(PG8_SA(0, 0), cA, voffA); PG8_STAGE(PG8_SB(0, 1), cB + hstep, voffB); PG8_STAGE(PG8_SA(0, 1), cA + hstep, voffA);
        if (wr == 1) PG8_BAR;
        PG8_WAIT_V(4); PG8_BAR;
        PG8_STAGE(PG8_SB(1, 0), cB + kstep, voffB); PG8_STAGE(PG8_SA(1, 0), cA + kstep, voffA); PG8_STAGE(PG8_SB(1, 1), cB + hstep + kstep, voffB);
        PG8_WAIT_V(6); PG8_BAR;
    }
    for (;;) {
        const bool has_next = S.next(ui + 1, nxt);
        float rsc[2][4];
        if constexpr (Epi::MIDK) E.pre(rsc, cur, wr, fr);
        const char* nA = has_next ? (const char*)g.A + (size_t)nxt.pm * tstep : cA; const char* nB = has_next ? (const char*)g.Bt + (size_t)nxt.pn * tstep : cB;
        for (int t = 0; t < nt; t += 2) {
            const bool last = (t == nt - 2);
            const char* a1 = cA + (size_t)(t + 1) * kstep;
            const char* a2 = last ? nA : cA + (size_t)(t + 2) * kstep; const char* b2 = last ? nB : cB + (size_t)(t + 2) * kstep;
            const char* a3 = a2 + kstep; const char* b3 = b2 + kstep;
            if (last && has_next) S.a_ready(nxt);
            if constexpr (Epi::MIDK) { if (t == nt / 2) E.mid(acc, rsc); }
            if constexpr (SP2) {
            PG8_LDB(B0, 0, 0); PG8_LDB(B1, 0, 1); PG8_SCHED; PG8_LDA(At, 0, 0); PG8_STAGE(PG8_SA(1, 1), a1 + hstep, voffA);
            PG8_WAIT_V(8); PG8_WAIT_L(0); PG8_BAR; PG8_MMA(0, 0, At, B0); PG8_MMA(0, 1, At, B1); PG8_BAR; PG8_SCHED;
            PG8_LDA(At, 0, 1); PG8_STAGE(PG8_SB(0, 0), b2, voffB); PG8_STAGE(PG8_SB(0, 1), b2 + hstep, voffB); PG8_STAGE(PG8_SA(0, 0), a2, voffA);
            PG8_WAIT_V(8); PG8_WAIT_L(0); PG8_BAR; PG8_MMA(1, 0, At, B0); PG8_MMA(1, 1, At, B1); PG8_BAR; PG8_SCHED;
            PG8_LDB(B0, 1, 0); PG8_LDB(B1, 1, 1); PG8_SCHED; PG8_LDA(At, 1, 0); PG8_STAGE(PG8_SA(0, 1), a2 + hstep, voffA);
            PG8_WAIT_V(8); PG8_WAIT_L(0); PG8_BAR; PG8_MMA(0, 0, At, B0); PG8_MMA(0, 1, At, B1); PG8_BAR; PG8_SCHED;
            PG8_LDA(At, 1, 1); PG8_STAGE(PG8_SB(1, 0), b3, voffB); PG8_STAGE(PG8_SB(1, 1), b3 + hstep, voffB); PG8_STAGE(PG8_SA(1, 0), a3, voffA);
            PG8_WAIT_V(8); PG8_WAIT_L(0); PG8_BAR; PG8_MMA(1, 0, At, B0); PG8_MMA(1, 1, At, B1); PG8_BAR; PG8_SCHED;
            } else {
            PG8_LDB(B0, 0, 0); PG8_SCHED; PG8_LDA(At, 0, 0); PG8_STAGE(PG8_SA(1, 1), a1 + hstep, voffA);
            PG8_WAIT_L(8); PG8_BAR; PG8_WAIT_L(0); PG8_MMA(0, 0, At, B0); PG8_BAR; PG8_SCHED;
            PG8_LDB(B1, 0, 1); PG8_STAGE(PG8_SB(0, 0), b2, voffB);
            PG8_BAR; PG8_WAIT_L(0); PG8_MMA(0, 1, At, B1); PG8_BAR;
            PG8_LDA(At, 0, 1); PG8_STAGE(PG8_SA(0, 0), a2, voffA);
            PG8_BAR; PG8_WAIT_L(0); PG8_MMA(1, 0, At, B0); PG8_BAR; PG8_SCHED;
            PG8_STAGE(PG8_SB(0, 1), b2 + hstep, voffB);
            PG8_WAIT_V(6); PG8_BAR; PG8_MMA(1, 1, At, B1); PG8_BAR;
            PG8_LDB(B0, 1, 0); PG8_SCHED; PG8_LDA(At, 1, 0); PG8_STAGE(PG8_SA(0, 1), a2 + hstep, voffA);
            PG8_WAIT_L(8); PG8_BAR; PG8_WAIT_L(0); PG8_MMA(0, 0, At, B0); PG8_BAR; PG8_SCHED;
            PG8_LDB(B1, 1, 1); PG8_STAGE(PG8_SB(1, 0), b3, voffB);
            PG8_BAR; PG8_WAIT_L(0); PG8_MMA(0, 1, At, B1); PG8_BAR;
            PG8_LDA(At, 1, 1); PG8_STAGE(PG8_SA(1, 0), a3, voffA);
            PG8_BAR; PG8_WAIT_L(0); PG8_MMA(1, 0, At, B0); PG8_BAR; PG8_SCHED;
            PG8_STAGE(PG8_SB(1, 1), b3 + hstep, voffB);
            PG8_WAIT_V(6); PG8_BAR; PG8_MMA(1, 1, At, B1); PG8_BAR;
            }
        }
        if constexpr (ALIGN_EPI) { if (wr == 0) PG8_BAR; }
        if constexpr (!Epi::AFTER_DRAIN) { E(acc, cur, wr, wc, fr, fq); S.done(cur); }
        if (!has_next) break;
#pragma unroll
        for (int a = 0; a < 2; ++a)
#pragma unroll
            for (int b = 0; b < 2; ++b)
#pragma unroll
                for (int m = 0; m < 4; ++m)
#pragma unroll
                    for (int n = 0; n < 2; ++n) acc[a][b][m][n] = (acc_t){};
        cur = nxt; cA = nA; cB = nB; ++ui;
        if constexpr (ALIGN_EPI) { if (wr == 1) PG8_BAR; }
    }
    PG8_WAIT_V(0);
    if constexpr (!ALIGN_EPI) { if (wr == 0) PG8_BAR; }
    PG8_BAR;
    if constexpr (Epi::AFTER_DRAIN) { E.fused(acc, cur, wr, wc, fr, fq, lds, wid, lane); S.done(cur); }
#undef PG8_SA
#undef PG8_SB
#undef PG8_STAGE
#undef PG8_LDA
#undef PG8_LDB
#undef PG8_MMA
#undef PG8_WAIT_V
#undef PG8_WAIT_L
#undef PG8_BAR
#undef PG8_SCHED
}
}
constexpr int NWAVES = 8;
constexpr int DM = 1024, MTOK = 32768, MPAD = pg8::MP_ROWS, NIN = 2304, DFF = 2816, NGU = 2 * DFF;
constexpr float LOG2E = 1.4426950408889634f;
constexpr float EPS = 1e-6f;
constexpr size_t MiB = 1u << 20;
constexpr size_t WS_CTL = 0, CTL_ZERO_BYTES = 65536;
constexpr size_t WS_SMA = 1 * MiB, WS_SMB = WS_SMA + 131072;
constexpr size_t WS_SWO = 9 * MiB + 524288 - 4096;
constexpr size_t WS_WOQ = 404 * MiB;
constexpr size_t WS_WDN = 3 * MiB;
constexpr size_t WS_R1 = 9 * MiB;
constexpr size_t WS_SX = WS_R1 + 262144, WS_SW = WS_R1 + 524288;
constexpr size_t WS_MIX = 10 * MiB;
constexpr size_t WS_X1Q = WS_MIX;
constexpr size_t WS_QKV = 74 * MiB;
constexpr size_t SZ_Q = (size_t)MPAD * 512 * 2, SZ_KB = (size_t)MPAD * 128 * 2;
constexpr size_t WS_QA = WS_QKV, WS_KA = WS_QA + SZ_Q, WS_VAT = WS_KA + SZ_Q, WS_QB = WS_VAT + SZ_Q, WS_KB = WS_QB + SZ_Q, WS_VBT = WS_KB + SZ_KB, WS_QKV_END = WS_VBT + SZ_KB;
constexpr size_t WS_H = 74 * MiB;
constexpr size_t WS_X1B = 250 * MiB;
constexpr size_t WS_XN = 314 * MiB;
constexpr size_t WS_WGQ = 405 * MiB;
constexpr size_t WS_WGU = 385 * MiB;
constexpr size_t WS_WIN = 396 * MiB;
constexpr size_t WS_WOUT = 383 * MiB;
constexpr size_t WS_END = 411 * MiB;
static_assert(WS_SMB + 131072 <= WS_WDN && WS_WDN + (size_t)DM * DFF * 2 <= WS_R1 && WS_R1 + (size_t)MPAD * 4 <= WS_SX && WS_SX + (size_t)MTOK * 4 <= WS_SWO && WS_SWO + 4096 == WS_SW && WS_SW + (size_t)NGU * 4 <= WS_MIX
              && WS_MIX + (size_t)MTOK * DM <= WS_QKV && WS_QKV_END <= WS_X1B && WS_H + (size_t)MTOK * DFF * 2 <= WS_X1B && WS_X1B + (size_t)MTOK * DM * 2 <= WS_XN
              && WS_XN + (size_t)MPAD * DM * 2 <= WS_WOUT && WS_WOUT + (size_t)DM * DM * 2 == WS_WGU && WS_WGU + (size_t)NGU * DM * 2 <= WS_WIN && WS_WIN + (size_t)NIN * DM * 2 <= WS_WOQ && WS_WOQ + (size_t)DM * DM == WS_WGQ
              && WS_WGQ + (size_t)NGU * DM <= WS_END, "d_ws map");
constexpr int CW_TMO = 0, CW_CODE = 1, CW_BAR = 4096;
constexpr int RING_OFF = 0, RING_BYTES = 131072;
constexpr int LDSCTL_OFF = 162816, MISC_OFF = LDSCTL_OFF + 320;
constexpr int LDS_BYTES = 163840;
#define GAS __attribute__((address_space(1)))
#define LAS __attribute__((address_space(3)))
typedef unsigned short bf16;
typedef unsigned v4u __attribute__((ext_vector_type(4)));
typedef float f32x4 __attribute__((ext_vector_type(4)));
typedef short bf16x8 __attribute__((ext_vector_type(8)));
typedef GAS unsigned gu32;
typedef GAS unsigned long long gu64;
#define RLX_AGENT __ATOMIC_RELAXED, __HIP_MEMORY_SCOPE_AGENT
#define LDS_WAIT() asm volatile("s_waitcnt lgkmcnt(0)" ::: "memory")
#define VM_WAIT() asm volatile("s_waitcnt vmcnt(0)" ::: "memory")
__device__ __forceinline__ unsigned long long rt() { return __builtin_amdgcn_s_memrealtime(); }
__device__ __forceinline__ unsigned f2bf(float f) { unsigned u = __builtin_bit_cast(unsigned, f); return (u + 0x7fffu + ((u >> 16) & 1u)) >> 16; }
__device__ __forceinline__ unsigned pk2(float lo, float hi) { return f2bf(lo) | (f2bf(hi) << 16); }

#define XB_TMO      128
#define XB_XCNT(j)  (256  + 64 * (j))
#define XB_XSUB(j)  (1280 + 64 * (j))
#define XB_XGEN(j)  (2304 + 64 * (j))
#define XB_TOP      3328
#define XB_TOPGEN   3392
#define XB_LSUB(j)  (3456 + 64 * (j))
#define XCD_BAR_WORDS 4480
#define XB_SPIN_CAP (1u << 18)

__device__ __forceinline__ unsigned xb_ld(unsigned* p)              { return __hip_atomic_load(p, __ATOMIC_RELAXED, __HIP_MEMORY_SCOPE_AGENT); }
__device__ __forceinline__ unsigned xb_add(unsigned* p, unsigned v) { return __hip_atomic_fetch_add(p, v, __ATOMIC_RELAXED, __HIP_MEMORY_SCOPE_AGENT); }
__device__ __forceinline__ unsigned xb_xcc_id() { return (unsigned)__builtin_amdgcn_s_getreg((3 << 11) | 20) & 0xFu; }
#define XB_SPIN(cond, bar) do { unsigned _sp = 0; while (cond) { __builtin_amdgcn_s_sleep(1); \
    if ((++_sp & 255u) == 0u) { if (xb_ld(&(bar)[XB_TMO])) break; if (_sp > XB_SPIN_CAP) { atomicAdd(&(bar)[XB_TMO], 1u); break; } } } } while (0)

struct XcdBarrier {
    unsigned* bar; unsigned x;
    volatile LAS unsigned* st;
};

__device__ __forceinline__ XcdBarrier xcd_barrier_post(unsigned* bar, volatile LAS unsigned* st) {
    XcdBarrier b; b.bar = bar; b.x = xb_xcc_id(); b.st = st;
    if (threadIdx.x == 0) st[3] = xb_add(&bar[XB_XCNT(b.x)], 1u);
    return b;
}
__device__ __forceinline__ void xcd_barrier_complete(unsigned* bar, unsigned x, unsigned& nloc, unsigned& nx, unsigned& xi) {
    const unsigned G = gridDim.x * gridDim.y * gridDim.z;
    unsigned sum, cnt, mine, below, sp = 0u;
    for (;;) {
        sum = 0u; cnt = 0u; mine = 0u; below = 0u;
#pragma unroll
        for (unsigned j = 0; j < 16; ++j) { const unsigned c = xb_ld(&bar[XB_XCNT(j)]); sum += c; cnt += (c > 0u) ? 1u : 0u; mine = (j == x) ? c : mine; below += (j < x && c > 0u) ? 1u : 0u; }
        if (sum == G) break;
        __builtin_amdgcn_s_sleep(1);
        if ((++sp & 255u) == 0u) { if (xb_ld(&bar[XB_TMO])) break; if (sp > XB_SPIN_CAP) { atomicAdd(&bar[XB_TMO], 1u); break; } }
    }
    nloc = mine > 0u ? mine : 1u; nx = cnt > 0u ? cnt : 1u; xi = below < nx ? below : nx - 1u;
}

__device__ __forceinline__ void xcd_barrier(const XcdBarrier& b) {
    asm volatile("s_waitcnt vmcnt(0)" ::: "memory");
    __syncthreads();
    if (threadIdx.x == 0) {
        unsigned* bar = b.bar;
        __builtin_amdgcn_s_waitcnt(0);
        unsigned nloc = b.st[0], nx = b.st[1];
        if (nloc == 0u) { unsigned xi; xcd_barrier_complete(bar, b.x, nloc, nx, xi); b.st[0] = nloc; b.st[1] = nx; b.st[2] = xi; }
        const unsigned old = xb_add(&bar[XB_XSUB(b.x)], 1u);
        const unsigned gen = old / nloc;
        if (old + 1u == (gen + 1u) * nloc) {
            __builtin_amdgcn_fence(__ATOMIC_RELEASE, "agent");
            asm volatile("s_waitcnt vmcnt(0)" ::: "memory");
            const unsigned og = xb_add(&bar[XB_TOP], 1u);
            const unsigned tg = og / nx;
            if (og + 1u == (tg + 1u) * nx) xb_add(&bar[XB_TOPGEN], 1u);
            else XB_SPIN(xb_ld(&bar[XB_TOPGEN]) == tg, bar);
            __builtin_amdgcn_fence(__ATOMIC_ACQUIRE, "agent");
            xb_add(&bar[XB_XGEN(b.x)], 1u);
            asm volatile("s_waitcnt vmcnt(0)" ::: "memory");
        } else {
            XB_SPIN(xb_ld(&bar[XB_XGEN(b.x)]) == gen, bar);
            __builtin_amdgcn_fence(__ATOMIC_ACQUIRE, "agent");
            asm volatile("s_waitcnt vmcnt(0)" ::: "memory");
        }
    }
    __syncthreads();
}

struct XcdEnv { int nloc, nx, xi, rank; };
__device__ __forceinline__ XcdEnv xcd_env(const XcdBarrier& b) {
    if (threadIdx.x == 0 && b.st[0] == 0u) { unsigned nloc, nx, xi; xcd_barrier_complete(b.bar, b.x, nloc, nx, xi); b.st[1] = nx; b.st[2] = xi; b.st[0] = nloc; }
    __syncthreads();
    XcdEnv e; e.nloc = __builtin_amdgcn_readfirstlane((int)b.st[0]); e.nx = __builtin_amdgcn_readfirstlane((int)b.st[1]); e.xi = __builtin_amdgcn_readfirstlane((int)b.st[2]); e.rank = __builtin_amdgcn_readfirstlane((int)b.st[3]);
    return e;
}
__device__ __forceinline__ void xcd_local_barrier(const XcdBarrier& b) {
    asm volatile("s_waitcnt vmcnt(0)" ::: "memory");
    __syncthreads();
    if (threadIdx.x == 0) {
        unsigned* bar = b.bar;
        __builtin_amdgcn_s_waitcnt(0);
        unsigned nloc = b.st[0];
        if (nloc == 0u) { unsigned nx, xi; xcd_barrier_complete(bar, b.x, nloc, nx, xi); b.st[1] = nx; b.st[2] = xi; b.st[0] = nloc; }
        const unsigned old = xb_add(&bar[XB_LSUB(b.x)], 1u);
        const unsigned target = (old / nloc + 1u) * nloc;
        XB_SPIN(xb_ld(&bar[XB_LSUB(b.x)]) < target, bar);
        __builtin_amdgcn_fence(__ATOMIC_ACQUIRE, "agent");
        asm volatile("s_waitcnt vmcnt(0)" ::: "memory");
    }
    __syncthreads();
}

static_assert((CW_BAR + 2 * XCD_BAR_WORDS) * 4 <= (int)CTL_ZERO_BYTES, "barrier words inside the memset region");
typedef float f32x16 __attribute__((ext_vector_type(16)));
typedef short s16x4 __attribute__((ext_vector_type(4)));
typedef unsigned u32x2 __attribute__((ext_vector_type(2)));
typedef unsigned u32x4 __attribute__((ext_vector_type(4)));
struct Frame {
    LAS unsigned char* lds;
    volatile LAS unsigned* MISC;
    gu32* ctl;
    int wave;
    int vcu, G;
};
__device__ __forceinline__ int fresh_lane() { int t = threadIdx.x; asm volatile("" : "+v"(t)); return t & 63; }
__device__ __forceinline__ float wave_sum(float v) {
#pragma unroll
    for (int o = 1; o < 64; o <<= 1) v += __shfl_xor(v, o);
    return v;
}
__device__ __forceinline__ unsigned q8x4(float a, float b, float c, float d, float qs) {
    const unsigned ua = __float_as_uint(__builtin_fmaf(a, qs, 12582912.0f)), ub = __float_as_uint(__builtin_fmaf(b, qs, 12582912.0f));
    const unsigned uc = __float_as_uint(__builtin_fmaf(c, qs, 12582912.0f)), ud = __float_as_uint(__builtin_fmaf(d, qs, 12582912.0f));
    const unsigned lo = __builtin_amdgcn_perm(ub, ua, 0x0c0c0400u), hi = __builtin_amdgcn_perm(ud, uc, 0x04000c0cu);
    return lo | hi;
}
constexpr int NBT_LD = 1028;
__device__ __forceinline__ void p0_nblock_task(const float* W, int N, int n0, const float* g, signed char* dstq, float* scl, int drow0, LAS float* T, int wave, int lane) {
    const int kq = lane >> 3, c4 = lane & 7;
#pragma unroll
    for (int kb2 = 0; kb2 < 2; ++kb2) { const int k0 = 64 * (2 * wave + kb2);
        f32x4 v[8];
#pragma unroll
        for (int i = 0; i < 8; ++i) v[i] = __builtin_nontemporal_load((const GAS f32x4*)(W + (size_t)(k0 + 8 * i + kq) * N + n0 + 4 * c4));
        if (g) {
#pragma unroll
            for (int i = 0; i < 8; ++i) v[i] = v[i] * g[k0 + 8 * i + kq]; }
#pragma unroll
        for (int i = 0; i < 8; ++i) { LAS float* d = T + (4 * c4) * NBT_LD + k0 + 8 * i + kq; d[0] = v[i].x; d[NBT_LD] = v[i].y; d[2 * NBT_LD] = v[i].z; d[3 * NBT_LD] = v[i].w; } }
    LDS_WAIT(); __syncthreads();
#pragma unroll
    for (int c = 0; c < 4; ++c) { const int ch = 4 * wave + c; const LAS f32x4* rp = (const LAS f32x4*)(T + ch * NBT_LD + 16 * lane);
        const f32x4 a = rp[0], b = rp[1], cc = rp[2], d = rp[3];
        float am = fmaxf(fmaxf(fmaxf(fabsf(a[0]), fabsf(a[1])), fmaxf(fabsf(a[2]), fabsf(a[3]))), fmaxf(fmaxf(fabsf(b[0]), fabsf(b[1])), fmaxf(fabsf(b[2]), fabsf(b[3]))));
        am = fmaxf(am, fmaxf(fmaxf(fmaxf(fabsf(cc[0]), fabsf(cc[1])), fmaxf(fabsf(cc[2]), fabsf(cc[3]))), fmaxf(fmaxf(fabsf(d[0]), fabsf(d[1])), fmaxf(fabsf(d[2]), fabsf(d[3])))));
#pragma unroll
        for (int o = 1; o < 64; o <<= 1) am = fmaxf(am, __shfl_xor(am, o));
        const float qs = am > 0.f ? 127.0f / am : 0.f;
        v4u q; q.x = q8x4(a[0], a[1], a[2], a[3], qs); q.y = q8x4(b[0], b[1], b[2], b[3], qs); q.z = q8x4(cc[0], cc[1], cc[2], cc[3], qs); q.w = q8x4(d[0], d[1], d[2], d[3], qs);
        *(GAS v4u*)(dstq + (size_t)(drow0 + ch) * DM + 16 * lane) = q;
        if (lane == 0) scl[drow0 + ch] = am > 0.f ? am * (1.0f / 127.0f) : 1.0f; }
    LDS_WAIT(); __syncthreads();
}
constexpr int P0_NTASKS = DM / 32 + 2 * (DFF / 32);
__device__ __forceinline__ void p0_weight_tasks(Frame& F, const float* w_out, const float* g2, const float* w_gate, const float* w_up, signed char* WOQ, float* SWO, signed char* WGQ, float* SW, int wg, int nwg) {
    LAS float* T = (LAS float*)(F.lds + RING_OFF);
    __syncthreads();
    for (int t = wg; t < P0_NTASKS; t += nwg) {
        if (t < DM / 32) { p0_nblock_task(w_out, DM, 32 * t, nullptr, WOQ, SWO, 32 * t, T, F.wave, fresh_lane()); continue; }
        const int r = t - DM / 32; const bool up = r >= DFF / 32; const int n0 = 32 * (up ? r - DFF / 32 : r);
        p0_nblock_task(up ? w_up : w_gate, DFF, n0, g2, WGQ, SW, 256 * (n0 >> 7) + (up ? 128 : 0) + (n0 & 127), T, F.wave, fresh_lane());
    }
}
__device__ __forceinline__ void p0_transpose_item(const float* W, int K, int N, bf16* WT, int k0, int n0, int drow, const float* g, LAS float* scr, int lane) {
    f32x4 v[8]; const int kq = lane >> 3, c4 = lane & 7;
#pragma unroll
    for (int i = 0; i < 8; ++i) v[i] = __builtin_nontemporal_load((const GAS f32x4*)(W + (size_t)(k0 + 8 * i + kq) * N + n0 + 4 * c4));
    if (g) {
#pragma unroll
        for (int i = 0; i < 8; ++i) v[i] = v[i] * g[k0 + 8 * i + kq]; }
#pragma unroll
    for (int i = 0; i < 8; ++i) { LAS float* d = scr + (8 * i + kq) * 33 + 4 * c4; d[0] = v[i].x; d[1] = v[i].y; d[2] = v[i].z; d[3] = v[i].w; }
    LDS_WAIT(); asm volatile("" ::: "memory");
    const int c = lane & 7;
#pragma unroll
    for (int j = 0; j < 4; ++j) { const int n = (lane >> 3) + 8 * j; const LAS float* s = scr + (8 * c) * 33 + n;
        v4u o; o.x = pk2(s[0 * 33], s[1 * 33]); o.y = pk2(s[2 * 33], s[3 * 33]); o.z = pk2(s[4 * 33], s[5 * 33]); o.w = pk2(s[6 * 33], s[7 * 33]);
        *(GAS v4u*)(WT + (size_t)(drow + n) * K + k0 + 8 * c) = o; }
    LDS_WAIT(); asm volatile("" ::: "memory");
}
constexpr int P0_I_IN = (DM / 64) * (NIN / 32), P0_I_DN = (DFF / 64) * (DM / 32), P0_NITEMS = P0_I_IN + P0_I_DN;
__device__ __forceinline__ void p0_weight_items(Frame& F, const float* g1, const float* w_in, const float* w_down, bf16* WIN, bf16* WDN, LAS float* scr, int lo, int hi, int worker, int nworkers) {
    constexpr int I_IN = P0_I_IN;
    for (int it = lo + worker; it < hi; it += nworkers) {
        int r = it;
        if (r < I_IN) { const int nb = r % (NIN / 32), kb = r / (NIN / 32), n0 = 32 * nb, g = n0 >> 6;
            const int drow = 256 * (g >> 2) + 128 * ((n0 & 63) >> 5) + 32 * (g & 3);
            p0_transpose_item(w_in, DM, NIN, WIN, 64 * kb, n0, drow, g1, scr, fresh_lane()); continue; } r -= I_IN;
        { const int nb = r % (DM / 32), kb = r / (DM / 32); p0_transpose_item(w_down, DFF, DM, WDN, 64 * kb, 32 * nb, 32 * nb, nullptr, scr, fresh_lane()); }
    }
}
__device__ __forceinline__ void p0_prologue(Frame& F, const float* xp, const float* xs, const float* meta, const float* g1, const float* w_in, const float* w_out, const float* g2, const float* w_gate, const float* w_up, const float* w_down,
        bf16* WIN, signed char* WOQ, float* SWO, signed char* WGQ, float* SW, bf16* WDN, bf16* XN, float* R1, bool defer) {
    LAS float* scr = (LAS float*)(F.lds + RING_OFF + F.wave * 16384);
    const int lane_ = fresh_lane();
    const int gw = F.vcu * NWAVES + F.wave, NGW = F.G * NWAVES;
    constexpr int I_IN = (DM / 64) * (NIN / 32);
    p0_weight_items(F, g1, w_in, w_down, WIN, WDN, scr, 0, defer ? I_IN : P0_NITEMS, gw, NGW);
    if (!defer) p0_weight_tasks(F, w_out, g2, w_gate, w_up, WOQ, SWO, WGQ, SW, F.vcu, F.G);
    for (int m0 = gw; m0 < MPAD; m0 += 4 * NGW) {
        f32x4 v[4][4];
#pragma unroll
        for (int b = 0; b < 4; ++b) { const int m = m0 + b * NGW;
            if (m < MTOK + 16) { const float* xrow = m < 16384 ? xp + (size_t)m * DM : (m < MTOK ? xs + (size_t)(m - 16384) * DM : meta + (size_t)(m - MTOK) * DM);
                const GAS f32x4* xr = (const GAS f32x4*)xrow + lane_;
#pragma unroll
                for (int j = 0; j < 4; ++j) v[b][j] = __builtin_nontemporal_load(xr + 64 * j); }
            else {
#pragma unroll
                for (int j = 0; j < 4; ++j) v[b][j] = (f32x4){0.f, 0.f, 0.f, 0.f}; } }
#pragma unroll
        for (int b = 0; b < 4; ++b) { const int m = m0 + b * NGW; if (m >= MPAD) continue;
            float sq = 0.f;
#pragma unroll
            for (int j = 0; j < 4; ++j) sq += (v[b][j].x * v[b][j].x + v[b][j].y * v[b][j].y) + (v[b][j].z * v[b][j].z + v[b][j].w * v[b][j].w);
            const float rstd = __builtin_amdgcn_rsqf(wave_sum(sq) * (1.f / DM) + EPS);
            if (lane_ == 0) R1[m] = rstd;
            GAS unsigned long long* o8 = (GAS unsigned long long*)(XN + (size_t)m * DM) + lane_;
#pragma unroll
            for (int j = 0; j < 4; ++j) { const f32x4 y = v[b][j];
                o8[64 * j] = (unsigned long long)pk2(y.x, y.y) | ((unsigned long long)pk2(y.z, y.w) << 32); } }
    }
}
__device__ __forceinline__ unsigned cvtpk(float lo, float hi) { return pg8::cvt_pk_bf16(lo, hi); }
__device__ __forceinline__ void attn_load_kv(bf16x8 (&kf)[4], bf16x8 (&vf)[2][2], const bf16* krow, const bf16* vcol) {
#pragma unroll
    for (int s = 0; s < 4; ++s) kf[s] = *(const bf16x8*)(krow + 16 * s);
#pragma unroll
    for (int db = 0; db < 2; ++db)
#pragma unroll
        for (int s = 0; s < 2; ++s) { const bf16* p = vcol + (size_t)(32 * db) * MPAD + 16 * s;
            const s16x4 lo = *(const s16x4*)p, hi = *(const s16x4*)(p + 8);
            vf[db][s] = (bf16x8){lo[0], lo[1], lo[2], lo[3], hi[0], hi[1], hi[2], hi[3]}; }
}
__device__ __forceinline__ void attn_load_k(bf16x8 (&kf)[4], const bf16* kt) {
#pragma unroll
    for (int s = 0; s < 4; ++s) kf[s] = *(const bf16x8*)(kt + 512 * s);
}
__device__ __forceinline__ void attn_load_v(bf16x8 (&vf)[2][2], const bf16* vt) {
#pragma unroll
    for (int db = 0; db < 2; ++db)
#pragma unroll
        for (int s = 0; s < 2; ++s) vf[db][s] = *(const bf16x8*)(vt + 512 * (2 * db + s));
}
__device__ __forceinline__ f32x16 attn_qk(const bf16x8 (&kf)[4], const LAS bf16x8* qf, f32x16 S = (f32x16){}) {
#pragma unroll
    for (int s = 0; s < 4; ++s) S = __builtin_amdgcn_mfma_f32_32x32x16_bf16(kf[s], qf[64 * s], S, 0, 0, 0);
    return S;
}
__device__ __forceinline__ void attn_pv_half(f32x16 (&O)[2], const float (&p)[8], const bf16x8 (&vf)[2][2], int s) {
    u32x4 pw; pw.x = cvtpk(p[0], p[1]); pw.y = cvtpk(p[2], p[3]); pw.z = cvtpk(p[4], p[5]); pw.w = cvtpk(p[6], p[7]);
    const bf16x8 pb = __builtin_bit_cast(bf16x8, pw);
#pragma unroll
    for (int db = 0; db < 2; ++db) O[db] = __builtin_amdgcn_mfma_f32_32x32x16_bf16(vf[db][s], pb, O[db], 0, 0, 0);
}
__device__ __forceinline__ f32x16 attn_tab16(const LAS float* tab4, int cstride, int I) {
    const int a = I & 3; const LAS f32x4* p = (const LAS f32x4*)(tab4 + a * cstride + (I - a));
    const f32x4 v0 = p[0], v1 = p[2], v2 = p[4], v3 = p[6];
    return (f32x16){v0[0], v0[1], v0[2], v0[3], v1[0], v1[1], v1[2], v1[3], v2[0], v2[1], v2[2], v2[3], v3[0], v3[1], v3[2], v3[3]};
}
constexpr int TA_CS = 608, TB_CS = 324, TM_CS = 132;
template <bool ISB, int CB>
__device__ __forceinline__ void attn_win_tile(f32x16 (&O)[2][2], float (&l)[2], const bf16x8 (&kf)[4], const bf16x8 (&vf)[2][2], const LAS bf16x8* qf,
                                              const LAS float* tabAB, const LAS float* tabM, int wt, int rowoff, int jlo, int q, int h) {
#pragma unroll
    for (int qb = 0; qb < 2; ++qb) {
        if (ISB) { const int j = jlo + wt; if ((qb == 0 && j == 9) || (qb == 1 && j == 0)) continue; }
        constexpr int cb = CB;
        f32x16 C, Bv = (f32x16){};
        if (!ISB) {
            const int c = 32 * qb + q; int cs = c - 8; cs = cs < 0 ? 0 : (cs > 48 ? 48 : cs);
            const int kcb = 32 * cb + 4 * h;
            C = attn_tab16(tabM, TM_CS, 63 + kcb - cs);
            Bv = attn_tab16(tabAB, TA_CS, rowoff + 63 + kcb - c);
        } else {
            C = attn_tab16(tabAB, TB_CS, 32 * (jlo + wt) - 128 - 32 * qb - q + 4 * h + 160);
        }
        const f32x16 S = attn_qk(kf, qf + 256 * qb, C);
        float ls0 = 0.f, ls1 = 0.f;
#pragma unroll
        for (int s2 = 0; s2 < 2; ++s2) {
            if (!ISB && qb != cb && s2 == cb) continue;
            float p[8];
#pragma unroll
            for (int j = 0; j < 8; ++j) { const int rg = 8 * s2 + j;
                float x = S[rg]; if (!ISB) x += Bv[rg];
                p[j] = __builtin_amdgcn_exp2f(x); }
            ls0 += (p[0] + p[1]) + (p[2] + p[3]); ls1 += (p[4] + p[5]) + (p[6] + p[7]);
            attn_pv_half(O[qb], p, vf, s2);
        }
        l[qb] += ls0 + ls1;
        __builtin_amdgcn_sched_barrier(0);
    }
}
struct AttnPtrs { const bf16 *QA, *KA, *VAT, *QB, *KB, *VBT; unsigned char* MIX; float *SMA, *SMB; const float *ona, *onb; };
template <bool ISB>
__device__ __forceinline__ void attn_unit(Frame& F, const AttnPtrs& T, int t0, const LAS float* tabAB, const LAS float* tabM, float sinkexp, LAS float* ssx, LAS bf16x8* qlds) {
    const int lane = fresh_lane(), w = F.wave, q = lane & 31, h = lane >> 5;
    int sb, N; if (t0 < 16384) { sb = t0 & ~8191; N = 8192; } else { sb = 16384 + ((t0 - 16384) & ~4095); N = 4096; }
    const int q0 = t0 - sb;
    constexpr int NT = MPAD / 32;
    const bf16* Qp = (ISB ? T.QB : T.QA) + ((size_t)w * NT + (t0 >> 5)) * 2048 + lane * 8;
    const int khead = ISB ? (w >> 2) : w;
    const bf16* Kp = (ISB ? T.KB : T.KA) + (size_t)khead * NT * 2048 + lane * 8;
    const bf16* Vp = (ISB ? T.VBT : T.VAT) + (size_t)khead * NT * 2048 + lane * 8;
    int nw, jlo = 0, tbase0, rs = 0, rq = 0;
    if (!ISB) { const int rows = N >> 6; rq = q0 >> 6; rs = rq - 4; rs = rs < 0 ? 0 : (rs > rows - 8 ? rows - 8 : rs); nw = 16; tbase0 = sb + 64 * rs; }
    else { jlo = q0 >= 128 ? 0 : (128 - q0) >> 5; int jhi = (N - q0 + 128) >> 5; jhi = jhi > 10 ? 10 : jhi; nw = jhi - jlo; tbase0 = sb + q0 - 128 + 32 * jlo; }
#define ATT_KROW(wt_) (rs + ((((wt_) >> 1) - rs) & 7))
#define ATT_TB(wt_) (ISB ? tbase0 + 32 * (wt_) : sb + 64 * ATT_KROW(wt_) + 32 * ((wt_) & 1))
    bf16x8 kfX[4], kfY[4], vfX[2][2], vfY[2][2];
    attn_load_k(kfX, Kp + (size_t)(MTOK >> 5) * 2048); attn_load_v(vfX, Vp + (size_t)(MTOK >> 5) * 2048);
    { const int tb = ATT_TB(0); attn_load_k(kfY, Kp + (size_t)(tb >> 5) * 2048); attn_load_v(vfY, Vp + (size_t)(tb >> 5) * 2048); }
    LAS bf16x8* qf = qlds + lane;
#pragma unroll
    for (int qb = 0; qb < 2; ++qb)
#pragma unroll
        for (int s = 0; s < 4; ++s) qf[256 * qb + 64 * s] = __builtin_nontemporal_load((const bf16x8*)(Qp + 2048 * qb + 512 * s));
    f32x16 O[2][2]; float l[2] = {0.f, 0.f};
#pragma unroll
    for (int qb = 0; qb < 2; ++qb)
#pragma unroll
        for (int db = 0; db < 2; ++db) O[qb][db] = (f32x16){};
#pragma unroll
    for (int qb = 0; qb < 2; ++qb) {
        const f32x16 S = attn_qk(kfX, qf + 256 * qb); float ls = 0.f;
        const int ib = 144 - q0 - 32 * qb - q + 4 * h;
        float p[8];
#pragma unroll
        for (int r = 0; r < 8; ++r) { float b = 0.f; if (ISB) { int idx = ib + (r & 3) + 8 * (r >> 2); idx = idx < 32 ? 32 : idx; b = tabAB[idx]; }
            p[r] = __builtin_amdgcn_exp2f(S[r] + b); ls += p[r]; }
        l[qb] += ls; attn_pv_half(O[qb], p, vfX, 0);
        __builtin_amdgcn_sched_barrier(0);
    }
#pragma unroll 1
    for (int wt = 0; wt < nw; wt += 2) {
        { const int tb = ATT_TB(wt + 1); attn_load_k(kfX, Kp + (size_t)(tb >> 5) * 2048); attn_load_v(vfX, Vp + (size_t)(tb >> 5) * 2048); }
        attn_win_tile<ISB, 0>(O, l, kfY, vfY, qf, tabAB, tabM, wt, ISB ? 0 : (ATT_KROW(wt) - rq + 7) * 32, jlo, q, h);
        { const int wn = wt + 2 < nw ? wt + 2 : wt; const int tb = ATT_TB(wn); attn_load_k(kfY, Kp + (size_t)(tb >> 5) * 2048); attn_load_v(vfY, Vp + (size_t)(tb >> 5) * 2048); }
        attn_win_tile<ISB, 1>(O, l, kfX, vfX, qf, tabAB, tabM, wt + 1, ISB ? 0 : (ATT_KROW(wt + 1) - rq + 7) * 32, jlo, q, h);
    }
#undef ATT_KROW
#undef ATT_TB
    f32x4 gvv[2][4];
    { const float* gain = (ISB ? T.onb : T.ona) + w * 64 + 4 * h;
#pragma unroll
      for (int db = 0; db < 2; ++db)
#pragma unroll
          for (int g = 0; g < 4; ++g) gvv[db][g] = *(const f32x4*)(gain + 32 * db + 8 * g); }
    float inv[2];
    LAS float* amx = ssx + 16896;
#pragma unroll
    for (int qb = 0; qb < 2; ++qb) { float lt = l[qb] + __shfl_xor(l[qb], 32); if (ISB) lt += sinkexp; inv[qb] = __builtin_amdgcn_rcpf(lt);
        float ss = 0.f, am = 0.f;
#pragma unroll
        for (int db = 0; db < 2; ++db)
#pragma unroll
            for (int rg = 0; rg < 16; ++rg) { const float o = O[qb][db][rg] * inv[qb]; ss += o * o; const float og = o * gvv[db][rg >> 2][rg & 3]; O[qb][db][rg] = og; am = fmaxf(am, fabsf(og)); }
        ss += __shfl_xor(ss, 32); am = fmaxf(am, __shfl_xor(am, 32));
        if (h == 0) { ssx[(32 * qb + q) * 8 + w] = ss; amx[(32 * qb + q) * 8 + w] = am; } }
    LDS_WAIT(); __syncthreads();
    unsigned char* Mp = T.MIX + (size_t)(t0 + q) * DM + (ISB ? 512 : 0) + w * 64 + 8 * h;
#pragma unroll
    for (int qb = 0; qb < 2; ++qb) {
        const f32x4 s0 = *(const LAS f32x4*)(ssx + (32 * qb + q) * 8), s1 = *(const LAS f32x4*)(ssx + (32 * qb + q) * 8 + 4);
        const f32x4 a0 = *(const LAS f32x4*)(amx + (32 * qb + q) * 8), a1 = *(const LAS f32x4*)(amx + (32 * qb + q) * 8 + 4);
        const float tot = ((s0[0] + s0[1]) + (s0[2] + s0[3])) + ((s1[0] + s1[1]) + (s1[2] + s1[3]));
        const float amax = fmaxf(fmaxf(fmaxf(a0[0], a0[1]), fmaxf(a0[2], a0[3])), fmaxf(fmaxf(a1[0], a1[1]), fmaxf(a1[2], a1[3])));
        const float rn = __builtin_amdgcn_rsqf(tot * (1.0f / 512.0f) + EPS);
        const float qs = amax > 0.f ? 127.0f / amax : 0.f;
        if (w == 0 && h == 0) (ISB ? T.SMB : T.SMA)[t0 + 32 * qb + q] = amax > 0.f ? amax * rn * (1.0f / 127.0f) : 1.0f;
#pragma unroll
        for (int db = 0; db < 2; ++db)
#pragma unroll
            for (int gp = 0; gp < 2; ++gp) {
                const unsigned a = q8x4(O[qb][db][8 * gp + 0], O[qb][db][8 * gp + 1], O[qb][db][8 * gp + 2], O[qb][db][8 * gp + 3], qs), b = q8x4(O[qb][db][8 * gp + 4], O[qb][db][8 * gp + 5], O[qb][db][8 * gp + 6], O[qb][db][8 * gp + 7], qs);
                const u32x2 r = __builtin_amdgcn_permlane32_swap(a, b, false, false);
                *(u32x2*)(Mp + (size_t)(32 * qb) * DM + 32 * db + 16 * gp) = r; }
    }
    LDS_WAIT(); __syncthreads();
}
__device__ __forceinline__ f32x16 attn_qk_r(const bf16x8 (&kf)[4], const bf16x8 (&qf)[4], f32x16 S) {
#pragma unroll
    for (int s = 0; s < 4; ++s) S = __builtin_amdgcn_mfma_f32_32x32x16_bf16(kf[s], qf[s], S, 0, 0, 0);
    return S;
}
template <int I> struct AWin { static constexpr int W0 = I == 0 ? 0 : (I == 1 ? 8 : (I == 2 ? 24 : 32)); };
__device__ __forceinline__ void attn_a_load_k(bf16x8 (&kf)[4], const bf16* kp) {
#pragma unroll
    for (int s = 0; s < 4; ++s) kf[s] = *(const bf16x8*)(kp + 512 * s);
}
template <int I>
__device__ __forceinline__ void attn_a_load_v(bf16x8 (&vf)[2][2], const bf16* vp) {
    constexpr int W0 = AWin<I>::W0;
#pragma unroll
    for (int db = 0; db < 2; ++db)
#pragma unroll
        for (int s = 0; s < 2; ++s) {
            constexpr int dummy = 0; (void)dummy;
            const int c0 = W0 + 16 * s, c1 = W0 + 16 * s + 8;
            const s16x4 lo = *(const s16x4*)(vp + (c0 >> 5) * 2048 + (2 * db + ((c0 & 31) >> 4)) * 512 + (((c0 & 31) >> 3) & 1) * 4);
            const s16x4 hi = *(const s16x4*)(vp + (c1 >> 5) * 2048 + (2 * db + ((c1 & 31) >> 4)) * 512 + (((c1 & 31) >> 3) & 1) * 4);
            vf[db][s] = (bf16x8){lo[0], lo[1], lo[2], lo[3], hi[0], hi[1], hi[2], hi[3]}; }
}
__device__ __forceinline__ void attn_a_step(f32x16 (&O)[2], float& l, const bf16x8 (&kf)[4], const bf16x8 (&vf)[2][2], const bf16x8 (&qf)[4], const f32x16& C, const f32x16& Bv) {
    const f32x16 S = attn_qk_r(kf, qf, C);
    float ls0 = 0.f, ls1 = 0.f;
#pragma unroll
    for (int s2 = 0; s2 < 2; ++s2) {
        float p[8];
#pragma unroll
        for (int j = 0; j < 8; ++j) p[j] = __builtin_amdgcn_exp2f(S[8 * s2 + j] + Bv[8 * s2 + j]);
        ls0 += (p[0] + p[1]) + (p[2] + p[3]); ls1 += (p[4] + p[5]) + (p[6] + p[7]);
        attn_pv_half(O, p, vf, s2);
    }
    l += ls0 + ls1;
    __builtin_amdgcn_sched_barrier(0);
}
template <int I>
__device__ __forceinline__ void attn_a_block(Frame& F, const AttnPtrs& T, int t0, int sb, int r0, int rows, const LAS float* tabA4, const LAS float* tabM4, LAS float* ssx) {
    constexpr int W0 = AWin<I>::W0; constexpr int NT = MPAD / 32;
    const int lane = fresh_lane(), w = F.wave, n = lane & 31, h = lane >> 5;
    const int qrow = r0 + (n >> 4), qcol = 16 * I + (n & 15), tq = 64 * (n >> 4) + qcol;
    int rsq = qrow - 4; rsq = rsq < 0 ? 0 : (rsq > rows - 8 ? rows - 8 : rsq);
    int rs0 = r0 - 4; rs0 = rs0 < 0 ? 0 : (rs0 > rows - 8 ? rows - 8 : rs0);
    int rs1 = r0 - 3; rs1 = rs1 < 0 ? 0 : (rs1 > rows - 8 ? rows - 8 : rs1);
    const int nk = rs1 + 8 - rs0;
    int cs = qcol - 8; cs = cs < 0 ? 0 : (cs > 48 ? 48 : cs);
    const int imv = 63 + W0 + 4 * h - cs;
    const int ibb = 63 + W0 + 4 * h - qcol - 32 * qrow + 32 * 7;
    const int colk = W0 + n;
    const bf16* Kp = T.KA + (size_t)w * NT * 2048 + (size_t)(colk >> 5) * 2048 + (32 * h + (colk & 31)) * 8;
    const bf16* Vp = T.VAT + (size_t)w * NT * 2048 + (32 * h + n) * 8;
    const bf16* Qp = T.QA + ((size_t)w * NT + ((t0 + tq) >> 5)) * 2048 + (32 * h + ((t0 + tq) & 31)) * 8;
    bf16x8 kfX[4], kfY[4], vfX[2][2], vfY[2][2], qf[4];
    attn_load_k(kfX, T.KA + (size_t)w * NT * 2048 + (size_t)(MTOK >> 5) * 2048 + lane * 8); attn_load_v(vfX, T.VAT + (size_t)w * NT * 2048 + (size_t)(MTOK >> 5) * 2048 + lane * 8);
    { const size_t to = (size_t)((sb + 64 * rs0) >> 5) * 2048; attn_a_load_k(kfY, Kp + to); attn_a_load_v<I>(vfY, Vp + to); }
#pragma unroll
    for (int s = 0; s < 4; ++s) qf[s] = __builtin_nontemporal_load((const bf16x8*)(Qp + 512 * s));
    f32x16 O[2]; O[0] = (f32x16){}; O[1] = (f32x16){}; float l = 0.f;
    f32x16 Cc = attn_tab16(tabM4, TM_CS, ((unsigned)(rs0 - rsq) < 8u) ? imv : 96), Bc = attn_tab16(tabA4, TA_CS, ibb + 32 * rs0);
    { const f32x16 S = attn_qk_r(kfX, qf, (f32x16){}); float p[8], ls = 0.f;
#pragma unroll
      for (int r = 0; r < 8; ++r) { p[r] = __builtin_amdgcn_exp2f(S[r]); ls += p[r]; }
      l += ls; attn_pv_half(O, p, vfX, 0);
      __builtin_amdgcn_sched_barrier(0); }
#pragma unroll 1
    for (int k = 0; k + 1 < nk; k += 2) {
        { const int kr = rs0 + k + 1; const size_t to = (size_t)((sb + 64 * kr) >> 5) * 2048; attn_a_load_k(kfX, Kp + to); attn_a_load_v<I>(vfX, Vp + to); }
        const f32x16 Cn = attn_tab16(tabM4, TM_CS, ((unsigned)(rs0 + k + 1 - rsq) < 8u) ? imv : 96), Bn = attn_tab16(tabA4, TA_CS, ibb + 32 * (rs0 + k + 1));
        attn_a_step(O, l, kfY, vfY, qf, Cc, Bc);
        { const int kn = k + 2 < nk ? k + 2 : nk - 1; const int kr = rs0 + kn; const size_t to = (size_t)((sb + 64 * kr) >> 5) * 2048; attn_a_load_k(kfY, Kp + to); attn_a_load_v<I>(vfY, Vp + to);
          Cc = attn_tab16(tabM4, TM_CS, ((unsigned)(kr - rsq) < 8u) ? imv : 96); Bc = attn_tab16(tabA4, TA_CS, ibb + 32 * kr); }
        attn_a_step(O, l, kfX, vfX, qf, Cn, Bn);
    }
    if (nk & 1) attn_a_step(O, l, kfY, vfY, qf, Cc, Bc);
    f32x4 gvv[2][4];
    { const float* gain = T.ona + w * 64 + 4 * h;
#pragma unroll
      for (int db = 0; db < 2; ++db)
#pragma unroll
          for (int g = 0; g < 4; ++g) gvv[db][g] = *(const f32x4*)(gain + 32 * db + 8 * g); }
    { const float lt = l + __shfl_xor(l, 32); const float inv = __builtin_amdgcn_rcpf(lt);
      float ss = 0.f, am = 0.f;
#pragma unroll
      for (int db = 0; db < 2; ++db)
#pragma unroll
          for (int rg = 0; rg < 16; ++rg) { const float o = O[db][rg] * inv; ss += o * o; const float og = o * gvv[db][rg >> 2][rg & 3]; O[db][rg] = og; am = fmaxf(am, fabsf(og)); }
      ss += __shfl_xor(ss, 32); am = fmaxf(am, __shfl_xor(am, 32));
      if (h == 0) { ssx[n * 8 + w] = ss; (ssx + 16896)[n * 8 + w] = am; } }
    LDS_WAIT(); __syncthreads();
    { unsigned char* Mp = T.MIX + (size_t)(t0 + tq) * DM + w * 64 + 8 * h;
      const LAS float* amx = ssx + 16896;
      const f32x4 s0 = *(const LAS f32x4*)(ssx + n * 8), s1 = *(const LAS f32x4*)(ssx + n * 8 + 4);
      const f32x4 a0 = *(const LAS f32x4*)(amx + n * 8), a1 = *(const LAS f32x4*)(amx + n * 8 + 4);
      const float tot = ((s0[0] + s0[1]) + (s0[2] + s0[3])) + ((s1[0] + s1[1]) + (s1[2] + s1[3]));
      const float amax = fmaxf(fmaxf(fmaxf(a0[0], a0[1]), fmaxf(a0[2], a0[3])), fmaxf(fmaxf(a1[0], a1[1]), fmaxf(a1[2], a1[3])));
      const float rn = __builtin_amdgcn_rsqf(tot * (1.0f / 512.0f) + EPS);
      const float qs = amax > 0.f ? 127.0f / amax : 0.f;
      if (w == 0 && h == 0) T.SMA[t0 + tq] = amax > 0.f ? amax * rn * (1.0f / 127.0f) : 1.0f;
#pragma unroll
      for (int db = 0; db < 2; ++db)
#pragma unroll
          for (int gp = 0; gp < 2; ++gp) {
              const unsigned a = q8x4(O[db][8 * gp + 0], O[db][8 * gp + 1], O[db][8 * gp + 2], O[db][8 * gp + 3], qs), b = q8x4(O[db][8 * gp + 4], O[db][8 * gp + 5], O[db][8 * gp + 6], O[db][8 * gp + 7], qs);
              const u32x2 r = __builtin_amdgcn_permlane32_swap(a, b, false, false);
              *(u32x2*)(Mp + 32 * db + 16 * gp) = r; } }
    LDS_WAIT(); __syncthreads();
}
__device__ __forceinline__ void attn_a_unit(Frame& F, const AttnPtrs& T, int t0, const LAS float* tabA4, const LAS float* tabM4, LAS float* ssx) {
    int sb, N; if (t0 < 16384) { sb = t0 & ~8191; N = 8192; } else { sb = 16384 + ((t0 - 16384) & ~4095); N = 4096; }
    const int r0 = (t0 - sb) >> 6, rows = N >> 6;
    attn_a_block<0>(F, T, t0, sb, r0, rows, tabA4, tabM4, ssx);
    attn_a_block<1>(F, T, t0, sb, r0, rows, tabA4, tabM4, ssx);
    attn_a_block<2>(F, T, t0, sb, r0, rows, tabA4, tabM4, ssx);
    attn_a_block<3>(F, T, t0, sb, r0, rows, tabA4, tabM4, ssx);
}
__device__ __forceinline__ void attn_phase(Frame& F, const AttnPtrs& T, const float* rpb, const float* t5, const float* sink, int pan0, int pan1, int rank, int nloc) {
    const int lane = fresh_lane(), w = F.wave;
    LAS float* tabAB = (LAS float*)(F.lds + RING_OFF + w * 10240);
    LAS float* tabM = (LAS float*)(F.lds + RING_OFF + 81920);
    LAS float* ssx = (LAS float*)(F.lds + RING_OFF + 84480);
    LAS bf16x8* qlds = (LAS bf16x8*)(F.lds + RING_OFF + 86528 + w * 8192);
    for (int i = lane; i < 4 * TA_CS; i += 64) tabAB[i] = 0.f;
#pragma unroll
    for (int k = 0; k < 8; ++k) { int i = lane + 64 * k; i = i < 465 ? i : 464; const int dr = i / 31, dc = i - 31 * dr; const float v = rpb[w * 465 + i] * LOG2E; const int pos = 48 + 32 * dr + dc;
#pragma unroll
        for (int a = 0; a < 4; ++a) tabAB[a * TA_CS + pos - a] = v; }
    if (w == 0) for (int i = lane; i < TM_CS; i += 64) { const float v = (i >= 63 && i < 79) ? 0.f : -INFINITY;
#pragma unroll
        for (int a = 0; a < 4; ++a) if (i - a >= 0) tabM[a * TM_CS + i - a] = v; }
    const float sinkexp = __builtin_amdgcn_exp2f(sink[w] * LOG2E);
    LDS_WAIT(); __syncthreads();
#pragma unroll 1
    for (int u = 2 * pan0 + rank; u < 2 * pan1; u += nloc) attn_a_unit(F, T, u * 128, tabAB, tabM, ssx);
#pragma unroll
    for (int k = 0; k < 6; ++k) { int i = lane + 64 * k; i = i < TB_CS ? i : TB_CS - 1; const int rel = i - 160; int n = rel < 0 ? -rel : rel; const bool ok = n <= 128; n = ok ? n : 128;
        const int lg = n < 8 ? n : (33 - __clz(n * n)); const int bk = (rel > 0 ? 16 : 0) + (lg > 15 ? 15 : lg); float v = t5[bk * 8 + w] * LOG2E; v = ok ? v : -INFINITY;
#pragma unroll
        for (int a = 0; a < 4; ++a) if (i - a >= 0) tabAB[a * TB_CS + i - a] = v; }
    LDS_WAIT(); asm volatile("" ::: "memory");
#pragma unroll 1
    for (int u = 4 * pan0 + rank; u < 4 * pan1; u += nloc) attn_unit<true>(F, T, u * 64, tabAB, tabM, sinkexp, ssx, qlds);
}
template <bool NORM>
__device__ __forceinline__ void quant_rows(const bf16* src, signed char* dstq, float* scl, int nrows, int worker, int nworkers) {
    const int lane = threadIdx.x & 63;
    for (int m0 = worker; m0 < nrows; m0 += 4 * nworkers) {
        v4u v[4][2];
#pragma unroll
        for (int b = 0; b < 4; ++b) { int m = m0 + b * nworkers; m = m < nrows ? m : nrows - 1; const bf16* sp = src + (size_t)m * DM;
            v[b][0] = *(const GAS v4u*)(sp + lane * 16); v[b][1] = *(const GAS v4u*)(sp + lane * 16 + 8); }
#pragma unroll
        for (int b = 0; b < 4; ++b) { const int m = m0 + b * nworkers; if (m >= nrows) continue;
            float x[16];
#pragma unroll
            for (int k = 0; k < 2; ++k) { const v4u w = v[b][k];
                x[8 * k + 0] = __uint_as_float(w.x << 16); x[8 * k + 1] = __uint_as_float(w.x & 0xffff0000u); x[8 * k + 2] = __uint_as_float(w.y << 16); x[8 * k + 3] = __uint_as_float(w.y & 0xffff0000u);
                x[8 * k + 4] = __uint_as_float(w.z << 16); x[8 * k + 5] = __uint_as_float(w.z & 0xffff0000u); x[8 * k + 6] = __uint_as_float(w.w << 16); x[8 * k + 7] = __uint_as_float(w.w & 0xffff0000u); }
            float am = 0.f, ss = 0.f;
#pragma unroll
            for (int i = 0; i < 16; ++i) { am = fmaxf(am, fabsf(x[i])); ss += x[i] * x[i]; }
#pragma unroll
            for (int o = 1; o < 64; o <<= 1) { am = fmaxf(am, __shfl_xor(am, o)); if (NORM) ss += __shfl_xor(ss, o); }
            const float sc = am > 0.f ? am * (1.0f / 127.0f) : 1.0f, qs = am > 0.f ? 127.0f / am : 0.f;
            v4u q; q.x = q8x4(x[0], x[1], x[2], x[3], qs); q.y = q8x4(x[4], x[5], x[6], x[7], qs); q.z = q8x4(x[8], x[9], x[10], x[11], qs); q.w = q8x4(x[12], x[13], x[14], x[15], qs);
            *(GAS v4u*)(dstq + (size_t)m * DM + lane * 16) = q;
            if (lane == 0) scl[m] = NORM ? sc * __builtin_amdgcn_rsqf(ss * (1.0f / 1024.0f) + EPS) : sc;
        }
    }
}
#ifndef PROBE_PHASE
#define PROBE_PHASE -1
#endif
#ifndef MK_N_LAUNCHES
#define MK_N_LAUNCHES 1
#endif
constexpr int N_LAUNCHES = MK_N_LAUNCHES;
constexpr int PER_PHASE = 7;
struct Args { const float* in[19]; float* out; unsigned char* ws; int ph_lo, ph_hi, li, pad; };
__global__ void __launch_bounds__(NWAVES * 64, 2) hybrid_fwd(Args args_by_value) {
    __shared__ __attribute__((aligned(16))) unsigned char lds[LDS_BYTES];
    typedef const __attribute__((address_space(4))) Args* KArgs;
#define ENV() KArgs ap_ = (KArgs)__builtin_amdgcn_kernarg_segment_ptr(); asm volatile("" : "+s"(ap_)); \
    unsigned char* ws = ap_->ws; unsigned char* dout = (unsigned char*)ap_->out; \
    Frame F; F.lds = (LAS unsigned char*)lds; F.MISC = (volatile LAS unsigned*)(F.lds + MISC_OFF); F.wave = __builtin_amdgcn_readfirstlane((int)threadIdx.x >> 6); \
    F.G = gridDim.x; { const int bx = blockIdx.x; F.vcu = (F.G % 8 == 0) ? (bx % 8) * (F.G / 8) + bx / 8 : bx; } F.ctl = (gu32*)(ws + WS_CTL); \
    XcdBarrier bar; bar.bar = (unsigned*)(F.ctl + CW_BAR) + ap_->li * XCD_BAR_WORDS; bar.x = xb_xcc_id(); bar.st = F.MISC + 8; (void)dout; (void)bar
#define AIN(k) ((const float*)ap_->in[k])
    (void)args_by_value;
    int lo, hi;
    { ENV(); lo = ap_->ph_lo; hi = ap_->ph_hi;
      for (int u = threadIdx.x; u < (LDS_BYTES - LDSCTL_OFF) / 4; u += NWAVES * 64) ((LAS unsigned*)(F.lds + LDSCTL_OFF))[u] = 0u;
      __syncthreads();
      if (N_LAUNCHES != PER_PHASE) (void)xcd_barrier_post((unsigned*)(F.ctl + CW_BAR) + ap_->li * XCD_BAR_WORDS, F.MISC + 8); }
#define GRID_BAR() do { if (N_LAUNCHES != PER_PHASE) xcd_barrier(bar); } while (0)
#define LOCAL_BAR() do { if (N_LAUNCHES != PER_PHASE) xcd_local_barrier(bar); } while (0)
#ifndef PH_MASK
#define PH_MASK 127
#endif
#define IN(k) (((PH_MASK >> (k)) & 1) && lo <= (k) && (k) < hi)
#define BOTH(k) (IN(k) && IN((k) + 1))
#define P1_RAGGED() const int p1_units = (MPAD / 256) * (NIN / 256), p1_last = (p1_units - 1) / (int)gridDim.x, p1_busy = p1_units - p1_last * (int)gridDim.x, p1_idle = (int)gridDim.x - p1_busy; const bool defer_w = p1_idle >= 64
    if (IN(0)) { ENV(); P1_RAGGED(); p0_prologue(F, AIN(0), AIN(1), AIN(2), AIN(4), AIN(5), AIN(14), AIN(15), AIN(16), AIN(17), AIN(18),
            (bf16*)(ws + WS_WIN), (signed char*)(ws + WS_WOQ), (float*)(ws + WS_SWO), (signed char*)(ws + WS_WGQ), (float*)(ws + WS_SW), (bf16*)(ws + WS_WDN), (bf16*)(ws + WS_XN), (float*)(ws + WS_R1), defer_w); if (BOTH(0)) GRID_BAR(); }
    if (IN(1)) { ENV();
        pg8::Gemm g{(bf16*)(ws + WS_XN), (bf16*)(ws + WS_WIN), MPAD, NIN, DM}; pg8::StaticOrder S; S.init(MPAD, NIN, F.G, (int)blockIdx.x);
        pg8::EpiQKV E{ws, (PG8_LAS unsigned char*)(F.lds + RING_OFF + RING_BYTES), AIN(6), AIN(7), AIN(9), AIN(10), WS_QA, WS_KA, WS_VAT, WS_QB, WS_KB, WS_VBT, WS_R1};
        pg8::gemm_phase<pg8::EpiQKV, pg8::StaticOrder, true, true>(F.lds + RING_OFF, g, S, E);
    }
    if (IN(1)) { ENV();
        P1_RAGGED();
        if (defer_w && (int)blockIdx.x >= p1_busy) {
            p0_weight_tasks(F, AIN(14), AIN(15), AIN(16), AIN(17), (signed char*)(ws + WS_WOQ), (float*)(ws + WS_SWO), (signed char*)(ws + WS_WGQ), (float*)(ws + WS_SW), (int)blockIdx.x - p1_busy, p1_idle);
            p0_weight_items(F, AIN(4), AIN(5), AIN(18), (bf16*)(ws + WS_WIN), (bf16*)(ws + WS_WDN),
                            (LAS float*)(F.lds + RING_OFF + F.wave * 16384), P0_I_IN, P0_NITEMS, ((int)blockIdx.x - p1_busy) * NWAVES + F.wave, p1_idle * NWAVES);
        }
        if (BOTH(1)) GRID_BAR();
    }
    if (IN(2)) { ENV(); const AttnPtrs T{(bf16*)(ws + WS_QA), (bf16*)(ws + WS_KA), (bf16*)(ws + WS_VAT), (bf16*)(ws + WS_QB), (bf16*)(ws + WS_KB), (bf16*)(ws + WS_VBT), ws + WS_MIX, (float*)(ws + WS_SMA), (float*)(ws + WS_SMB), AIN(12), AIN(13)};
        const XcdEnv xe = xcd_env(bar); const int nM = MTOK / 256;
        attn_phase(F, T, AIN(8), AIN(3), AIN(11), (int)((long)xe.xi * nM / xe.nx), (int)((long)(xe.xi + 1) * nM / xe.nx), xe.rank, xe.nloc); if (BOTH(2)) LOCAL_BAR(); }
    if (IN(3)) { ENV(); const XcdEnv xe = xcd_env(bar);
        pg8::Gemm g{(bf16*)(ws + WS_MIX), (bf16*)(ws + WS_WOQ), MTOK, DM, DM / 2}; pg8::XcdOrder S; S.init(MTOK, DM, xe.nloc, xe.rank, xe.nx, xe.xi);
        pg8::EpiOut E{(bf16*)(ws + WS_XN), (bf16*)(ws + WS_X1B), (const float*)(ws + WS_SMA), (const float*)(ws + WS_SMB), (const float*)(ws + WS_SWO)};
        pg8::gemm_phase<pg8::EpiOut, pg8::XcdOrder, true, true>(F.lds + RING_OFF, g, S, E);
        if (BOTH(3)) LOCAL_BAR();
    }
    if (IN(4)) { ENV(); const XcdEnv xe = xcd_env(bar);
        const int nM = MTOK / 256, r0 = (int)((long)xe.xi * nM / xe.nx) * 256, r1 = (int)((long)(xe.xi + 1) * nM / xe.nx) * 256;
        quant_rows<true>((const bf16*)(ws + WS_X1B) + (size_t)r0 * DM, (signed char*)(ws + WS_X1Q) + (size_t)r0 * DM, (float*)(ws + WS_SX) + r0, r1 - r0, xe.rank * NWAVES + F.wave, xe.nloc * NWAVES);
        if (BOTH(4)) LOCAL_BAR(); }
    if (IN(5)) { ENV(); const XcdEnv xe = xcd_env(bar);
        pg8::Gemm g{(bf16*)(ws + WS_X1Q), (bf16*)(ws + WS_WGQ), MTOK, NGU, DM / 2}; pg8::XcdOrder S; S.init(MTOK, NGU, xe.nloc, xe.rank, xe.nx, xe.xi);
        pg8::EpiGU E{nullptr, (const float*)(ws + WS_SX), (const float*)(ws + WS_SW), (bf16*)(ws + WS_H)};
        pg8::gemm_phase<pg8::EpiGU, pg8::XcdOrder, true, true>(F.lds + RING_OFF, g, S, E);
        if (BOTH(5)) LOCAL_BAR();
    }
    if (IN(6)) { ENV(); const XcdEnv xe = xcd_env(bar);
        pg8::Gemm g{(bf16*)(ws + WS_H), (bf16*)(ws + WS_WDN), MTOK, DM, DFF}; pg8::XcdOrder S; S.init(MTOK, DM, xe.nloc, xe.rank, xe.nx, xe.xi);
        pg8::EpiDown E{(bf16*)(ws + WS_X1B), (float*)ap_->out};
        pg8::gemm_phase<pg8::EpiDown, pg8::XcdOrder, true, true>(F.lds + RING_OFF, g, S, E);
    }
#undef IN
#undef BOTH
}

extern "C" void kernel_launch(void* const* d_in, const int* in_sizes, int n_in, void* d_out, int out_size, void* d_ws, size_t ws_size, hipStream_t stream) {
    static int grid = 0;
    if (grid == 0) {
        if (n_in != 19 || out_size != MTOK * DM || ws_size < WS_END) { fprintf(stderr, "kernel_launch: unexpected shapes: n_in %d out %d ws %zu; nothing launched\n", n_in, out_size, ws_size); grid = -1; return; }
        int dev = 0, cus = 0;
        if (hipGetDevice(&dev) != hipSuccess || hipDeviceGetAttribute(&cus, hipDeviceAttributeMultiprocessorCount, dev) != hipSuccess) { grid = -1; return; }
        (void)hipGetLastError();
        grid = cus;
    }
    if (grid < 0) return;
    if (hipMemsetAsync((char*)d_ws + WS_CTL, 0, CTL_ZERO_BYTES, stream) != hipSuccess) { fprintf(stderr, "kernel_launch: memset failed\n"); return; }
    Args a{};
    for (int i = 0; i < 19; ++i) a.in[i] = (const float*)d_in[i];
    a.out = (float*)d_out; a.ws = (unsigned char*)d_ws;
#if PROBE_PHASE >= 0
    const int nl = 2; const int los[2] = {0, PROBE_PHASE}, his[2] = {PROBE_PHASE + 1, PER_PHASE};
#else
    const int nl = N_LAUNCHES;
#endif
    for (int li = 0; li < nl; ++li) {
#if PROBE_PHASE >= 0
        a.ph_lo = los[li]; a.ph_hi = his[li]; a.li = li;
#else
        a.ph_lo = (N_LAUNCHES == PER_PHASE) ? li : 0; a.ph_hi = (N_LAUNCHES == PER_PHASE) ? li + 1 : PER_PHASE; a.li = 0;
#endif
        hipLaunchKernelGGL(hybrid_fwd, dim3(grid), dim3(NWAVES * 64), 0, stream, a);
        const hipError_t le = hipPeekAtLastError();
        if (le != hipSuccess) { fprintf(stderr, "kernel_launch: launch %d failed: %s\n", li, hipGetErrorName(le)); break; }
    }
}
```

```cpp
#include <hip/hip_runtime.h>
#include <cstdio>
#include <cstdint>
namespace pg8 {
#define PG8_LAS __attribute__((address_space(3)))
typedef unsigned short bf16_t;
typedef short bf16x8 __attribute__((ext_vector_type(8)));
typedef float f32x4 __attribute__((ext_vector_type(4)));
typedef unsigned u32x4 __attribute__((ext_vector_type(4)));
typedef int i32x4 __attribute__((ext_vector_type(4)));
constexpr int BM = 256, BK = 64, HALF = 128, HTB = HALF * BK * 2  , STAGE_BYTES = 8 * HTB, NXCD = 8, WGM = 8;

__host__ __device__ __forceinline__ int lds_byte(int r, int c) { const int st = (r >> 4) * 2 + (c >> 5), rr = r & 15, cc = c & 31, ob = rr * 64 + cc * 2; return st * 1024 + (ob ^ (((ob >> 9) & 1) << 5)); }
__host__ __device__ __forceinline__ void stage_rc(int b, int& R, int& C) { const int st = b / 1024, sb = b % 1024, swz = sb ^ (((sb >> 9) & 1) << 5); R = (st >> 1) * 16 + swz / 64; C = (st & 1) * 32 + (swz % 64) / 2; }
__host__ __device__ __forceinline__ int perm32(int rho) { const int n = rho >> 4, i = rho & 15; return 8 * (i >> 2) + 4 * n + (i & 3); }

struct Unit { int pm, pn; };
struct Gemm { const bf16_t* A; const bf16_t* Bt; int M, N, K; };

struct StaticOrder {
    int nM, nN, nwg, G, c;
    __host__ __device__ void init(int M, int N, int G_, int c_) { nM = M / BM; nN = N / BM; nwg = nM * nN; G = G_; c = c_; }
    __host__ __device__ bool next(int i, Unit& u) const {
        const long L = (long)i * G + c; if (L >= nwg) return false;
        int wgid = (int)L; { const int q = nwg / NXCD, r = nwg % NXCD, xcd = wgid % NXCD, off = wgid / NXCD; wgid = (xcd < r ? xcd * (q + 1) : r * (q + 1) + (xcd - r) * q) + off; }
        const int nig = WGM * nN, gid = wgid / nig, fm = gid * WGM, gsz = (nM - fm) < WGM ? (nM - fm) : WGM;
        u.pm = fm + ((wgid % nig) % gsz); u.pn = (wgid % nig) / gsz; return true;
    }
    __device__ __forceinline__ void a_ready(const Unit&) const {}
    __device__ __forceinline__ void done(const Unit&) const {}
};

struct XcdOrder {
    int nN, p0, cnt, nloc, rank;
    __host__ __device__ void init(int M, int N, int nloc_, int rank_, int nx, int xi) { const int nM = M / BM; nN = N / BM; p0 = (int)((long)xi * nM / nx); const int p1 = (int)((long)(xi + 1) * nM / nx); cnt = (p1 - p0) * nN; nloc = nloc_; rank = rank_; }
    __host__ __device__ bool next(int i, Unit& u) const {
        const long L = (long)i * nloc + rank; if (L >= cnt) return false;
        const int w = (int)L, np = cnt / nN, nig = WGM * nN, gid = w / nig, fm = gid * WGM, gsz = (np - fm) < WGM ? (np - fm) : WGM;
        u.pm = p0 + fm + ((w % nig) % gsz); u.pn = (w % nig) / gsz; return true;
    }
    __device__ __forceinline__ void a_ready(const Unit&) const {}
    __device__ __forceinline__ void done(const Unit&) const {}
};
struct RevOrder {
    StaticOrder s;
    __host__ __device__ void init(int M, int N, int G_, int c_) { s.init(M, N, G_, c_); }
    __host__ __device__ bool next(int i, Unit& u) const { const bool r = s.next(i, u); u.pm = s.nM - 1 - u.pm; return r; }
    __device__ __forceinline__ void a_ready(const Unit&) const {}
    __device__ __forceinline__ void done(const Unit&) const {}
};

typedef float f32x2_t __attribute__((ext_vector_type(2))); typedef __bf16 bf16x2_t __attribute__((ext_vector_type(2)));
__device__ __forceinline__ unsigned cvt_pk_bf16(float lo, float hi) { f32x2_t v = {lo, hi}; bf16x2_t b = __builtin_convertvector(v, bf16x2_t); return __builtin_bit_cast(unsigned, b); }
constexpr int MP_ROWS = 33024;
constexpr float RMS_EPS = 1e-6f;
constexpr float QSCALE = 0.125f * 1.4426950408889634f;

struct EpiQKV {
    typedef f32x4 acc_t;
    static constexpr bool PERM = true, AFTER_DRAIN = false, MIDK = false;
    unsigned char* ws; PG8_LAS unsigned char* vtl; const float *qna, *kna, *qnb, *knb;
    size_t oQA, oKA, oVAt, oQB, oKB, oVBt, oR1;
    __device__ __forceinline__ void operator()(const f32x4 (&acc)[2][2][4][2], const Unit& u, int wr, int wc, int fr, int fq) const {
        constexpr int NT = MP_ROWS / 32;
        const int pn = u.pn, row0 = u.pm * BM + wr * 64 + fr, sec = pn >> 1;
        bf16_t* dst; int head = 4 * (pn & 1) + wc; const float* gain = nullptr; float sc = 1.f; bool isV = false;
        const float* R1 = (const float*)(ws + oR1);
        if (sec == 0) { dst = (bf16_t*)(ws + oQA); gain = qna; sc = QSCALE; }
        else if (sec == 1) { dst = (bf16_t*)(ws + oKA); gain = kna; }
        else if (sec == 2) { dst = (bf16_t*)(ws + oVAt); isV = true; }
        else if (sec == 3) { dst = (bf16_t*)(ws + oQB); gain = qnb; sc = QSCALE; }
        else { if (wc < 2) { dst = (bf16_t*)(ws + oKB); head = wc; gain = knb; } else { dst = (bf16_t*)(ws + oVBt); head = wc - 2; isV = true; } }
        bf16_t* hbase = dst + (size_t)head * NT * 2048;
#define EPI_R1V() float r1v[2][4]; _Pragma("unroll") for (int ai = 0; ai < 2; ++ai) _Pragma("unroll") for (int m = 0; m < 4; ++m) r1v[ai][m] = R1[row0 + ai * HALF + m * 16]
        if (!isV) {
            EPI_R1V();
            f32x4 gv[2][2];
#pragma unroll
            for (int bj = 0; bj < 2; ++bj)
#pragma unroll
                for (int n = 0; n < 2; ++n) gv[bj][n] = *(const f32x4*)(gain + 32 * bj + 8 * fq + 4 * n) * sc;
#pragma unroll
            for (int ai = 0; ai < 2; ++ai)
#pragma unroll
                for (int m = 0; m < 4; ++m) {
                    float ss = 0.f;
#pragma unroll
                    for (int bj = 0; bj < 2; ++bj)
#pragma unroll
                        for (int n = 0; n < 2; ++n) { const f32x4 x = acc[ai][bj][m][n]; ss += (x[0] * x[0] + x[1] * x[1]) + (x[2] * x[2] + x[3] * x[3]); }
                    ss += __shfl_xor(ss, 16); ss += __shfl_xor(ss, 32);
                    const int row = row0 + ai * HALF + m * 16;
                    const float r1 = r1v[ai][m];
                    const float r = r1 * __builtin_amdgcn_rsqf(ss * (r1 * r1) * (1.0f / 64.0f) + RMS_EPS);
                    bf16_t* rowp = hbase + (size_t)(row >> 5) * 2048 + (fq >> 1) * 512 + ((fq & 1) * 32 + (row & 31)) * 8;
#pragma unroll
                    for (int bj = 0; bj < 2; ++bj) { const f32x4 v0 = acc[ai][bj][m][0] * r * gv[bj][0], v1 = acc[ai][bj][m][1] * r * gv[bj][1];
                        u32x4 w; w.x = cvt_pk_bf16(v0[0], v0[1]); w.y = cvt_pk_bf16(v0[2], v0[3]); w.z = cvt_pk_bf16(v1[0], v1[1]); w.w = cvt_pk_bf16(v1[2], v1[3]);
                        *(u32x4*)(rowp + bj * 1024) = w; }
                }
        } else {
            EPI_R1V();
            PG8_LAS unsigned short* vt = (PG8_LAS unsigned short*)(vtl + (wr * 4 + wc) * 2048);
            const int hh = (fr >> 2) & 1, jj = 4 * ((fr >> 3) & 1) + (fr & 3), wofs = (32 * hh + 8 * fq) * 8 + jj, ln = fq * 16 + fr;
#pragma unroll
            for (int ai = 0; ai < 2; ++ai)
#pragma unroll
                for (int m = 0; m < 4; ++m) { const int row = row0 + ai * HALF + m * 16; const float r1 = r1v[ai][m];
                    bf16_t* tb = hbase + (size_t)(row >> 5) * 2048 + (m & 1) * 512 + ln * 8;
#pragma unroll
                    for (int bj = 0; bj < 2; ++bj) { PG8_LAS unsigned short* buf = vt + bj * 512;
#pragma unroll
                        for (int n = 0; n < 2; ++n) { const f32x4 x = acc[ai][bj][m][n] * r1; const unsigned w0 = cvt_pk_bf16(x[0], x[1]), w1 = cvt_pk_bf16(x[2], x[3]);
                            buf[wofs + (4 * n + 0) * 8] = (unsigned short)(w0 & 0xffffu); buf[wofs + (4 * n + 1) * 8] = (unsigned short)(w0 >> 16);
                            buf[wofs + (4 * n + 2) * 8] = (unsigned short)(w1 & 0xffffu); buf[wofs + (4 * n + 3) * 8] = (unsigned short)(w1 >> 16); }
                        const u32x4 w = *(const PG8_LAS u32x4*)(buf + ln * 8);
                        *(u32x4*)(tb + bj * 1024) = w; }
                }
        }
    }
};
struct EpiOut {
    typedef i32x4 acc_t;
    static constexpr bool PERM = true, AFTER_DRAIN = false, MIDK = true;
    const bf16_t* XB; bf16_t* X1B; const float *SMA, *SMB, *SWO;
    __device__ __forceinline__ void pre(float (&rsc)[2][4], const Unit& u, int wr, int fr) const {
        const int row0 = u.pm * BM + wr * 64 + fr; float sa[2][4], sb[2][4];
#pragma unroll
        for (int ai = 0; ai < 2; ++ai)
#pragma unroll
            for (int m = 0; m < 4; ++m) { sa[ai][m] = SMA[row0 + ai * HALF + m * 16]; sb[ai][m] = SMB[row0 + ai * HALF + m * 16]; }
#pragma unroll
        for (int ai = 0; ai < 2; ++ai)
#pragma unroll
            for (int m = 0; m < 4; ++m) rsc[ai][m] = sa[ai][m] / sb[ai][m];
    }
    __device__ __forceinline__ void mid(i32x4 (&acc)[2][2][4][2], const float (&rsc)[2][4]) const {
#pragma unroll
        for (int ai = 0; ai < 2; ++ai)
#pragma unroll
            for (int bj = 0; bj < 2; ++bj)
#pragma unroll
                for (int m = 0; m < 4; ++m)
#pragma unroll
                    for (int n = 0; n < 2; ++n)
#pragma unroll
                        for (int i = 0; i < 4; ++i) acc[ai][bj][m][n][i] = (int)__builtin_rintf((float)acc[ai][bj][m][n][i] * rsc[ai][m]);
    }
    __device__ __forceinline__ void operator()(const i32x4 (&acc)[2][2][4][2], const Unit& u, int wr, int wc, int fr, int fq) const {
        const int row0 = u.pm * BM + wr * 64 + fr, colb = u.pn * BM + wc * 32 + 8 * fq;
        f32x4 swv[2][2];
#pragma unroll
        for (int bj = 0; bj < 2; ++bj)
#pragma unroll
            for (int n = 0; n < 2; ++n) swv[bj][n] = *(const f32x4*)(SWO + colb + bj * HALF + 4 * n);
#pragma unroll
        for (int ai = 0; ai < 2; ++ai) {
            u32x4 xb[4][2]; float sb[4];
#pragma unroll
            for (int m = 0; m < 4; ++m) { sb[m] = SMB[row0 + ai * HALF + m * 16];
#pragma unroll
                for (int bj = 0; bj < 2; ++bj) xb[m][bj] = __builtin_nontemporal_load((const u32x4*)(XB + (size_t)(row0 + ai * HALF + m * 16) * 1024 + colb + bj * HALF)); }
#pragma unroll
            for (int m = 0; m < 4; ++m) { const int row = row0 + ai * HALF + m * 16;
#pragma unroll
                for (int bj = 0; bj < 2; ++bj) { const u32x4 w = xb[m][bj];
                    f32x4 x0, x1; x0[0] = __uint_as_float(w.x << 16); x0[1] = __uint_as_float(w.x & 0xffff0000u); x0[2] = __uint_as_float(w.y << 16); x0[3] = __uint_as_float(w.y & 0xffff0000u);
                    x1[0] = __uint_as_float(w.z << 16); x1[1] = __uint_as_float(w.z & 0xffff0000u); x1[2] = __uint_as_float(w.w << 16); x1[3] = __uint_as_float(w.w & 0xffff0000u);
                    f32x4 v0, v1;
#pragma unroll
                    for (int i = 0; i < 4; ++i) { v0[i] = (float)acc[ai][bj][m][0][i] * (sb[m] * swv[bj][0][i]) + x0[i]; v1[i] = (float)acc[ai][bj][m][1][i] * (sb[m] * swv[bj][1][i]) + x1[i]; }
                    u32x4 o; o.x = cvt_pk_bf16(v0[0], v0[1]); o.y = cvt_pk_bf16(v0[2], v0[3]); o.z = cvt_pk_bf16(v1[0], v1[1]); o.w = cvt_pk_bf16(v1[2], v1[3]);
                    *(u32x4*)(X1B + (size_t)row * 1024 + colb + bj * HALF) = o; }
            }
        }
    }
};
struct EpiGU {
    typedef i32x4 acc_t;
    static constexpr bool PERM = true, AFTER_DRAIN = false, MIDK = false;
    const float *SS2, *SX, *SW; bf16_t* H;
    __device__ __forceinline__ void operator()(const i32x4 (&acc)[2][2][4][2], const Unit& u, int wr, int wc, int fr, int fq) const {
        const int row0 = u.pm * BM + wr * 64 + fr, colb = u.pn * HALF + wc * 32 + 8 * fq;
        float sx[2][4]; f32x4 swv[2][2];
#pragma unroll
        for (int ai = 0; ai < 2; ++ai)
#pragma unroll
            for (int m = 0; m < 4; ++m) sx[ai][m] = SX[row0 + ai * HALF + m * 16];
#pragma unroll
        for (int bj = 0; bj < 2; ++bj)
#pragma unroll
            for (int n = 0; n < 2; ++n) swv[bj][n] = *(const f32x4*)(SW + u.pn * BM + bj * HALF + wc * 32 + 8 * fq + 4 * n);
#pragma unroll
        for (int ai = 0; ai < 2; ++ai)
#pragma unroll
            for (int m = 0; m < 4; ++m) { const int row = row0 + ai * HALF + m * 16;
                const float r = sx[ai][m];
                float hv[8];
#pragma unroll
                for (int n = 0; n < 2; ++n)
#pragma unroll
                    for (int i = 0; i < 4; ++i) { const float g = (float)acc[ai][0][m][n][i] * (r * swv[0][n][i]), up = (float)acc[ai][1][m][n][i] * (r * swv[1][n][i]);
                        const float e = __builtin_amdgcn_exp2f(g * -1.4426950408889634f); hv[4 * n + i] = g * up * __builtin_amdgcn_rcpf(1.0f + e); }
                u32x4 w; w.x = cvt_pk_bf16(hv[0], hv[1]); w.y = cvt_pk_bf16(hv[2], hv[3]); w.z = cvt_pk_bf16(hv[4], hv[5]); w.w = cvt_pk_bf16(hv[6], hv[7]);
                *(u32x4*)(H + (size_t)row * 2816 + colb) = w;
            }
    }
};
struct EpiDown {
    typedef f32x4 acc_t;
    static constexpr bool PERM = true, AFTER_DRAIN = false, MIDK = false;
    const bf16_t* X1B; float* out;
    __device__ __forceinline__ void operator()(const f32x4 (&acc)[2][2][4][2], const Unit& u, int wr, int wc, int fr, int fq) const {
        const int row0 = u.pm * BM + wr * 64 + fr, colb = u.pn * BM + wc * 32 + 8 * fq;
        u32x4 xb[2][4][2];
#pragma unroll
        for (int ai = 0; ai < 2; ++ai)
#pragma unroll
            for (int m = 0; m < 4; ++m)
#pragma unroll
                for (int bj = 0; bj < 2; ++bj) xb[ai][m][bj] = __builtin_nontemporal_load((const u32x4*)(X1B + (size_t)(row0 + ai * HALF + m * 16) * 1024 + colb + bj * HALF));
#pragma unroll
        for (int ai = 0; ai < 2; ++ai)
#pragma unroll
            for (int m = 0; m < 4; ++m) { const size_t off = (size_t)(row0 + ai * HALF + m * 16) * 1024 + colb;
#pragma unroll
                for (int bj = 0; bj < 2; ++bj) { const u32x4 w = xb[ai][m][bj];
                    f32x4 x0, x1; x0[0] = __uint_as_float(w.x << 16); x0[1] = __uint_as_float(w.x & 0xffff0000u); x0[2] = __uint_as_float(w.y << 16); x0[3] = __uint_as_float(w.y & 0xffff0000u);
                    x1[0] = __uint_as_float(w.z << 16); x1[1] = __uint_as_float(w.z & 0xffff0000u); x1[2] = __uint_as_float(w.w << 16); x1[3] = __uint_as_float(w.w & 0xffff0000u);
                    *(f32x4*)(out + off + bj * HALF) = acc[ai][bj][m][0] + x0; *(f32x4*)(out + off + bj * HALF + 4) = acc[ai][bj][m][1] + x1; }
            }
    }
};

__device__ __forceinline__ f32x4 mma16(bf16x8 a, bf16x8 b, f32x4 c) { return __builtin_amdgcn_mfma_f32_16x16x32_bf16(a, b, c, 0, 0, 0); }
__device__ __forceinline__ i32x4 mma16(bf16x8 a, bf16x8 b, i32x4 c) { return __builtin_amdgcn_mfma_i32_16x16x64_i8(__builtin_bit_cast(i32x4, a), __builtin_bit_cast(i32x4, b), c, 0, 0, 0); }
template <class Epi, class Sched, bool ALIGN_EPI = false, bool SP2 = false>
__device__ __forceinline__ void gemm_phase(PG8_LAS unsigned char* lds, const Gemm g, const Sched& S, const Epi& E) {
    const int tid = threadIdx.x, wid = __builtin_amdgcn_readfirstlane(tid >> 6), lane = tid & 63, wr = wid >> 2, wc = wid & 3, fr = lane & 15, fq = lane >> 4;
    const int K = g.K, nt = K / BK;
    unsigned voffA[2], voffB[2];
#pragma unroll
    for (int i = 0; i < 2; ++i) { int R, C; stage_rc(tid * 16 + i * 8192, R, C); const int Rb = Epi::PERM ? ((R & ~31) + perm32(R & 31)) : R;
        voffA[i] = (unsigned)(R * K + C) * 2u; voffB[i] = (unsigned)(Rb * K + C) * 2u; }
    const size_t kstep = (size_t)(BK * 2);
    const size_t hstep = (size_t)HALF * K * 2;
    const size_t tstep = 2 * hstep;
    const unsigned ldsw = (unsigned)wid * 1024u;
    const int aoff = lds_byte(wr * 64 + fr, fq * 8), boff = lds_byte(wc * 32 + fr, fq * 8);
#define PG8_SA(b, h) (((b) * 2 + (h)) * HTB)
#define PG8_SB(b, h) ((4 + (b) * 2 + (h)) * HTB)
#define PG8_STAGE(bufoff, gbase, voff) do { _Pragma("unroll") for (int _i = 0; _i < 2; ++_i) \
        __builtin_amdgcn_global_load_lds((const unsigned*)((const char*)(gbase) + (voff)[_i]), (PG8_LAS unsigned*)(lds + (bufoff) + ldsw + _i * 8192), 16, 0, 0); } while (0)
#define PG8_LDA(dst, b, h) do { _Pragma("unroll") for (int m = 0; m < 4; ++m) _Pragma("unroll") for (int k = 0; k < 2; ++k) dst[m][k] = *(const PG8_LAS bf16x8*)(lds + PG8_SA(b, h) + aoff + m * 2048 + k * 1024); } while (0)
#define PG8_LDB(dst, b, h) do { _Pragma("unroll") for (int n = 0; n < 2; ++n) _Pragma("unroll") for (int k = 0; k < 2; ++k) dst[n][k] = *(const PG8_LAS bf16x8*)(lds + PG8_SB(b, h) + boff + n * 2048 + k * 1024); } while (0)
#define PG8_MMA(ai, bj, At, Bt) do { __builtin_amdgcn_s_setprio(1); _Pragma("unroll") for (int m = 0; m < 4; ++m) _Pragma("unroll") for (int n = 0; n < 2; ++n) _Pragma("unroll") for (int k = 0; k < 2; ++k) \
        acc[ai][bj][m][n] = mma16(Bt[n][k], At[m][k], acc[ai][bj][m][n]); __builtin_amdgcn_s_setprio(0); } while (0)
#define PG8_WAIT_V(n) asm volatile("s_waitcnt vmcnt(" #n ")" ::: "memory")
#define PG8_WAIT_L(n) asm volatile("s_waitcnt lgkmcnt(" #n ")" ::: "memory")
#define PG8_BAR __builtin_amdgcn_s_barrier()
#define PG8_SCHED __builtin_amdgcn_sched_barrier(0)
    Unit cur, nxt; int ui = 0;
    if (!S.next(0, cur)) return;
    typedef typename Epi::acc_t acc_t;
    acc_t acc[2][2][4][2];
#pragma unroll
    for (int a = 0; a < 2; ++a)
#pragma unroll
        for (int b = 0; b < 2; ++b)
#pragma unroll
            for (int m = 0; m < 4; ++m)
#pragma unroll
                for (int n = 0; n < 2; ++n) acc[a][b][m][n] = (acc_t){};
    bf16x8 At[4][2], B0[2][2], B1[2][2];
    const char* cA = (const char*)g.A + (size_t)cur.pm * tstep; const char* cB = (const char*)g.Bt + (size_t)cur.pn * tstep;
    S.a_ready(cur);
    if constexpr (SP2) {
        PG8_STAGE(PG8_SB(0, 0), cB, voffB); PG8_STAGE(PG8_SB(0, 1), cB + hstep, voffB); PG8_STAGE(PG8_SA(0, 0), cA, voffA); PG8_STAGE(PG8_SA(0, 1), cA + hstep, voffA);
        if (wr == 1) PG8_BAR;
        PG8_WAIT_V(2); PG8_BAR;
        PG8_STAGE(PG8_SB(1, 0), cB + kstep, voffB); PG8_STAGE(PG8_SA(1, 0), cA + kstep, voffA); PG8_STAGE(PG8_SB(1, 1), cB + hstep + kstep, voffB);
        PG8_WAIT_V(6); PG8_BAR;
    } else {
        PG8_STAGE(PG8_SB(0, 0), cB, voffB); PG8_STAGE(PG8_SA(0, 0), cA, voffA); PG8_STAGE(PG8_SB(0, 1), cB + hstep, voffB); PG8_STAGE(PG8_SA(0, 1), cA + hstep, voffA);
        if (wr == 1) PG8_BAR;
        PG8_WAIT_V(4); PG8_BAR;
        PG8_STAGE(PG8_SB(1, 0), cB + kstep, voffB); PG8_STAGE(PG8_SA(1, 0), cA + kstep, voffA); PG8_STAGE(PG8_SB(1, 1), cB + hstep + kstep, voffB);
        PG8_WAIT_V(6); PG8_BAR;
    }
    for (;;) {
        const bool has_next = S.next(ui + 1, nxt);
        float rsc[2][4];
        if constexpr (Epi::MIDK) E.pre(rsc, cur, wr, fr);
        const char* nA = has_next ? (const char*)g.A + (size_t)nxt.pm * tstep : cA; const char* nB = has_next ? (const char*)g.Bt + (size_t)nxt.pn * tstep : cB;
        for (int t = 0; t < nt; t += 2) {
            const bool last = (t == nt - 2);
            const char* a1 = cA + (size_t)(t + 1) * kstep;
            const char* a2 = last ? nA : cA + (size_t)(t + 2) * kstep; const char* b2 = last ? nB : cB + (size_t)(t + 2) * kstep;
            const char* a3 = a2 + kstep; const char* b3 = b2 + kstep;
            if (last && has_next) S.a_ready(nxt);
            if constexpr (Epi::MIDK) { if (t == nt / 2) E.mid(acc, rsc); }
            if constexpr (SP2) {
            PG8_LDB(B0, 0, 0); PG8_LDB(B1, 0, 1); PG8_SCHED; PG8_LDA(At, 0, 0); PG8_STAGE(PG8_SA(1, 1), a1 + hstep, voffA);
            PG8_WAIT_V(8); PG8_WAIT_L(0); PG8_BAR; PG8_MMA(0, 0, At, B0); PG8_MMA(0, 1, At, B1); PG8_BAR; PG8_SCHED;
            PG8_LDA(At, 0, 1); PG8_STAGE(PG8_SB(0, 0), b2, voffB); PG8_STAGE(PG8_SB(0, 1), b2 + hstep, voffB); PG8_STAGE(PG8_SA(0, 0), a2, voffA);
            PG8_WAIT_V(8); PG8_WAIT_L(0); PG8_BAR; PG8_MMA(1, 0, At, B0); PG8_MMA(1, 1, At, B1); PG8_BAR; PG8_SCHED;
            PG8_LDB(B0, 1, 0); PG8_LDB(B1, 1, 1); PG8_SCHED; PG8_LDA(At, 1, 0); PG8_STAGE(PG8_SA(0, 1), a2 + hstep, voffA);
            PG8_WAIT_V(8); PG8_WAIT_L(0); PG8_BAR; PG8_MMA(0, 0, At, B0); PG8_MMA(0, 1, At, B1); PG8_BAR; PG8_SCHED;
            PG8_LDA(At, 1, 1); PG8_STAGE(PG8_SB(1, 0), b3, voffB); PG8_STAGE(PG8_SB(1, 1), b3 + hstep, voffB); PG8_STAGE(PG8_SA(1, 0), a3, voffA);
            PG8_WAIT_V(8); PG8_WAIT_L(0); PG8_BAR; PG8_MMA(1, 0, At, B0); PG8_MMA(1, 1, At, B1); PG8_BAR; PG8_SCHED;
            } else {
            PG8_LDB(B0, 0, 0); PG8_SCHED; PG8_LDA(At, 0, 0); PG8_STAGE(PG8_SA(1, 1), a1 + hstep, voffA);
            PG8_WAIT_L(8); PG8_BAR; PG8_WAIT_L(0); PG8_MMA(0, 0, At, B0); PG8_BAR; PG8_SCHED;
            PG8_LDB(B1, 0, 1); PG8_STAGE(PG8_SB(0, 0), b2, voffB);
            PG8_BAR; PG8_WAIT_L(0); PG8_MMA(0, 1, At, B1); PG8_BAR;
            PG8_LDA(At, 0, 1); PG8_STAGE(PG8_SA(0, 0), a2, voffA);
            PG8_BAR; PG8_WAIT_L(0); PG8_MMA(1, 0, At, B0); PG8_BAR; PG8_SCHED;
            PG8_STAGE(PG8_SB(0, 1), b2 + hstep, voffB);
            PG8_WAIT_V(6); PG8_BAR; PG8_MMA(1, 1, At, B1); PG8_BAR;
            PG8_LDB(B0, 1, 0); PG8_SCHED; PG8_LDA(At, 1, 0); PG8_STAGE(PG8_SA(0, 1), a2 + hstep, voffA);
            PG8_WAIT_L(8); PG8_BAR; PG8_WAIT_L(0); PG8_MMA(0, 0, At, B0); PG8_BAR; PG8_SCHED;
            PG8_LDB(B1, 1, 1); PG8_STAGE(PG8_SB(1, 0), b3, voffB);
            PG8_BAR; PG8_WAIT_L(0); PG8_MMA(0, 1, At, B1); PG8_BAR;
            PG8_LDA(At, 1, 1); PG8_STAGE(PG8_SA(1, 0), a3, voffA);
            PG8_BAR; PG8_WAIT_L(0); PG8_MMA(1, 0, At, B0); PG8_BAR; PG8_SCHED;
            PG8_STAGE(PG8_SB(1, 1), b3 + hstep, voffB);
            PG8_WAIT_V(6); PG8_BAR; PG8_MMA(1, 1, At, B1); PG8_BAR;
            }
        }
        if constexpr (ALIGN_EPI) { if (wr == 0) PG8_BAR; }
        if constexpr (!Epi::AFTER_DRAIN) { E(acc, cur, wr, wc, fr, fq); S.done(cur); }
        if (!has_next) break;
#pragma unroll
        for (int a = 0; a < 2; ++a)
#pragma unroll
            for (int b = 0; b < 2; ++b)
#pragma unroll
                for (int m = 0; m < 4; ++m)
#pragma unroll
                    for (int n = 0; n < 2; ++n) acc[a][b][m][n] = (acc_t){};
        cur = nxt; cA = nA; cB = nB; ++ui;
        if constexpr (ALIGN_EPI) { if (wr == 1) PG8_BAR; }
    }
    PG8_WAIT_V(0);
    if constexpr (!ALIGN_EPI) { if (wr == 0) PG8_BAR; }
    PG8_BAR;
    if constexpr (Epi::AFTER_DRAIN) { E.fused(acc, cur, wr, wc, fr, fq, lds, wid, lane); S.done(cur); }
#undef PG8_SA
#undef PG8_SB
#undef PG8_STAGE
#undef PG8_LDA
#undef PG8_LDB
#undef PG8_MMA
#undef PG8_WAIT_V
#undef PG8_WAIT_L
#undef PG8_BAR
#undef PG8_SCHED
}
}
constexpr int NWAVES = 8;
constexpr int DM = 1024, MTOK = 32768, MPAD = pg8::MP_ROWS, NIN = 2304, DFF = 2816, NGU = 2 * DFF;
constexpr float LOG2E = 1.4426950408889634f;
constexpr float EPS = 1e-6f;
constexpr size_t MiB = 1u << 20;
constexpr size_t WS_CTL = 0, CTL_ZERO_BYTES = 65536;
constexpr size_t WS_SMA = 1 * MiB, WS_SMB = WS_SMA + 131072;
constexpr size_t WS_SWO = 9 * MiB + 524288 - 4096;
constexpr size_t WS_WOQ = 404 * MiB;
constexpr size_t WS_WDN = 3 * MiB;
constexpr size_t WS_R1 = 9 * MiB;
constexpr size_t WS_SX = WS_R1 + 262144, WS_SW = WS_R1 + 524288;
constexpr size_t WS_MIX = 10 * MiB;
constexpr size_t WS_X1Q = WS_MIX;
constexpr size_t WS_QKV = 74 * MiB;
constexpr size_t SZ_Q = (size_t)MPAD * 512 * 2, SZ_KB = (size_t)MPAD * 128 * 2;
constexpr size_t WS_QA = WS_QKV, WS_KA = WS_QA + SZ_Q, WS_VAT = WS_KA + SZ_Q, WS_QB = WS_VAT + SZ_Q, WS_KB = WS_QB + SZ_Q, WS_VBT = WS_KB + SZ_KB, WS_QKV_END = WS_VBT + SZ_KB;
constexpr size_t WS_H = 74 * MiB;
constexpr size_t WS_X1B = 250 * MiB;
constexpr size_t WS_XN = 314 * MiB;
constexpr size_t WS_WGQ = 405 * MiB;
constexpr size_t WS_WGU = 385 * MiB;
constexpr size_t WS_WIN = 396 * MiB;
constexpr size_t WS_WOUT = 383 * MiB;
constexpr size_t WS_END = 411 * MiB;
static_assert(WS_SMB + 131072 <= WS_WDN && WS_WDN + (size_t)DM * DFF * 2 <= WS_R1 && WS_R1 + (size_t)MPAD * 4 <= WS_SX && WS_SX + (size_t)MTOK * 4 <= WS_SWO && WS_SWO + 4096 == WS_SW && WS_SW + (size_t)NGU * 4 <= WS_MIX
              && WS_MIX + (size_t)MTOK * DM <= WS_QKV && WS_QKV_END <= WS_X1B && WS_H + (size_t)MTOK * DFF * 2 <= WS_X1B && WS_X1B + (size_t)MTOK * DM * 2 <= WS_XN
              && WS_XN + (size_t)MPAD * DM * 2 <= WS_WOUT && WS_WOUT + (size_t)DM * DM * 2 == WS_WGU && WS_WGU + (size_t)NGU * DM * 2 <= WS_WIN && WS_WIN + (size_t)NIN * DM * 2 <= WS_WOQ && WS_WOQ + (size_t)DM * DM == WS_WGQ
              && WS_WGQ + (size_t)NGU * DM <= WS_END, "d_ws map");
constexpr int CW_TMO = 0, CW_CODE = 1, CW_BAR = 4096;
constexpr int RING_OFF = 0, RING_BYTES = 131072;
constexpr int LDSCTL_OFF = 162816, MISC_OFF = LDSCTL_OFF + 320;
constexpr int LDS_BYTES = 163840;
#define GAS __attribute__((address_space(1)))
#define LAS __attribute__((address_space(3)))
typedef unsigned short bf16;
typedef unsigned v4u __attribute__((ext_vector_type(4)));
typedef float f32x4 __attribute__((ext_vector_type(4)));
typedef short bf16x8 __attribute__((ext_vector_type(8)));
typedef GAS unsigned gu32;
typedef GAS unsigned long long gu64;
#define RLX_AGENT __ATOMIC_RELAXED, __HIP_MEMORY_SCOPE_AGENT
#define LDS_WAIT() asm volatile("s_waitcnt lgkmcnt(0)" ::: "memory")
#define VM_WAIT() asm volatile("s_waitcnt vmcnt(0)" ::: "memory")
__device__ __forceinline__ unsigned long long rt() { return __builtin_amdgcn_s_memrealtime(); }
__device__ __forceinline__ unsigned f2bf(float f) { unsigned u = __builtin_bit_cast(unsigned, f); return (u + 0x7fffu + ((u >> 16) & 1u)) >> 16; }
__device__ __forceinline__ unsigned pk2(float lo, float hi) { return f2bf(lo) | (f2bf(hi) << 16); }

#define XB_TMO      128
#define XB_XCNT(j)  (256  + 64 * (j))
#define XB_XSUB(j)  (1280 + 64 * (j))
#define XB_XGEN(j)  (2304 + 64 * (j))
#define XB_TOP      3328
#define XB_TOPGEN   3392
#define XB_LSUB(j)  (3456 + 64 * (j))
#define XCD_BAR_WORDS 4480
#define XB_SPIN_CAP (1u << 18)

__device__ __forceinline__ unsigned xb_ld(unsigned* p)              { return __hip_atomic_load(p, __ATOMIC_RELAXED, __HIP_MEMORY_SCOPE_AGENT); }
__device__ __forceinline__ unsigned xb_add(unsigned* p, unsigned v) { return __hip_atomic_fetch_add(p, v, __ATOMIC_RELAXED, __HIP_MEMORY_SCOPE_AGENT); }
__device__ __forceinline__ unsigned xb_xcc_id() { return (unsigned)__builtin_amdgcn_s_getreg((3 << 11) | 20) & 0xFu; }
#define XB_SPIN(cond, bar) do { unsigned _sp = 0; while (cond) { __builtin_amdgcn_s_sleep(1); \
    if ((++_sp & 255u) == 0u) { if (xb_ld(&(bar)[XB_TMO])) break; if (_sp > XB_SPIN_CAP) { atomicAdd(&(bar)[XB_TMO], 1u); break; } } } } while (0)

struct XcdBarrier {
    unsigned* bar; unsigned x;
    volatile LAS unsigned* st;
};

__device__ __forceinline__ XcdBarrier xcd_barrier_post(unsigned* bar, volatile LAS unsigned* st) {
    XcdBarrier b; b.bar = bar; b.x = xb_xcc_id(); b.st = st;
    if (threadIdx.x == 0) st[3] = xb_add(&bar[XB_XCNT(b.x)], 1u);
    return b;
}
__device__ __forceinline__ void xcd_barrier_complete(unsigned* bar, unsigned x, unsigned& nloc, unsigned& nx, unsigned& xi) {
    const unsigned G = gridDim.x * gridDim.y * gridDim.z;
    unsigned sum, cnt, mine, below, sp = 0u;
    for (;;) {
        sum = 0u; cnt = 0u; mine = 0u; below = 0u;
#pragma unroll
        for (unsigned j = 0; j < 16; ++j) { const unsigned c = xb_ld(&bar[XB_XCNT(j)]); sum += c; cnt += (c > 0u) ? 1u : 0u; mine = (j == x) ? c : mine; below += (j < x && c > 0u) ? 1u : 0u; }
        if (sum == G) break;
        __builtin_amdgcn_s_sleep(1);
        if ((++sp & 255u) == 0u) { if (xb_ld(&bar[XB_TMO])) break; if (sp > XB_SPIN_CAP) { atomicAdd(&bar[XB_TMO], 1u); break; } }
    }
    nloc = mine > 0u ? mine : 1u; nx = cnt > 0u ? cnt : 1u; xi = below < nx ? below : nx - 1u;
}

__device__ __forceinline__ void xcd_barrier(const XcdBarrier& b) {
    asm volatile("s_waitcnt vmcnt(0)" ::: "memory");
    __syncthreads();
    if (threadIdx.x == 0) {
        unsigned* bar = b.bar;
        __builtin_amdgcn_s_waitcnt(0);
        unsigned nloc = b.st[0], nx = b.st[1];
        if (nloc == 0u) { unsigned xi; xcd_barrier_complete(bar, b.x, nloc, nx, xi); b.st[0] = nloc; b.st[1] = nx; b.st[2] = xi; }
        const unsigned old = xb_add(&bar[XB_XSUB(b.x)], 1u);
        const unsigned gen = old / nloc;
        if (old + 1u == (gen + 1u) * nloc) {
            __builtin_amdgcn_fence(__ATOMIC_RELEASE, "agent");
            asm volatile("s_waitcnt vmcnt(0)" ::: "memory");
            const unsigned og = xb_add(&bar[XB_TOP], 1u);
            const unsigned tg = og / nx;
            if (og + 1u == (tg + 1u) * nx) xb_add(&bar[XB_TOPGEN], 1u);
            else XB_SPIN(xb_ld(&bar[XB_TOPGEN]) == tg, bar);
            __builtin_amdgcn_fence(__ATOMIC_ACQUIRE, "agent");
            xb_add(&bar[XB_XGEN(b.x)], 1u);
            asm volatile("s_waitcnt vmcnt(0)" ::: "memory");
        } else {
            XB_SPIN(xb_ld(&bar[XB_XGEN(b.x)]) == gen, bar);
            __builtin_amdgcn_fence(__ATOMIC_ACQUIRE, "agent");
            asm volatile("s_waitcnt vmcnt(0)" ::: "memory");
        }
    }
    __syncthreads();
}

struct XcdEnv { int nloc, nx, xi, rank; };
__device__ __forceinline__ XcdEnv xcd_env(const XcdBarrier& b) {
    if (threadIdx.x == 0 && b.st[0] == 0u) { unsigned nloc, nx, xi; xcd_barrier_complete(b.bar, b.x, nloc, nx, xi); b.st[1] = nx; b.st[2] = xi; b.st[0] = nloc; }
    __syncthreads();
    XcdEnv e; e.nloc = __builtin_amdgcn_readfirstlane((int)b.st[0]); e.nx = __builtin_amdgcn_readfirstlane((int)b.st[1]); e.xi = __builtin_amdgcn_readfirstlane((int)b.st[2]); e.rank = __builtin_amdgcn_readfirstlane((int)b.st[3]);
    return e;
}
__device__ __forceinline__ void xcd_local_barrier(const XcdBarrier& b) {
    asm volatile("s_waitcnt vmcnt(0)" ::: "memory");
    __syncthreads();
    if (threadIdx.x == 0) {
        unsigned* bar = b.bar;
        __builtin_amdgcn_s_waitcnt(0);
        unsigned nloc = b.st[0];
        if (nloc == 0u) { unsigned nx, xi; xcd_barrier_complete(bar, b.x, nloc, nx, xi); b.st[1] = nx; b.st[2] = xi; b.st[0] = nloc; }
        const unsigned old = xb_add(&bar[XB_LSUB(b.x)], 1u);
        const unsigned target = (old / nloc + 1u) * nloc;
        XB_SPIN(xb_ld(&bar[XB_LSUB(b.x)]) < target, bar);
        __builtin_amdgcn_fence(__ATOMIC_ACQUIRE, "agent");
        asm volatile("s_waitcnt vmcnt(0)" ::: "memory");
    }
    __syncthreads();
}

static_assert((CW_BAR + 2 * XCD_BAR_WORDS) * 4 <= (int)CTL_ZERO_BYTES, "barrier words inside the memset region");
typedef float f32x16 __attribute__((ext_vector_type(16)));
typedef short s16x4 __attribute__((ext_vector_type(4)));
typedef unsigned u32x2 __attribute__((ext_vector_type(2)));
typedef unsigned u32x4 __attribute__((ext_vector_type(4)));
struct Frame {
    LAS unsigned char* lds;
    volatile LAS unsigned* MISC;
    gu32* ctl;
    int wave;
    int vcu, G;
};
__device__ __forceinline__ int fresh_lane() { int t = threadIdx.x; asm volatile("" : "+v"(t)); return t & 63; }
__device__ __forceinline__ float wave_sum(float v) {
#pragma unroll
    for (int o = 1; o < 64; o <<= 1) v += __shfl_xor(v, o);
    return v;
}
__device__ __forceinline__ unsigned q8x4(float a, float b, float c, float d, float qs) {
    const unsigned ua = __float_as_uint(__builtin_fmaf(a, qs, 12582912.0f)), ub = __float_as_uint(__builtin_fmaf(b, qs, 12582912.0f));
    const unsigned uc = __float_as_uint(__builtin_fmaf(c, qs, 12582912.0f)), ud = __float_as_uint(__builtin_fmaf(d, qs, 12582912.0f));
    const unsigned lo = __builtin_amdgcn_perm(ub, ua, 0x0c0c0400u), hi = __builtin_amdgcn_perm(ud, uc, 0x04000c0cu);
    return lo | hi;
}
constexpr int NBT_LD = 1028;
__device__ __forceinline__ void p0_nblock_task(const float* W, int N, int n0, const float* g, signed char* dstq, float* scl, int drow0, LAS float* T, int wave, int lane) {
    const int kq = lane >> 3, c4 = lane & 7;
#pragma unroll
    for (int kb2 = 0; kb2 < 2; ++kb2) { const int k0 = 64 * (2 * wave + kb2);
        f32x4 v[8];
#pragma unroll
        for (int i = 0; i < 8; ++i) v[i] = __builtin_nontemporal_load((const GAS f32x4*)(W + (size_t)(k0 + 8 * i + kq) * N + n0 + 4 * c4));
        if (g) {
#pragma unroll
            for (int i = 0; i < 8; ++i) v[i] = v[i] * g[k0 + 8 * i + kq]; }
#pragma unroll
        for (int i = 0; i < 8; ++i) { LAS float* d = T + (4 * c4) * NBT_LD + k0 + 8 * i + kq; d[0] = v[i].x; d[NBT_LD] = v[i].y; d[2 * NBT_LD] = v[i].z; d[3 * NBT_LD] = v[i].w; } }
    LDS_WAIT(); __syncthreads();
#pragma unroll
    for (int c = 0; c < 4; ++c) { const int ch = 4 * wave + c; const LAS f32x4* rp = (const LAS f32x4*)(T + ch * NBT_LD + 16 * lane);
        const f32x4 a = rp[0], b = rp[1], cc = rp[2], d = rp[3];
        float am = fmaxf(fmaxf(fmaxf(fabsf(a[0]), fabsf(a[1])), fmaxf(fabsf(a[2]), fabsf(a[3]))), fmaxf(fmaxf(fabsf(b[0]), fabsf(b[1])), fmaxf(fabsf(b[2]), fabsf(b[3]))));
        am = fmaxf(am, fmaxf(fmaxf(fmaxf(fabsf(cc[0]), fabsf(cc[1])), fmaxf(fabsf(cc[2]), fabsf(cc[3]))), fmaxf(fmaxf(fabsf(d[0]), fabsf(d[1])), fmaxf(fabsf(d[2]), fabsf(d[3])))));
#pragma unroll
        for (int o = 1; o < 64; o <<= 1) am = fmaxf(am, __shfl_xor(am, o));
        const float qs = am > 0.f ? 127.0f / am : 0.f;
        v4u q; q.x = q8x4(a[0], a[1], a[2], a[3], qs); q.y = q8x4(b[0], b[1], b[2], b[3], qs); q.z = q8x4(cc[0], cc[1], cc[2], cc[3], qs); q.w = q8x4(d[0], d[1], d[2], d[3], qs);
        *(GAS v4u*)(dstq + (size_t)(drow0 + ch) * DM + 16 * lane) = q;
        if (lane == 0) scl[drow0 + ch] = am > 0.f ? am * (1.0f / 127.0f) : 1.0f; }
    LDS_WAIT(); __syncthreads();
}
constexpr int P0_NTASKS = DM / 32 + 2 * (DFF / 32);
__device__ __forceinline__ void p0_weight_tasks(Frame& F, const float* w_out, const float* g2, const float* w_gate, const float* w_up, signed char* WOQ, float* SWO, signed char* WGQ, float* SW, int wg, int nwg) {
    LAS float* T = (LAS float*)(F.lds + RING_OFF);
    __syncthreads();
    for (int t = wg; t < P0_NTASKS; t += nwg) {
        if (t < DM / 32) { p0_nblock_task(w_out, DM, 32 * t, nullptr, WOQ, SWO, 32 * t, T, F.wave, fresh_lane()); continue; }
        const int r = t - DM / 32; const bool up = r >= DFF / 32; const int n0 = 32 * (up ? r - DFF / 32 : r);
        p0_nblock_task(up ? w_up : w_gate, DFF, n0, g2, WGQ, SW, 256 * (n0 >> 7) + (up ? 128 : 0) + (n0 & 127), T, F.wave, fresh_lane());
    }
}
__device__ __forceinline__ void p0_transpose_item(const float* W, int K, int N, bf16* WT, int k0, int n0, int drow, const float* g, LAS float* scr, int lane) {
    f32x4 v[8]; const int kq = lane >> 3, c4 = lane & 7;
#pragma unroll
    for (int i = 0; i < 8; ++i) v[i] = __builtin_nontemporal_load((const GAS f32x4*)(W + (size_t)(k0 + 8 * i + kq) * N + n0 + 4 * c4));
    if (g) {
#pragma unroll
        for (int i = 0; i < 8; ++i) v[i] = v[i] * g[k0 + 8 * i + kq]; }
#pragma unroll
    for (int i = 0; i < 8; ++i) { LAS float* d = scr + (8 * i + kq) * 33 + 4 * c4; d[0] = v[i].x; d[1] = v[i].y; d[2] = v[i].z; d[3] = v[i].w; }
    LDS_WAIT(); asm volatile("" ::: "memory");
    const int c = lane & 7;
#pragma unroll
    for (int j = 0; j < 4; ++j) { const int n = (lane >> 3) + 8 * j; const LAS float* s = scr + (8 * c) * 33 + n;
        v4u o; o.x = pk2(s[0 * 33], s[1 * 33]); o.y = pk2(s[2 * 33], s[3 * 33]); o.z = pk2(s[4 * 33], s[5 * 33]); o.w = pk2(s[6 * 33], s[7 * 33]);
        *(GAS v4u*)(WT + (size_t)(drow + n) * K + k0 + 8 * c) = o; }
    LDS_WAIT(); asm volatile("" ::: "memory");
}
constexpr int P0_I_IN = (DM / 64) * (NIN / 32), P0_I_DN = (DFF / 64) * (DM / 32), P0_NITEMS = P0_I_IN + P0_I_DN;
__device__ __forceinline__ void p0_weight_items(Frame& F, const float* g1, const float* w_in, const float* w_down, bf16* WIN, bf16* WDN, LAS float* scr, int lo, int hi, int worker, int nworkers) {
    constexpr int I_IN = P0_I_IN;
    for (int it = lo + worker; it < hi; it += nworkers) {
        int r = it;
        if (r < I_IN) { const int nb = r % (NIN / 32), kb = r / (NIN / 32), n0 = 32 * nb, g = n0 >> 6;
            const int drow = 256 * (g >> 2) + 128 * ((n0 & 63) >> 5) + 32 * (g & 3);
            p0_transpose_item(w_in, DM, NIN, WIN, 64 * kb, n0, drow, g1, scr, fresh_lane()); continue; } r -= I_IN;
        { const int nb = r % (DM / 32), kb = r / (DM / 32); p0_transpose_item(w_down, DFF, DM, WDN, 64 * kb, 32 * nb, 32 * nb, nullptr, scr, fresh_lane()); }
    }
}
__device__ __forceinline__ void p0_prologue(Frame& F, const float* xp, const float* xs, const float* meta, const float* g1, const float* w_in, const float* w_out, const float* g2, const float* w_gate, const float* w_up, const float* w_down,
        bf16* WIN, signed char* WOQ, float* SWO, signed char* WGQ, float* SW, bf16* WDN, bf16* XN, float* R1, bool defer) {
    LAS float* scr = (LAS float*)(F.lds + RING_OFF + F.wave * 16384);
    const int lane_ = fresh_lane();
    const int gw = F.vcu * NWAVES + F.wave, NGW = F.G * NWAVES;
    constexpr int I_IN = (DM / 64) * (NIN / 32);
    p0_weight_items(F, g1, w_in, w_down, WIN, WDN, scr, 0, defer ? I_IN : P0_NITEMS, gw, NGW);
    if (!defer) p0_weight_tasks(F, w_out, g2, w_gate, w_up, WOQ, SWO, WGQ, SW, F.vcu, F.G);
    for (int m0 = gw; m0 < MPAD; m0 += 4 * NGW) {
        f32x4 v[4][4];
#pragma unroll
        for (int b = 0; b < 4; ++b) { const int m = m0 + b * NGW;
            if (m < MTOK + 16) { const float* xrow = m < 16384 ? xp + (size_t)m * DM : (m < MTOK ? xs + (size_t)(m - 16384) * DM : meta + (size_t)(m - MTOK) * DM);
                const GAS f32x4* xr = (const GAS f32x4*)xrow + lane_;
#pragma unroll
                for (int j = 0; j < 4; ++j) v[b][j] = __builtin_nontemporal_load(xr + 64 * j); }
            else {
#pragma unroll
                for (int j = 0; j < 4; ++j) v[b][j] = (f32x4){0.f, 0.f, 0.f, 0.f}; } }
#pragma unroll
        for (int b = 0; b < 4; ++b) { const int m = m0 + b * NGW; if (m >= MPAD) continue;
            float sq = 0.f;
#pragma unroll
            for (int j = 0; j < 4; ++j) sq += (v[b][j].x * v[b][j].x + v[b][j].y * v[b][j].y) + (v[b][j].z * v[b][j].z + v[b][j].w * v[b][j].w);
            const float rstd = __builtin_amdgcn_rsqf(wave_sum(sq) * (1.f / DM) + EPS);
            if (lane_ == 0) R1[m] = rstd;
            GAS unsigned long long* o8 = (GAS unsigned long long*)(XN + (size_t)m * DM) + lane_;
#pragma unroll
            for (int j = 0; j < 4; ++j) { const f32x4 y = v[b][j];
                o8[64 * j] = (unsigned long long)pk2(y.x, y.y) | ((unsigned long long)pk2(y.z, y.w) << 32); } }
    }
}
__device__ __forceinline__ unsigned cvtpk(float lo, float hi) { return pg8::cvt_pk_bf16(lo, hi); }
__device__ __forceinline__ void attn_load_kv(bf16x8 (&kf)[4], bf16x8 (&vf)[2][2], const bf16* krow, const bf16* vcol) {
#pragma unroll
    for (int s = 0; s < 4; ++s) kf[s] = *(const bf16x8*)(krow + 16 * s);
#pragma unroll
    for (int db = 0; db < 2; ++db)
#pragma unroll
        for (int s = 0; s < 2; ++s) { const bf16* p = vcol + (size_t)(32 * db) * MPAD + 16 * s;
            const s16x4 lo = *(const s16x4*)p, hi = *(const s16x4*)(p + 8);
            vf[db][s] = (bf16x8){lo[0], lo[1], lo[2], lo[3], hi[0], hi[1], hi[2], hi[3]}; }
}
__device__ __forceinline__ void attn_load_k(bf16x8 (&kf)[4], const bf16* kt) {
#pragma unroll
    for (int s = 0; s < 4; ++s) kf[s] = *(const bf16x8*)(kt + 512 * s);
}
__device__ __forceinline__ void attn_load_v(bf16x8 (&vf)[2][2], const bf16* vt) {
#pragma unroll
    for (int db = 0; db < 2; ++db)
#pragma unroll
        for (int s = 0; s < 2; ++s) vf[db][s] = *(const bf16x8*)(vt + 512 * (2 * db + s));
}
__device__ __forceinline__ f32x16 attn_qk(const bf16x8 (&kf)[4], const LAS bf16x8* qf, f32x16 S = (f32x16){}) {
#pragma unroll
    for (int s = 0; s < 4; ++s) S = __builtin_amdgcn_mfma_f32_32x32x16_bf16(kf[s], qf[64 * s], S, 0, 0, 0);
    return S;
}
__device__ __forceinline__ void attn_pv_half(f32x16 (&O)[2], const float (&p)[8], const bf16x8 (&vf)[2][2], int s) {
    u32x4 pw; pw.x = cvtpk(p[0], p[1]); pw.y = cvtpk(p[2], p[3]); pw.z = cvtpk(p[4], p[5]); pw.w = cvtpk(p[6], p[7]);
    const bf16x8 pb = __builtin_bit_cast(bf16x8, pw);
#pragma unroll
    for (int db = 0; db < 2; ++db) O[db] = __builtin_amdgcn_mfma_f32_32x32x16_bf16(vf[db][s], pb, O[db], 0, 0, 0);
}
__device__ __forceinline__ f32x16 attn_tab16(const LAS float* tab4, int cstride, int I) {
    const int a = I & 3; const LAS f32x4* p = (const LAS f32x4*)(tab4 + a * cstride + (I - a));
    const f32x4 v0 = p[0], v1 = p[2], v2 = p[4], v3 = p[6];
    return (f32x16){v0[0], v0[1], v0[2], v0[3], v1[0], v1[1], v1[2], v1[3], v2[0], v2[1], v2[2], v2[3], v3[0], v3[1], v3[2], v3[3]};
}
constexpr int TA_CS = 608, TB_CS = 324, TM_CS = 132;
template <bool ISB, int CB>
__device__ __forceinline__ void attn_win_tile(f32x16 (&O)[2][2], float (&l)[2], const bf16x8 (&kf)[4], const bf16x8 (&vf)[2][2], const LAS bf16x8* qf,
                                              const LAS float* tabAB, const LAS float* tabM, int wt, int rowoff, int jlo, int q, int h) {
#pragma unroll
    for (int qb = 0; qb < 2; ++qb) {
        if (ISB) { const int j = jlo + wt; if ((qb == 0 && j == 9) || (qb == 1 && j == 0)) continue; }
        constexpr int cb = CB;
        f32x16 C, Bv = (f32x16){};
        if (!ISB) {
            const int c = 32 * qb + q; int cs = c - 8; cs = cs < 0 ? 0 : (cs > 48 ? 48 : cs);
            const int kcb = 32 * cb + 4 * h;
            C = attn_tab16(tabM, TM_CS, 63 + kcb - cs);
            Bv = attn_tab16(tabAB, TA_CS, rowoff + 63 + kcb - c);
        } else {
            C = attn_tab16(tabAB, TB_CS, 32 * (jlo + wt) - 128 - 32 * qb - q + 4 * h + 160);
        }
        const f32x16 S = attn_qk(kf, qf + 256 * qb, C);
        float ls0 = 0.f, ls1 = 0.f;
#pragma unroll
        for (int s2 = 0; s2 < 2; ++s2) {
            if (!ISB && qb != cb && s2 == cb) continue;
            float p[8];
#pragma unroll
            for (int j = 0; j < 8; ++j) { const int rg = 8 * s2 + j;
                float x = S[rg]; if (!ISB) x += Bv[rg];
                p[j] = __builtin_amdgcn_exp2f(x); }
            ls0 += (p[0] + p[1]) + (p[2] + p[3]); ls1 += (p[4] + p[5]) + (p[6] + p[7]);
            attn_pv_half(O[qb], p, vf, s2);
        }
        l[qb] += ls0 + ls1;
        __builtin_amdgcn_sched_barrier(0);
    }
}
struct AttnPtrs { const bf16 *QA, *KA, *VAT, *QB, *KB, *VBT; unsigned char* MIX; float *SMA, *SMB; const float *ona, *onb; };
template <bool ISB>
__device__ __forceinline__ void attn_unit(Frame& F, const AttnPtrs& T, int t0, const LAS float* tabAB, const LAS float* tabM, float sinkexp, LAS float* ssx, LAS bf16x8* qlds) {
    const int lane = fresh_lane(), w = F.wave, q = lane & 31, h = lane >> 5;
    int sb, N; if (t0 < 16384) { sb = t0 & ~8191; N = 8192; } else { sb = 16384 + ((t0 - 16384) & ~4095); N = 4096; }
    const int q0 = t0 - sb;
    constexpr int NT = MPAD / 32;
    const bf16* Qp = (ISB ? T.QB : T.QA) + ((size_t)w * NT + (t0 >> 5)) * 2048 + lane * 8;
    const int khead = ISB ? (w >> 2) : w;
    const bf16* Kp = (ISB ? T.KB : T.KA) + (size_t)khead * NT * 2048 + lane * 8;
    const bf16* Vp = (ISB ? T.VBT : T.VAT) + (size_t)khead * NT * 2048 + lane * 8;
    int nw, jlo = 0, tbase0, rs = 0, rq = 0;
    if (!ISB) { const int rows = N >> 6; rq = q0 >> 6; rs = rq - 4; rs = rs < 0 ? 0 : (rs > rows - 8 ? rows - 8 : rs); nw = 16; tbase0 = sb + 64 * rs; }
    else { jlo = q0 >= 128 ? 0 : (128 - q0) >> 5; int jhi = (N - q0 + 128) >> 5; jhi = jhi > 10 ? 10 : jhi; nw = jhi - jlo; tbase0 = sb + q0 - 128 + 32 * jlo; }
#define ATT_KROW(wt_) (rs + ((((wt_) >> 1) - rs) & 7))
#define ATT_TB(wt_) (ISB ? tbase0 + 32 * (wt_) : sb + 64 * ATT_KROW(wt_) + 32 * ((wt_) & 1))
    bf16x8 kfX[4], kfY[4], vfX[2][2], vfY[2][2];
    attn_load_k(kfX, Kp + (size_t)(MTOK >> 5) * 2048); attn_load_v(vfX, Vp + (size_t)(MTOK >> 5) * 2048);
    { const int tb = ATT_TB(0); attn_load_k(kfY, Kp + (size_t)(tb >> 5) * 2048); attn_load_v(vfY, Vp + (size_t)(tb >> 5) * 2048); }
    LAS bf16x8* qf = qlds + lane;
#pragma unroll
    for (int qb = 0; qb < 2; ++qb)
#pragma unroll
        for (int s = 0; s < 4; ++s) qf[256 * qb + 64 * s] = __builtin_nontemporal_load((const bf16x8*)(Qp + 2048 * qb + 512 * s));
    f32x16 O[2][2]; float l[2] = {0.f, 0.f};
#pragma unroll
    for (int qb = 0; qb < 2; ++qb)
#pragma unroll
        for (int db = 0; db < 2; ++db) O[qb][db] = (f32x16){};
#pragma unroll
    for (int qb = 0; qb < 2; ++qb) {
        const f32x16 S = attn_qk(kfX, qf + 256 * qb); float ls = 0.f;
        const int ib = 144 - q0 - 32 * qb - q + 4 * h;
        float p[8];
#pragma unroll
        for (int r = 0; r < 8; ++r) { float b = 0.f; if (ISB) { int idx = ib + (r & 3) + 8 * (r >> 2); idx = idx < 32 ? 32 : idx; b = tabAB[idx]; }
            p[r] = __builtin_amdgcn_exp2f(S[r] + b); ls += p[r]; }
        l[qb] += ls; attn_pv_half(O[qb], p, vfX, 0);
        __builtin_amdgcn_sched_barrier(0);
    }
#pragma unroll 1
    for (int wt = 0; wt < nw; wt += 2) {
        { const int tb = ATT_TB(wt + 1); attn_load_k(kfX, Kp + (size_t)(tb >> 5) * 2048); attn_load_v(vfX, Vp + (size_t)(tb >> 5) * 2048); }
        attn_win_tile<ISB, 0>(O, l, kfY, vfY, qf, tabAB, tabM, wt, ISB ? 0 : (ATT_KROW(wt) - rq + 7) * 32, jlo, q, h);
        { const int wn = wt + 2 < nw ? wt + 2 : wt; const int tb = ATT_TB(wn); attn_load_k(kfY, Kp + (size_t)(tb >> 5) * 2048); attn_load_v(vfY, Vp + (size_t)(tb >> 5) * 2048); }
        attn_win_tile<ISB, 1>(O, l, kfX, vfX, qf, tabAB, tabM, wt + 1, ISB ? 0 : (ATT_KROW(wt + 1) - rq + 7) * 32, jlo, q, h);
    }
#undef ATT_KROW
#undef ATT_TB
    f32x4 gvv[2][4];
    { const float* gain = (ISB ? T.onb : T.ona) + w * 64 + 4 * h;
#pragma unroll
      for (int db = 0; db < 2; ++db)
#pragma unroll
          for (int g = 0; g < 4; ++g) gvv[db][g] = *(const f32x4*)(gain + 32 * db + 8 * g); }
    float inv[2];
    LAS float* amx = ssx + 16896;
#pragma unroll
    for (int qb = 0; qb < 2; ++qb) { float lt = l[qb] + __shfl_xor(l[qb], 32); if (ISB) lt += sinkexp; inv[qb] = __builtin_amdgcn_rcpf(lt);
        float ss = 0.f, am = 0.f;
#pragma unroll
        for (int db = 0; db < 2; ++db)
#pragma unroll
            for (int rg = 0; rg < 16; ++rg) { const float o = O[qb][db][rg] * inv[qb]; ss += o * o; const float og = o * gvv[db][rg >> 2][rg & 3]; O[qb][db][rg] = og; am = fmaxf(am, fabsf(og)); }
        ss += __shfl_xor(ss, 32); am = fmaxf(am, __shfl_xor(am, 32));
        if (h == 0) { ssx[(32 * qb + q) * 8 + w] = ss; amx[(32 * qb + q) * 8 + w] = am; } }
    LDS_WAIT(); __syncthreads();
    unsigned char* Mp = T.MIX + (size_t)(t0 + q) * DM + (ISB ? 512 : 0) + w * 64 + 8 * h;
#pragma unroll
    for (int qb = 0; qb < 2; ++qb) {
        const f32x4 s0 = *(const LAS f32x4*)(ssx + (32 * qb + q) * 8), s1 = *(const LAS f32x4*)(ssx + (32 * qb + q) * 8 + 4);
        const f32x4 a0 = *(const LAS f32x4*)(amx + (32 * qb + q) * 8), a1 = *(const LAS f32x4*)(amx + (32 * qb + q) * 8 + 4);
        const float tot = ((s0[0] + s0[1]) + (s0[2] + s0[3])) + ((s1[0] + s1[1]) + (s1[2] + s1[3]));
        const float amax = fmaxf(fmaxf(fmaxf(a0[0], a0[1]), fmaxf(a0[2], a0[3])), fmaxf(fmaxf(a1[0], a1[1]), fmaxf(a1[2], a1[3])));
        const float rn = __builtin_amdgcn_rsqf(tot * (1.0f / 512.0f) + EPS);
        const float qs = amax > 0.f ? 127.0f / amax : 0.f;
        if (w == 0 && h == 0) (ISB ? T.SMB : T.SMA)[t0 + 32 * qb + q] = amax > 0.f ? amax * rn * (1.0f / 127.0f) : 1.0f;
#pragma unroll
        for (int db = 0; db < 2; ++db)
#pragma unroll
            for (int gp = 0; gp < 2; ++gp) {
                const unsigned a = q8x4(O[qb][db][8 * gp + 0], O[qb][db][8 * gp + 1], O[qb][db][8 * gp + 2], O[qb][db][8 * gp + 3], qs), b = q8x4(O[qb][db][8 * gp + 4], O[qb][db][8 * gp + 5], O[qb][db][8 * gp + 6], O[qb][db][8 * gp + 7], qs);
                const u32x2 r = __builtin_amdgcn_permlane32_swap(a, b, false, false);
                *(u32x2*)(Mp + (size_t)(32 * qb) * DM + 32 * db + 16 * gp) = r; }
    }
    LDS_WAIT(); __syncthreads();
}
__device__ __forceinline__ f32x16 attn_qk_r(const bf16x8 (&kf)[4], const bf16x8 (&qf)[4], f32x16 S) {
#pragma unroll
    for (int s = 0; s < 4; ++s) S = __builtin_amdgcn_mfma_f32_32x32x16_bf16(kf[s], qf[s], S, 0, 0, 0);
    return S;
}
template <int I> struct AWin { static constexpr int W0 = I == 0 ? 0 : (I == 1 ? 8 : (I == 2 ? 24 : 32)); };
__device__ __forceinline__ void attn_a_load_k(bf16x8 (&kf)[4], const bf16* kp) {
#pragma unroll
    for (int s = 0; s < 4; ++s) kf[s] = *(const bf16x8*)(kp + 512 * s);
}
template <int I>
__device__ __forceinline__ void attn_a_load_v(bf16x8 (&vf)[2][2], const bf16* vp) {
    constexpr int W0 = AWin<I>::W0;
#pragma unroll
    for (int db = 0; db < 2; ++db)
#pragma unroll
        for (int s = 0; s < 2; ++s) {
            constexpr int dummy = 0; (void)dummy;
            const int c0 = W0 + 16 * s, c1 = W0 + 16 * s + 8;
            const s16x4 lo = *(const s16x4*)(vp + (c0 >> 5) * 2048 + (2 * db + ((c0 & 31) >> 4)) * 512 + (((c0 & 31) >> 3) & 1) * 4);
            const s16x4 hi = *(const s16x4*)(vp + (c1 >> 5) * 2048 + (2 * db + ((c1 & 31) >> 4)) * 512 + (((c1 & 31) >> 3) & 1) * 4);
            vf[db][s] = (bf16x8){lo[0], lo[1], lo[2], lo[3], hi[0], hi[1], hi[2], hi[3]}; }
}
__device__ __forceinline__ void attn_a_step(f32x16 (&O)[2], float& l, const bf16x8 (&kf)[4], const bf16x8 (&vf)[2][2], const bf16x8 (&qf)[4], const f32x16& C, const f32x16& Bv) {
    const f32x16 S = attn_qk_r(kf, qf, C);
    float ls0 = 0.f, ls1 = 0.f;
#pragma unroll
    for (int s2 = 0; s2 < 2; ++s2) {
        float p[8];
#pragma unroll
        for (int j = 0; j < 8; ++j) p[j] = __builtin_amdgcn_exp2f(S[8 * s2 + j] + Bv[8 * s2 + j]);
        ls0 += (p[0] + p[1]) + (p[2] + p[3]); ls1 += (p[4] + p[5]) + (p[6] + p[7]);
        attn_pv_half(O, p, vf, s2);
    }
    l += ls0 + ls1;
    __builtin_amdgcn_sched_barrier(0);
}
template <int I>
__device__ __forceinline__ void attn_a_block(Frame& F, const AttnPtrs& T, int t0, int sb, int r0, int rows, const LAS float* tabA4, const LAS float* tabM4, LAS float* ssx) {
    constexpr int W0 = AWin<I>::W0; constexpr int NT = MPAD / 32;
    const int lane = fresh_lane(), w = F.wave, n = lane & 31, h = lane >> 5;
    const int qrow = r0 + (n >> 4), qcol = 16 * I + (n & 15), tq = 64 * (n >> 4) + qcol;
    int rsq = qrow - 4; rsq = rsq < 0 ? 0 : (rsq > rows - 8 ? rows - 8 : rsq);
    int rs0 = r0 - 4; rs0 = rs0 < 0 ? 0 : (rs0 > rows - 8 ? rows - 8 : rs0);
    int rs1 = r0 - 3; rs1 = rs1 < 0 ? 0 : (rs1 > rows - 8 ? rows - 8 : rs1);
    const int nk = rs1 + 8 - rs0;
    int cs = qcol - 8; cs = cs < 0 ? 0 : (cs > 48 ? 48 : cs);
    const int imv = 63 + W0 + 4 * h - cs;
    const int ibb = 63 + W0 + 4 * h - qcol - 32 * qrow + 32 * 7;
    const int colk = W0 + n;
    const bf16* Kp = T.KA + (size_t)w * NT * 2048 + (size_t)(colk >> 5) * 2048 + (32 * h + (colk & 31)) * 8;
    const bf16* Vp = T.VAT + (size_t)w * NT * 2048 + (32 * h + n) * 8;
    const bf16* Qp = T.QA + ((size_t)w * NT + ((t0 + tq) >> 5)) * 2048 + (32 * h + ((t0 + tq) & 31)) * 8;
    bf16x8 kfX[4], kfY[4], vfX[2][2], vfY[2][2], qf[4];
    attn_load_k(kfX, T.KA + (size_t)w * NT * 2048 + (size_t)(MTOK >> 5) * 2048 + lane * 8); attn_load_v(vfX, T.VAT + (size_t)w * NT * 2048 + (size_t)(MTOK >> 5) * 2048 + lane * 8);
    { const size_t to = (size_t)((sb + 64 * rs0) >> 5) * 2048; attn_a_load_k(kfY, Kp + to); attn_a_load_v<I>(vfY, Vp + to); }
#pragma unroll
    for (int s = 0; s < 4; ++s) qf[s] = __builtin_nontemporal_load((const bf16x8*)(Qp + 512 * s));
    f32x16 O[2]; O[0] = (f32x16){}; O[1] = (f32x16){}; float l = 0.f;
    f32x16 Cc = attn_tab16(tabM4, TM_CS, ((unsigned)(rs0 - rsq) < 8u) ? imv : 96), Bc = attn_tab16(tabA4, TA_CS, ibb + 32 * rs0);
    { const f32x16 S = attn_qk_r(kfX, qf, (f32x16){}); float p[8], ls = 0.f;
#pragma unroll
      for (int r = 0; r < 8; ++r) { p[r] = __builtin_amdgcn_exp2f(S[r]); ls += p[r]; }
      l += ls; attn_pv_half(O, p, vfX, 0);
      __builtin_amdgcn_sched_barrier(0); }
#pragma unroll 1
    for (int k = 0; k + 1 < nk; k += 2) {
        { const int kr = rs0 + k + 1; const size_t to = (size_t)((sb + 64 * kr) >> 5) * 2048; attn_a_load_k(kfX, Kp + to); attn_a_load_v<I>(vfX, Vp + to); }
        const f32x16 Cn = attn_tab16(tabM4, TM_CS, ((unsigned)(rs0 + k + 1 - rsq) < 8u) ? imv : 96), Bn = attn_tab16(tabA4, TA_CS, ibb + 32 * (rs0 + k + 1));
        attn_a_step(O, l, kfY, vfY, qf, Cc, Bc);
        { const int kn = k + 2 < nk ? k + 2 : nk - 1; const int kr = rs0 + kn; const size_t to = (size_t)((sb + 64 * kr) >> 5) * 2048; attn_a_load_k(kfY, Kp + to); attn_a_load_v<I>(vfY, Vp + to);
          Cc = attn_tab16(tabM4, TM_CS, ((unsigned)(kr - rsq) < 8u) ? imv : 96); Bc = attn_tab16(tabA4, TA_CS, ibb + 32 * kr); }
        attn_a_step(O, l, kfX, vfX, qf, Cn, Bn);
    }
    if (nk & 1) attn_a_step(O, l, kfY, vfY, qf, Cc, Bc);
    f32x4 gvv[2][4];
    { const float* gain = T.ona + w * 64 + 4 * h;
#pragma unroll
      for (int db = 0; db < 2; ++db)
#pragma unroll
          for (int g = 0; g < 4; ++g) gvv[db][g] = *(const f32x4*)(gain + 32 * db + 8 * g); }
    { const float lt = l + __shfl_xor(l, 32); const float inv = __builtin_amdgcn_rcpf(lt);
      float ss = 0.f, am = 0.f;
#pragma unroll
      for (int db = 0; db < 2; ++db)
#pragma unroll
          for (int rg = 0; rg < 16; ++rg) { const float o = O[db][rg] * inv; ss += o * o; const float og = o * gvv[db][rg >> 2][rg & 3]; O[db][rg] = og; am = fmaxf(am, fabsf(og)); }
      ss += __shfl_xor(ss, 32); am = fmaxf(am, __shfl_xor(am, 32));
      if (h == 0) { ssx[n * 8 + w] = ss; (ssx + 16896)[n * 8 + w] = am; } }
    LDS_WAIT(); __syncthreads();
    { unsigned char* Mp = T.MIX + (size_t)(t0 + tq) * DM + w * 64 + 8 * h;
      const LAS float* amx = ssx + 16896;
      const f32x4 s0 = *(const LAS f32x4*)(ssx + n * 8), s1 = *(const LAS f32x4*)(ssx + n * 8 + 4);
      const f32x4 a0 = *(const LAS f32x4*)(amx + n * 8), a1 = *(const LAS f32x4*)(amx + n * 8 + 4);
      const float tot = ((s0[0] + s0[1]) + (s0[2] + s0[3])) + ((s1[0] + s1[1]) + (s1[2] + s1[3]));
      const float amax = fmaxf(fmaxf(fmaxf(a0[0], a0[1]), fmaxf(a0[2], a0[3])), fmaxf(fmaxf(a1[0], a1[1]), fmaxf(a1[2], a1[3])));
      const float rn = __builtin_amdgcn_rsqf(tot * (1.0f / 512.0f) + EPS);
      const float qs = amax > 0.f ? 127.0f / amax : 0.f;
      if (w == 0 && h == 0) T.SMA[t0 + tq] = amax > 0.f ? amax * rn * (1.0f / 127.0f) : 1.0f;
#pragma unroll
      for (int db = 0; db < 2; ++db)
#pragma unroll
          for (int gp = 0; gp < 2; ++gp) {
              const unsigned a = q8x4(O[db][8 * gp + 0], O[db][8 * gp + 1], O[db][8 * gp + 2], O[db][8 * gp + 3], qs), b = q8x4(O[db][8 * gp + 4], O[db][8 * gp + 5], O[db][8 * gp + 6], O[db][8 * gp + 7], qs);
              const u32x2 r = __builtin_amdgcn_permlane32_swap(a, b, false, false);
              *(u32x2*)(Mp + 32 * db + 16 * gp) = r; } }
    LDS_WAIT(); __syncthreads();
}
__device__ __forceinline__ void attn_a_unit(Frame& F, const AttnPtrs& T, int t0, const LAS float* tabA4, const LAS float* tabM4, LAS float* ssx) {
    int sb, N; if (t0 < 16384) { sb = t0 & ~8191; N = 8192; } else { sb = 16384 + ((t0 - 16384) & ~4095); N = 4096; }
    const int r0 = (t0 - sb) >> 6, rows = N >> 6;
    attn_a_block<0>(F, T, t0, sb, r0, rows, tabA4, tabM4, ssx);
    attn_a_block<1>(F, T, t0, sb, r0, rows, tabA4, tabM4, ssx);
    attn_a_block<2>(F, T, t0, sb, r0, rows, tabA4, tabM4, ssx);
    attn_a_block<3>(F, T, t0, sb, r0, rows, tabA4, tabM4, ssx);
}
__device__ __forceinline__ void attn_phase(Frame& F, const AttnPtrs& T, const float* rpb, const float* t5, const float* sink) {
    const int lane = fresh_lane(), w = F.wave;
    LAS float* tabAB = (LAS float*)(F.lds + RING_OFF + w * 10240);
    LAS float* tabM = (LAS float*)(F.lds + RING_OFF + 81920);
    LAS float* ssx = (LAS float*)(F.lds + RING_OFF + 84480);
    LAS bf16x8* qlds = (LAS bf16x8*)(F.lds + RING_OFF + 86528 + w * 8192);
    for (int i = lane; i < 4 * TA_CS; i += 64) tabAB[i] = 0.f;
#pragma unroll
    for (int k = 0; k < 8; ++k) { int i = lane + 64 * k; i = i < 465 ? i : 464; const int dr = i / 31, dc = i - 31 * dr; const float v = rpb[w * 465 + i] * LOG2E; const int pos = 48 + 32 * dr + dc;
#pragma unroll
        for (int a = 0; a < 4; ++a) tabAB[a * TA_CS + pos - a] = v; }
    if (w == 0) for (int i = lane; i < TM_CS; i += 64) { const float v = (i >= 63 && i < 79) ? 0.f : -INFINITY;
#pragma unroll
        for (int a = 0; a < 4; ++a) if (i - a >= 0) tabM[a * TM_CS + i - a] = v; }
    const float sinkexp = __builtin_amdgcn_exp2f(sink[w] * LOG2E);
    LDS_WAIT(); __syncthreads();
#pragma unroll 1
    for (int u = F.vcu; u < 256; u += F.G) attn_a_unit(F, T, u * 128, tabAB, tabM, ssx);
#pragma unroll
    for (int k = 0; k < 6; ++k) { int i = lane + 64 * k; i = i < TB_CS ? i : TB_CS - 1; const int rel = i - 160; int n = rel < 0 ? -rel : rel; const bool ok = n <= 128; n = ok ? n : 128;
        const int lg = n < 8 ? n : (33 - __clz(n * n)); const int bk = (rel > 0 ? 16 : 0) + (lg > 15 ? 15 : lg); float v = t5[bk * 8 + w] * LOG2E; v = ok ? v : -INFINITY;
#pragma unroll
        for (int a = 0; a < 4; ++a) if (i - a >= 0) tabAB[a * TB_CS + i - a] = v; }
    LDS_WAIT(); asm volatile("" ::: "memory");
#pragma unroll 1
    for (int u = F.vcu; u < 512; u += F.G) attn_unit<true>(F, T, u * 64, tabAB, tabM, sinkexp, ssx, qlds);
}
template <bool NORM>
__device__ __forceinline__ void quant_rows(const bf16* src, signed char* dstq, float* scl, int nrows, int worker, int nworkers) {
    const int lane = threadIdx.x & 63;
    for (int m0 = worker; m0 < nrows; m0 += 4 * nworkers) {
        v4u v[4][2];
#pragma unroll
        for (int b = 0; b < 4; ++b) { int m = m0 + b * nworkers; m = m < nrows ? m : nrows - 1; const bf16* sp = src + (size_t)m * DM;
            v[b][0] = *(const GAS v4u*)(sp + lane * 16); v[b][1] = *(const GAS v4u*)(sp + lane * 16 + 8); }
#pragma unroll
        for (int b = 0; b < 4; ++b) { const int m = m0 + b * nworkers; if (m >= nrows) continue;
            float x[16];
#pragma unroll
            for (int k = 0; k < 2; ++k) { const v4u w = v[b][k];
                x[8 * k + 0] = __uint_as_float(w.x << 16); x[8 * k + 1] = __uint_as_float(w.x & 0xffff0000u); x[8 * k + 2] = __uint_as_float(w.y << 16); x[8 * k + 3] = __uint_as_float(w.y & 0xffff0000u);
                x[8 * k + 4] = __uint_as_float(w.z << 16); x[8 * k + 5] = __uint_as_float(w.z & 0xffff0000u); x[8 * k + 6] = __uint_as_float(w.w << 16); x[8 * k + 7] = __uint_as_float(w.w & 0xffff0000u); }
            float am = 0.f, ss = 0.f;
#pragma unroll
            for (int i = 0; i < 16; ++i) { am = fmaxf(am, fabsf(x[i])); ss += x[i] * x[i]; }
#pragma unroll
            for (int o = 1; o < 64; o <<= 1) { am = fmaxf(am, __shfl_xor(am, o)); if (NORM) ss += __shfl_xor(ss, o); }
            const float sc = am > 0.f ? am * (1.0f / 127.0f) : 1.0f, qs = am > 0.f ? 127.0f / am : 0.f;
            v4u q; q.x = q8x4(x[0], x[1], x[2], x[3], qs); q.y = q8x4(x[4], x[5], x[6], x[7], qs); q.z = q8x4(x[8], x[9], x[10], x[11], qs); q.w = q8x4(x[12], x[13], x[14], x[15], qs);
            *(GAS v4u*)(dstq + (size_t)m * DM + lane * 16) = q;
            if (lane == 0) scl[m] = NORM ? sc * __builtin_amdgcn_rsqf(ss * (1.0f / 1024.0f) + EPS) : sc;
        }
    }
}
#ifndef PROBE_PHASE
#define PROBE_PHASE -1
#endif
#ifndef MK_N_LAUNCHES
#define MK_N_LAUNCHES 1
#endif
constexpr int N_LAUNCHES = MK_N_LAUNCHES;
constexpr int PER_PHASE = 7;
struct Args { const float* in[19]; float* out; unsigned char* ws; int ph_lo, ph_hi, li, pad; };
__global__ void __launch_bounds__(NWAVES * 64, 2) hybrid_fwd(Args args_by_value) {
    __shared__ __attribute__((aligned(16))) unsigned char lds[LDS_BYTES];
    typedef const __attribute__((address_space(4))) Args* KArgs;
#define ENV() KArgs ap_ = (KArgs)__builtin_amdgcn_kernarg_segment_ptr(); asm volatile("" : "+s"(ap_)); \
    unsigned char* ws = ap_->ws; unsigned char* dout = (unsigned char*)ap_->out; \
    Frame F; F.lds = (LAS unsigned char*)lds; F.MISC = (volatile LAS unsigned*)(F.lds + MISC_OFF); F.wave = __builtin_amdgcn_readfirstlane((int)threadIdx.x >> 6); \
    F.G = gridDim.x; { const int bx = blockIdx.x; F.vcu = (F.G % 8 == 0) ? (bx % 8) * (F.G / 8) + bx / 8 : bx; } F.ctl = (gu32*)(ws + WS_CTL); \
    XcdBarrier bar; bar.bar = (unsigned*)(F.ctl + CW_BAR) + ap_->li * XCD_BAR_WORDS; bar.x = xb_xcc_id(); bar.st = F.MISC + 8; (void)dout; (void)bar
#define AIN(k) ((const float*)ap_->in[k])
    (void)args_by_value;
    int lo, hi;
    { ENV(); lo = ap_->ph_lo; hi = ap_->ph_hi;
      for (int u = threadIdx.x; u < (LDS_BYTES - LDSCTL_OFF) / 4; u += NWAVES * 64) ((LAS unsigned*)(F.lds + LDSCTL_OFF))[u] = 0u;
      __syncthreads();
      if (N_LAUNCHES != PER_PHASE) (void)xcd_barrier_post((unsigned*)(F.ctl + CW_BAR) + ap_->li * XCD_BAR_WORDS, F.MISC + 8); }
#define GRID_BAR() do { if (N_LAUNCHES != PER_PHASE) xcd_barrier(bar); } while (0)
#define LOCAL_BAR() do { if (N_LAUNCHES != PER_PHASE) xcd_local_barrier(bar); } while (0)
#ifndef PH_MASK
#define PH_MASK 127
#endif
#define IN(k) (((PH_MASK >> (k)) & 1) && lo <= (k) && (k) < hi)
#define BOTH(k) (IN(k) && IN((k) + 1))
#define P1_RAGGED() const int p1_units = (MPAD / 256) * (NIN / 256), p1_last = (p1_units - 1) / (int)gridDim.x, p1_busy = p1_units - p1_last * (int)gridDim.x, p1_idle = (int)gridDim.x - p1_busy; const bool defer_w = p1_idle >= 64
    if (IN(0)) { ENV(); P1_RAGGED(); p0_prologue(F, AIN(0), AIN(1), AIN(2), AIN(4), AIN(5), AIN(14), AIN(15), AIN(16), AIN(17), AIN(18),
            (bf16*)(ws + WS_WIN), (signed char*)(ws + WS_WOQ), (float*)(ws + WS_SWO), (signed char*)(ws + WS_WGQ), (float*)(ws + WS_SW), (bf16*)(ws + WS_WDN), (bf16*)(ws + WS_XN), (float*)(ws + WS_R1), defer_w); if (BOTH(0)) GRID_BAR(); }
    if (IN(1)) { ENV();
        pg8::Gemm g{(bf16*)(ws + WS_XN), (bf16*)(ws + WS_WIN), MPAD, NIN, DM}; pg8::StaticOrder S; S.init(MPAD, NIN, F.G, (int)blockIdx.x);
        pg8::EpiQKV E{ws, (PG8_LAS unsigned char*)(F.lds + RING_OFF + RING_BYTES), AIN(6), AIN(7), AIN(9), AIN(10), WS_QA, WS_KA, WS_VAT, WS_QB, WS_KB, WS_VBT, WS_R1};
        pg8::gemm_phase<pg8::EpiQKV, pg8::StaticOrder, true, true>(F.lds + RING_OFF, g, S, E);
    }
    if (IN(1)) { ENV();
        P1_RAGGED();
        if (defer_w && (int)blockIdx.x >= p1_busy) {
            p0_weight_tasks(F, AIN(14), AIN(15), AIN(16), AIN(17), (signed char*)(ws + WS_WOQ), (float*)(ws + WS_SWO), (signed char*)(ws + WS_WGQ), (float*)(ws + WS_SW), (int)blockIdx.x - p1_busy, p1_idle);
            p0_weight_items(F, AIN(4), AIN(5), AIN(18), (bf16*)(ws + WS_WIN), (bf16*)(ws + WS_WDN),
                            (LAS float*)(F.lds + RING_OFF + F.wave * 16384), P0_I_IN, P0_NITEMS, ((int)blockIdx.x - p1_busy) * NWAVES + F.wave, p1_idle * NWAVES);
        }
        if (BOTH(1)) GRID_BAR();
    }
    if (IN(2)) { ENV(); const AttnPtrs T{(bf16*)(ws + WS_QA), (bf16*)(ws + WS_KA), (bf16*)(ws + WS_VAT), (bf16*)(ws + WS_QB), (bf16*)(ws + WS_KB), (bf16*)(ws + WS_VBT), ws + WS_MIX, (float*)(ws + WS_SMA), (float*)(ws + WS_SMB), AIN(12), AIN(13)};
        attn_phase(F, T, AIN(8), AIN(3), AIN(11)); if (BOTH(2)) GRID_BAR(); }
    if (IN(3)) { ENV(); const XcdEnv xe = xcd_env(bar);
        pg8::Gemm g{(bf16*)(ws + WS_MIX), (bf16*)(ws + WS_WOQ), MTOK, DM, DM / 2}; pg8::XcdOrder S; S.init(MTOK, DM, xe.nloc, xe.rank, xe.nx, xe.xi);
        pg8::EpiOut E{(bf16*)(ws + WS_XN), (bf16*)(ws + WS_X1B), (const float*)(ws + WS_SMA), (const float*)(ws + WS_SMB), (const float*)(ws + WS_SWO)};
        pg8::gemm_phase<pg8::EpiOut, pg8::XcdOrder, true, true>(F.lds + RING_OFF, g, S, E);
        if (BOTH(3)) LOCAL_BAR();
    }
    if (IN(4)) { ENV(); const XcdEnv xe = xcd_env(bar);
        const int nM = MTOK / 256, r0 = (int)((long)xe.xi * nM / xe.nx) * 256, r1 = (int)((long)(xe.xi + 1) * nM / xe.nx) * 256;
        quant_rows<true>((const bf16*)(ws + WS_X1B) + (size_t)r0 * DM, (signed char*)(ws + WS_X1Q) + (size_t)r0 * DM, (float*)(ws + WS_SX) + r0, r1 - r0, xe.rank * NWAVES + F.wave, xe.nloc * NWAVES);
        if (BOTH(4)) LOCAL_BAR(); }
    if (IN(5)) { ENV(); const XcdEnv xe = xcd_env(bar);
        pg8::Gemm g{(bf16*)(ws + WS_X1Q), (bf16*)(ws + WS_WGQ), MTOK, NGU, DM / 2}; pg8::XcdOrder S; S.init(MTOK, NGU, xe.nloc, xe.rank, xe.nx, xe.xi);
        pg8::EpiGU E{nullptr, (const float*)(ws + WS_SX), (const float*)(ws + WS_SW), (bf16*)(ws + WS_H)};
        pg8::gemm_phase<pg8::EpiGU, pg8::XcdOrder, true, true>(F.lds + RING_OFF, g, S, E);
        if (BOTH(5)) LOCAL_BAR();
    }
    if (IN(6)) { ENV(); const XcdEnv xe = xcd_env(bar);
        pg8::Gemm g{(bf16*)(ws + WS_H), (bf16*)(ws + WS_WDN), MTOK, DM, DFF}; pg8::XcdOrder S; S.init(MTOK, DM, xe.nloc, xe.rank, xe.nx, xe.xi);
        pg8::EpiDown E{(bf16*)(ws + WS_X1B), (float*)ap_->out};
        pg8::gemm_phase<pg8::EpiDown, pg8::XcdOrder, true, true>(F.lds + RING_OFF, g, S, E);
    }
#undef IN
#undef BOTH
}

extern "C" void kernel_launch(void* const* d_in, const int* in_sizes, int n_in, void* d_out, int out_size, void* d_ws, size_t ws_size, hipStream_t stream) {
    static int grid = 0;
    if (grid == 0) {
        if (n_in != 19 || out_size != MTOK * DM || ws_size < WS_END) { fprintf(stderr, "kernel_launch: unexpected shapes: n_in %d out %d ws %zu; nothing launched\n", n_in, out_size, ws_size); grid = -1; return; }
        int dev = 0, cus = 0;
        if (hipGetDevice(&dev) != hipSuccess || hipDeviceGetAttribute(&cus, hipDeviceAttributeMultiprocessorCount, dev) != hipSuccess) { grid = -1; return; }
        (void)hipGetLastError();
        grid = cus;
    }
    if (grid < 0) return;
    if (hipMemsetAsync((char*)d_ws + WS_CTL, 0, CTL_ZERO_BYTES, stream) != hipSuccess) { fprintf(stderr, "kernel_launch: memset failed\n"); return; }
    Args a{};
    for (int i = 0; i < 19; ++i) a.in[i] = (const float*)d_in[i];
    a.out = (float*)d_out; a.ws = (unsigned char*)d_ws;
#if PROBE_PHASE >= 0
    const int nl = 2; const int los[2] = {0, PROBE_PHASE}, his[2] = {PROBE_PHASE + 1, PER_PHASE};
#else
    const int nl = N_LAUNCHES;
#endif
    for (int li = 0; li < nl; ++li) {
#if PROBE_PHASE >= 0
        a.ph_lo = los[li]; a.ph_hi = his[li]; a.li = li;
#else
        a.ph_lo = (N_LAUNCHES == PER_PHASE) ? li : 0; a.ph_hi = (N_LAUNCHES == PER_PHASE) ? li + 1 : PER_PHASE; a.li = 0;
#endif
        hipLaunchKernelGGL(hybrid_fwd, dim3(grid), dim3(NWAVES * 64), 0, stream, a);
        const hipError_t le = hipPeekAtLastError();
        if (le != hipSuccess) { fprintf(stderr, "kernel_launch: launch %d failed: %s\n", li, hipGetErrorName(le)); break; }
    }
}
```

```cpp
#include <hip/hip_runtime.h>
#include <cstdio>
#include <cstdint>
namespace pg8 {
#define PG8_LAS __attribute__((address_space(3)))
typedef unsigned short bf16_t;
typedef short bf16x8 __attribute__((ext_vector_type(8)));
typedef float f32x4 __attribute__((ext_vector_type(4)));
typedef unsigned u32x4 __attribute__((ext_vector_type(4)));
typedef int i32x4 __attribute__((ext_vector_type(4)));
constexpr int BM = 256, BK = 64, HALF = 128, HTB = HALF * BK * 2  , STAGE_BYTES = 8 * HTB, NXCD = 8, WGM = 8;

__host__ __device__ __forceinline__ int lds_byte(int r, int c) { const int st = (r >> 4) * 2 + (c >> 5), rr = r & 15, cc = c & 31, ob = rr * 64 + cc * 2; return st * 1024 + (ob ^ (((ob >> 9) & 1) << 5)); }
__host__ __device__ __forceinline__ void stage_rc(int b, int& R, int& C) { const int st = b / 1024, sb = b % 1024, swz = sb ^ (((sb >> 9) & 1) << 5); R = (st >> 1) * 16 + swz / 64; C = (st & 1) * 32 + (swz % 64) / 2; }
__host__ __device__ __forceinline__ int perm32(int rho) { const int n = rho >> 4, i = rho & 15; return 8 * (i >> 2) + 4 * n + (i & 3); }

struct Unit { int pm, pn; };
struct Gemm { const bf16_t* A; const bf16_t* Bt; int M, N, K; };

struct StaticOrder {
    int nM, nN, nwg, G, c;
    __host__ __device__ void init(int M, int N, int G_, int c_) { nM = M / BM; nN = N / BM; nwg = nM * nN; G = G_; c = c_; }
    __host__ __device__ bool next(int i, Unit& u) const {
        const long L = (long)i * G + c; if (L >= nwg) return false;
        int wgid = (int)L; { const int q = nwg / NXCD, r = nwg % NXCD, xcd = wgid % NXCD, off = wgid / NXCD; wgid = (xcd < r ? xcd * (q + 1) : r * (q + 1) + (xcd - r) * q) + off; }
        const int nig = WGM * nN, gid = wgid / nig, fm = gid * WGM, gsz = (nM - fm) < WGM ? (nM - fm) : WGM;
        u.pm = fm + ((wgid % nig) % gsz); u.pn = (wgid % nig) / gsz; return true;
    }
    __device__ __forceinline__ void a_ready(const Unit&) const {}
    __device__ __forceinline__ void done(const Unit&) const {}
};

struct XcdOrder {
    int nN, p0, cnt, nloc, rank;
    __host__ __device__ void init(int M, int N, int nloc_, int rank_, int nx, int xi) { const int nM = M / BM; nN = N / BM; p0 = (int)((long)xi * nM / nx); const int p1 = (int)((long)(xi + 1) * nM / nx); cnt = (p1 - p0) * nN; nloc = nloc_; rank = rank_; }
    __host__ __device__ bool next(int i, Unit& u) const {
        const long L = (long)i * nloc + rank; if (L >= cnt) return false;
        const int w = (int)L, np = cnt / nN, nig = WGM * nN, gid = w / nig, fm = gid * WGM, gsz = (np - fm) < WGM ? (np - fm) : WGM;
        u.pm = p0 + fm + ((w % nig) % gsz); u.pn = (w % nig) / gsz; return true;
    }
    __device__ __forceinline__ void a_ready(const Unit&) const {}
    __device__ __forceinline__ void done(const Unit&) const {}
};
struct RevOrder {
    StaticOrder s;
    __host__ __device__ void init(int M, int N, int G_, int c_) { s.init(M, N, G_, c_); }
    __host__ __device__ bool next(int i, Unit& u) const { const bool r = s.next(i, u); u.pm = s.nM - 1 - u.pm; return r; }
    __device__ __forceinline__ void a_ready(const Unit&) const {}
    __device__ __forceinline__ void done(const Unit&) const {}
};

typedef float f32x2_t __attribute__((ext_vector_type(2))); typedef __bf16 bf16x2_t __attribute__((ext_vector_type(2)));
__device__ __forceinline__ unsigned cvt_pk_bf16(float lo, float hi) { f32x2_t v = {lo, hi}; bf16x2_t b = __builtin_convertvector(v, bf16x2_t); return __builtin_bit_cast(unsigned, b); }
constexpr int MP_ROWS = 33024;
constexpr float RMS_EPS = 1e-6f;
constexpr float QSCALE = 0.125f * 1.4426950408889634f;

struct EpiQKV {
    typedef f32x4 acc_t;
    static constexpr bool PERM = true, AFTER_DRAIN = false, MIDK = false;
    unsigned char* ws; PG8_LAS unsigned char* vtl; const float *qna, *kna, *qnb, *knb;
    size_t oQA, oKA, oVAt, oQB, oKB, oVBt, oR1;
    __device__ __forceinline__ void operator()(const f32x4 (&acc)[2][2][4][2], const Unit& u, int wr, int wc, int fr, int fq) const {
        constexpr int NT = MP_ROWS / 32;
        const int pn = u.pn, row0 = u.pm * BM + wr * 64 + fr, sec = pn >> 1;
        bf16_t* dst; int head = 4 * (pn & 1) + wc; const float* gain = nullptr; float sc = 1.f; bool isV = false;
        const float* R1 = (const float*)(ws + oR1);
        if (sec == 0) { dst = (bf16_t*)(ws + oQA); gain = qna; sc = QSCALE; }
        else if (sec == 1) { dst = (bf16_t*)(ws + oKA); gain = kna; }
        else if (sec == 2) { dst = (bf16_t*)(ws + oVAt); isV = true; }
        else if (sec == 3) { dst = (bf16_t*)(ws + oQB); gain = qnb; sc = QSCALE; }
        else { if (wc < 2) { dst = (bf16_t*)(ws + oKB); head = wc; gain = knb; } else { dst = (bf16_t*)(ws + oVBt); head = wc - 2; isV = true; } }
        bf16_t* hbase = dst + (size_t)head * NT * 2048;
#define EPI_R1V() float r1v[2][4]; _Pragma("unroll") for (int ai = 0; ai < 2; ++ai) _Pragma("unroll") for (int m = 0; m < 4; ++m) r1v[ai][m] = R1[row0 + ai * HALF + m * 16]
        if (!isV) {
            EPI_R1V();
            f32x4 gv[2][2];
#pragma unroll
            for (int bj = 0; bj < 2; ++bj)
#pragma unroll
                for (int n = 0; n < 2; ++n) gv[bj][n] = *(const f32x4*)(gain + 32 * bj + 8 * fq + 4 * n) * sc;
#pragma unroll
            for (int ai = 0; ai < 2; ++ai)
#pragma unroll
                for (int m = 0; m < 4; ++m) {
                    float ss = 0.f;
#pragma unroll
                    for (int bj = 0; bj < 2; ++bj)
#pragma unroll
                        for (int n = 0; n < 2; ++n) { const f32x4 x = acc[ai][bj][m][n]; ss += (x[0] * x[0] + x[1] * x[1]) + (x[2] * x[2] + x[3] * x[3]); }
                    ss += __shfl_xor(ss, 16); ss += __shfl_xor(ss, 32);
                    const int row = row0 + ai * HALF + m * 16;
                    const float r1 = r1v[ai][m];
                    const float r = r1 * __builtin_amdgcn_rsqf(ss * (r1 * r1) * (1.0f / 64.0f) + RMS_EPS);
                    bf16_t* rowp = hbase + (size_t)(row >> 5) * 2048 + (fq >> 1) * 512 + ((fq & 1) * 32 + (row & 31)) * 8;
#pragma unroll
                    for (int bj = 0; bj < 2; ++bj) { const f32x4 v0 = acc[ai][bj][m][0] * r * gv[bj][0], v1 = acc[ai][bj][m][1] * r * gv[bj][1];
                        u32x4 w; w.x = cvt_pk_bf16(v0[0], v0[1]); w.y = cvt_pk_bf16(v0[2], v0[3]); w.z = cvt_pk_bf16(v1[0], v1[1]); w.w = cvt_pk_bf16(v1[2], v1[3]);
                        *(u32x4*)(rowp + bj * 1024) = w; }
                }
        } else {
            EPI_R1V();
            PG8_LAS unsigned short* vt = (PG8_LAS unsigned short*)(vtl + (wr * 4 + wc) * 2048);
            const int hh = (fr >> 2) & 1, jj = 4 * ((fr >> 3) & 1) + (fr & 3), wofs = (32 * hh + 8 * fq) * 8 + jj, ln = fq * 16 + fr;
#pragma unroll
            for (int ai = 0; ai < 2; ++ai)
#pragma unroll
                for (int m = 0; m < 4; ++m) { const int row = row0 + ai * HALF + m * 16; const float r1 = r1v[ai][m];
                    bf16_t* tb = hbase + (size_t)(row >> 5) * 2048 + (m & 1) * 512 + ln * 8;
#pragma unroll
                    for (int bj = 0; bj < 2; ++bj) { PG8_LAS unsigned short* buf = vt + bj * 512;
#pragma unroll
                        for (int n = 0; n < 2; ++n) { const f32x4 x = acc[ai][bj][m][n] * r1; const unsigned w0 = cvt_pk_bf16(x[0], x[1]), w1 = cvt_pk_bf16(x[2], x[3]);
                            buf[wofs + (4 * n + 0) * 8] = (unsigned short)(w0 & 0xffffu); buf[wofs + (4 * n + 1) * 8] = (unsigned short)(w0 >> 16);
                            buf[wofs + (4 * n + 2) * 8] = (unsigned short)(w1 & 0xffffu); buf[wofs + (4 * n + 3) * 8] = (unsigned short)(w1 >> 16); }
                        const u32x4 w = *(const PG8_LAS u32x4*)(buf + ln * 8);
                        *(u32x4*)(tb + bj * 1024) = w; }
                }
        }
    }
};
struct EpiOut {
    typedef i32x4 acc_t;
    static constexpr bool PERM = true, AFTER_DRAIN = false, MIDK = true;
    const bf16_t* XB; bf16_t* X1B; const float *SMA, *SMB, *SWO;
    __device__ __forceinline__ void pre(float (&rsc)[2][4], const Unit& u, int wr, int fr) const {
        const int row0 = u.pm * BM + wr * 64 + fr; float sa[2][4], sb[2][4];
#pragma unroll
        for (int ai = 0; ai < 2; ++ai)
#pragma unroll
            for (int m = 0; m < 4; ++m) { sa[ai][m] = SMA[row0 + ai * HALF + m * 16]; sb[ai][m] = SMB[row0 + ai * HALF + m * 16]; }
#pragma unroll
        for (int ai = 0; ai < 2; ++ai)
#pragma unroll
            for (int m = 0; m < 4; ++m) rsc[ai][m] = sa[ai][m] / sb[ai][m];
    }
    __device__ __forceinline__ void mid(i32x4 (&acc)[2][2][4][2], const float (&rsc)[2][4]) const {
#pragma unroll
        for (int ai = 0; ai < 2; ++ai)
#pragma unroll
            for (int bj = 0; bj < 2; ++bj)
#pragma unroll
                for (int m = 0; m < 4; ++m)
#pragma unroll
                    for (int n = 0; n < 2; ++n)
#pragma unroll
                        for (int i = 0; i < 4; ++i) acc[ai][bj][m][n][i] = (int)__builtin_rintf((float)acc[ai][bj][m][n][i] * rsc[ai][m]);
    }
    __device__ __forceinline__ void operator()(const i32x4 (&acc)[2][2][4][2], const Unit& u, int wr, int wc, int fr, int fq) const {
        const int row0 = u.pm * BM + wr * 64 + fr, colb = u.pn * BM + wc * 32 + 8 * fq;
        f32x4 swv[2][2];
#pragma unroll
        for (int bj = 0; bj < 2; ++bj)
#pragma unroll
            for (int n = 0; n < 2; ++n) swv[bj][n] = *(const f32x4*)(SWO + colb + bj * HALF + 4 * n);
#pragma unroll
        for (int ai = 0; ai < 2; ++ai) {
            u32x4 xb[4][2]; float sb[4];
#pragma unroll
            for (int m = 0; m < 4; ++m) { sb[m] = SMB[row0 + ai * HALF + m * 16];
#pragma unroll
                for (int bj = 0; bj < 2; ++bj) xb[m][bj] = __builtin_nontemporal_load((const u32x4*)(XB + (size_t)(row0 + ai * HALF + m * 16) * 1024 + colb + bj * HALF)); }
#pragma unroll
            for (int m = 0; m < 4; ++m) { const int row = row0 + ai * HALF + m * 16;
#pragma unroll
                for (int bj = 0; bj < 2; ++bj) { const u32x4 w = xb[m][bj];
                    f32x4 x0, x1; x0[0] = __uint_as_float(w.x << 16); x0[1] = __uint_as_float(w.x & 0xffff0000u); x0[2] = __uint_as_float(w.y << 16); x0[3] = __uint_as_float(w.y & 0xffff0000u);
                    x1[0] = __uint_as_float(w.z << 16); x1[1] = __uint_as_float(w.z & 0xffff0000u); x1[2] = __uint_as_float(w.w << 16); x1[3] = __uint_as_float(w.w & 0xffff0000u);
                    f32x4 v0, v1;
#pragma unroll
                    for (int i = 0; i < 4; ++i) { v0[i] = (float)acc[ai][bj][m][0][i] * (sb[m] * swv[bj][0][i]) + x0[i]; v1[i] = (float)acc[ai][bj][m][1][i] * (sb[m] * swv[bj][1][i]) + x1[i]; }
                    u32x4 o; o.x = cvt_pk_bf16(v0[0], v0[1]); o.y = cvt_pk_bf16(v0[2], v0[3]); o.z = cvt_pk_bf16(v1[0], v1[1]); o.w = cvt_pk_bf16(v1[2], v1[3]);
                    *(u32x4*)(X1B + (size_t)row * 1024 + colb + bj * HALF) = o; }
            }
        }
    }
};
struct EpiGU {
    typedef i32x4 acc_t;
    static constexpr bool PERM = true, AFTER_DRAIN = false, MIDK = false;
    const float *SS2, *SX, *SW; bf16_t* H;
    __device__ __forceinline__ void operator()(const i32x4 (&acc)[2][2][4][2], const Unit& u, int wr, int wc, int fr, int fq) const {
        const int row0 = u.pm * BM + wr * 64 + fr, colb = u.pn * HALF + wc * 32 + 8 * fq;
        float sx[2][4];
#pragma unroll
        for (int ai = 0; ai < 2; ++ai)
#pragma unroll
            for (int m = 0; m < 4; ++m) sx[ai][m] = SX[row0 + ai * HALF + m * 16];
        const float swg = SW[u.pn * BM + wc * 32], swu = SW[u.pn * BM + HALF + wc * 32];
#pragma unroll
        for (int ai = 0; ai < 2; ++ai)
#pragma unroll
            for (int m = 0; m < 4; ++m) { const int row = row0 + ai * HALF + m * 16;
                const float r = sx[ai][m], rg = r * swg, as = rg * -1.4426950408889634f, hs = rg * (r * swu);
                float hv[8];
#pragma unroll
                for (int n = 0; n < 2; ++n)
#pragma unroll
                    for (int i = 0; i < 4; ++i) { const float ag = (float)acc[ai][0][m][n][i], au = (float)acc[ai][1][m][n][i];
                        const float e = __builtin_amdgcn_exp2f(ag * as); hv[4 * n + i] = ((ag * au) * hs) * __builtin_amdgcn_rcpf(1.0f + e); }
                u32x4 w; w.x = cvt_pk_bf16(hv[0], hv[1]); w.y = cvt_pk_bf16(hv[2], hv[3]); w.z = cvt_pk_bf16(hv[4], hv[5]); w.w = cvt_pk_bf16(hv[6], hv[7]);
                *(u32x4*)(H + (size_t)row * 2816 + colb) = w;
            }
    }
};
struct EpiDown {
    typedef f32x4 acc_t;
    static constexpr bool PERM = true, AFTER_DRAIN = false, MIDK = false;
    const bf16_t* X1B; float* out;
    __device__ __forceinline__ void operator()(const f32x4 (&acc)[2][2][4][2], const Unit& u, int wr, int wc, int fr, int fq) const {
        const int row0 = u.pm * BM + wr * 64 + fr, colb = u.pn * BM + wc * 32 + 8 * fq;
        u32x4 xb[2][4][2];
#pragma unroll
        for (int ai = 0; ai < 2; ++ai)
#pragma unroll
            for (int m = 0; m < 4; ++m)
#pragma unroll
                for (int bj = 0; bj < 2; ++bj) xb[ai][m][bj] = __builtin_nontemporal_load((const u32x4*)(X1B + (size_t)(row0 + ai * HALF + m * 16) * 1024 + colb + bj * HALF));
#pragma unroll
        for (int ai = 0; ai < 2; ++ai)
#pragma unroll
            for (int m = 0; m < 4; ++m) { const size_t off = (size_t)(row0 + ai * HALF + m * 16) * 1024 + colb;
#pragma unroll
                for (int bj = 0; bj < 2; ++bj) { const u32x4 w = xb[ai][m][bj];
                    f32x4 x0, x1; x0[0] = __uint_as_float(w.x << 16); x0[1] = __uint_as_float(w.x & 0xffff0000u); x0[2] = __uint_as_float(w.y << 16); x0[3] = __uint_as_float(w.y & 0xffff0000u);
                    x1[0] = __uint_as_float(w.z << 16); x1[1] = __uint_as_float(w.z & 0xffff0000u); x1[2] = __uint_as_float(w.w << 16); x1[3] = __uint_as_float(w.w & 0xffff0000u);
                    *(f32x4*)(out + off + bj * HALF) = acc[ai][bj][m][0] + x0; *(f32x4*)(out + off + bj * HALF + 4) = acc[ai][bj][m][1] + x1; }
            }
    }
};

__device__ __forceinline__ f32x4 mma16(bf16x8 a, bf16x8 b, f32x4 c) { return __builtin_amdgcn_mfma_f32_16x16x32_bf16(a, b, c, 0, 0, 0); }
__device__ __forceinline__ i32x4 mma16(bf16x8 a, bf16x8 b, i32x4 c) { return __builtin_amdgcn_mfma_i32_16x16x64_i8(__builtin_bit_cast(i32x4, a), __builtin_bit_cast(i32x4, b), c, 0, 0, 0); }
template <class Epi, class Sched, bool ALIGN_EPI = false, bool SP2 = false>
__device__ __forceinline__ void gemm_phase(PG8_LAS unsigned char* lds, const Gemm g, const Sched& S, const Epi& E) {
    const int tid = threadIdx.x, wid = __builtin_amdgcn_readfirstlane(tid >> 6), lane = tid & 63, wr = wid >> 2, wc = wid & 3, fr = lane & 15, fq = lane >> 4;
    const int K = g.K, nt = K / BK;
    unsigned voffA[2], voffB[2];
#pragma unroll
    for (int i = 0; i < 2; ++i) { int R, C; stage_rc(tid * 16 + i * 8192, R, C); const int Rb = Epi::PERM ? ((R & ~31) + perm32(R & 31)) : R;
        voffA[i] = (unsigned)(R * K + C) * 2u; voffB[i] = (unsigned)(Rb * K + C) * 2u; }
    const size_t kstep = (size_t)(BK * 2);
    const size_t hstep = (size_t)HALF * K * 2;
    const size_t tstep = 2 * hstep;
    const unsigned ldsw = (unsigned)wid * 1024u;
    const int aoff = lds_byte(wr * 64 + fr, fq * 8), boff = lds_byte(wc * 32 + fr, fq * 8);
#define PG8_SA(b, h) (((b) * 2 + (h)) * HTB)
#define PG8_SB(b, h) ((4 + (b) * 2 + (h)) * HTB)
#define PG8_STAGE(bufoff, gbase, voff) do { _Pragma("unroll") for (int _i = 0; _i < 2; ++_i) \
        __builtin_amdgcn_global_load_lds((const unsigned*)((const char*)(gbase) + (voff)[_i]), (PG8_LAS unsigned*)(lds + (bufoff) + ldsw + _i * 8192), 16, 0, 0); } while (0)
#define PG8_LDA(dst, b, h) do { _Pragma("unroll") for (int m = 0; m < 4; ++m) _Pragma("unroll") for (int k = 0; k < 2; ++k) dst[m][k] = *(const PG8_LAS bf16x8*)(lds + PG8_SA(b, h) + aoff + m * 2048 + k * 1024); } while (0)
#define PG8_LDB(dst, b, h) do { _Pragma("unroll") for (int n = 0; n < 2; ++n) _Pragma("unroll") for (int k = 0; k < 2; ++k) dst[n][k] = *(const PG8_LAS bf16x8*)(lds + PG8_SB(b, h) + boff + n * 2048 + k * 1024); } while (0)
#define PG8_MMA(ai, bj, At, Bt) do { __builtin_amdgcn_s_setprio(1); _Pragma("unroll") for (int m = 0; m < 4; ++m) _Pragma("unroll") for (int n = 0; n < 2; ++n) _Pragma("unroll") for (int k = 0; k < 2; ++k) \
        acc[ai][bj][m][n] = mma16(Bt[n][k], At[m][k], acc[ai][bj][m][n]); __builtin_amdgcn_s_setprio(0); } while (0)
#define PG8_WAIT_V(n) asm volatile("s_waitcnt vmcnt(" #n ")" ::: "memory")
#define PG8_WAIT_L(n) asm volatile("s_waitcnt lgkmcnt(" #n ")" ::: "memory")
#define PG8_BAR __builtin_amdgcn_s_barrier()
#define PG8_SCHED __builtin_amdgcn_sched_barrier(0)
    Unit cur, nxt; int ui = 0;
    if (!S.next(0, cur)) return;
    typedef typename Epi::acc_t acc_t;
    acc_t acc[2][2][4][2];
#pragma unroll
    for (int a = 0; a < 2; ++a)
#pragma unroll
        for (int b = 0; b < 2; ++b)
#pragma unroll
            for (int m = 0; m < 4; ++m)
#pragma unroll
                for (int n = 0; n < 2; ++n) acc[a][b][m][n] = (acc_t){};
    bf16x8 At[4][2], B0[2][2], B1[2][2];
    const char* cA = (const char*)g.A + (size_t)cur.pm * tstep; const char* cB = (const char*)g.Bt + (size_t)cur.pn * tstep;
    S.a_ready(cur);
    if constexpr (SP2) {
        PG8_STAGE(PG8_SB(0, 0), cB, voffB); PG8_STAGE(PG8_SB(0, 1), cB + hstep, voffB); PG8_STAGE(PG8_SA(0, 0), cA, voffA); PG8_STAGE(PG8_SA(0, 1), cA + hstep, voffA);
        if (wr == 1) PG8_BAR;
        PG8_WAIT_V(2); PG8_BAR;
        PG8_STAGE(PG8_SB(1, 0), cB + kstep, voffB); PG8_STAGE(PG8_SA(1, 0), cA + kstep, voffA); PG8_STAGE(PG8_SB(1, 1), cB + hstep + kstep, voffB);
        PG8_WAIT_V(6); PG8_BAR;
    } else {
        PG8_STAGE(PG8_SB(0, 0), cB, voffB); PG8_STAGE(PG8_SA(0, 0), cA, voffA); PG8_STAGE(PG8_SB(0, 1), cB + hstep, voffB); PG8_STAGE(PG8_SA(0, 1), cA + hstep, voffA);
        if (wr == 1) PG8_BAR;
        PG8_WAIT_V(4); PG8_BAR;
        PG8_STAGE(PG8_SB(1, 0), cB + kstep, voffB); PG8_STAGE(PG8_SA(1, 0), cA + kstep, voffA); PG8_STAGE(PG8_SB(1, 1), cB + hstep + kstep, voffB);
        PG8_WAIT_V(6); PG8_BAR;
    }
    for (;;) {
        const bool has_next = S.next(ui + 1, nxt);
        float rsc[2][4];
        if constexpr (Epi::MIDK) E.pre(rsc, cur, wr, fr);
        const char* nA = has_next ? (const char*)g.A + (size_t)nxt.pm * tstep : cA; const char* nB = has_next ? (const char*)g.Bt + (size_t)nxt.pn * tstep : cB;
        for (int t = 0; t < nt; t += 2) {
            const bool last = (t == nt - 2);
            const char* a1 = cA + (size_t)(t + 1) * kstep;
            const char* a2 = last ? nA : cA + (size_t)(t + 2) * kstep; const char* b2 = last ? nB : cB + (size_t)(t + 2) * kstep;
            const char* a3 = a2 + kstep; const char* b3 = b2 + kstep;
            if (last && has_next) S.a_ready(nxt);
            if constexpr (Epi::MIDK) { if (t == nt / 2) E.mid(acc, rsc); }
            if constexpr (SP2) {
            PG8_LDB(B0, 0, 0); PG8_LDB(B1, 0, 1); PG8_SCHED; PG8_LDA(At, 0, 0); PG8_STAGE(PG8_SA(1, 1), a1 + hstep, voffA);
            PG8_WAIT_V(8); PG8_WAIT_L(0); PG8_BAR; PG8_MMA(0, 0, At, B0); PG8_MMA(0, 1, At, B1); PG8_BAR; PG8_SCHED;
            PG8_LDA(At, 0, 1); PG8_STAGE(PG8_SB(0, 0), b2, voffB); PG8_STAGE(PG8_SB(0, 1), b2 + hstep, voffB); PG8_STAGE(PG8_SA(0, 0), a2, voffA);
            PG8_WAIT_V(8); PG8_WAIT_L(0); PG8_BAR; PG8_MMA(1, 0, At, B0); PG8_MMA(1, 1, At, B1); PG8_BAR; PG8_SCHED;
            PG8_LDB(B0, 1, 0); PG8_LDB(B1, 1, 1); PG8_SCHED; PG8_LDA(At, 1, 0); PG8_STAGE(PG8_SA(0, 1), a2 + hstep, voffA);
            PG8_WAIT_V(8); PG8_WAIT_L(0); PG8_BAR; PG8_MMA(0, 0, At, B0); PG8_MMA(0, 1, At, B1); PG8_BAR; PG8_SCHED;
            PG8_LDA(At, 1, 1); PG8_STAGE(PG8_SB(1, 0), b3, voffB); PG8_STAGE(PG8_SB(1, 1), b3 + hstep, voffB); PG8_STAGE(PG8_SA(1, 0), a3, voffA);
            PG8_WAIT_V(8); PG8_WAIT_L(0); PG8_BAR; PG8_MMA(1, 0, At, B0); PG8_MMA(1, 1, At, B1); PG8_BAR; PG8_SCHED;
            } else {
            PG8_LDB(B0, 0, 0); PG8_SCHED; PG8_LDA(At, 0, 0); PG8_STAGE(PG8_SA(1, 1), a1 + hstep, voffA);
            PG8_WAIT_L(8); PG8_BAR; PG8_WAIT_L(0); PG8_MMA(0, 0, At, B0); PG8_BAR; PG8_SCHED;
            PG8_LDB(B1, 0, 1); PG8_STAGE(PG8_SB(0, 0), b2, voffB);
            PG8_BAR; PG8_WAIT_L(0); PG8_MMA(0, 1, At, B1); PG8_BAR;
            PG8_LDA(At, 0, 1); PG8_STAGE(PG8_SA(0, 0), a2, voffA);
            PG8_BAR; PG8_WAIT_L(0); PG8_MMA(1, 0, At, B0); PG8_BAR; PG8_SCHED;
            PG8_STAGE(PG8_SB(0, 1), b2 + hstep, voffB);
            PG8_WAIT_V(6); PG8_BAR; PG8_MMA(1, 1, At, B1); PG8_BAR;
            PG8_LDB(B0, 1, 0); PG8_SCHED; PG8_LDA(At, 1, 0); PG8_STAGE(PG8_SA(0, 1), a2 + hstep, voffA);
            PG8_WAIT_L(8); PG8_BAR; PG8_WAIT_L(0); PG8_MMA(0, 0, At, B0); PG8_BAR; PG8_SCHED;
            PG8_LDB(B1, 1, 1); PG8_STAGE(PG8_SB(1, 0), b3, voffB);
            PG8_BAR; PG8_WAIT_L(0); PG8_MMA(0, 1, At, B1); PG8_BAR;
            PG8_LDA(At, 1, 1); PG8_STAGE(PG8_SA(1, 0), a3, voffA);
            PG8_BAR; PG8_WAIT_L(0); PG8_MMA(1, 0, At, B0); PG8_BAR; PG8_SCHED;
            PG8_STAGE(PG8_SB(1, 1), b3 + hstep, voffB);
            PG8_WAIT_V(6); PG8_BAR; PG8_MMA(1, 1, At, B1); PG8_BAR;
            }
        }
        if constexpr (ALIGN_EPI) { if (wr == 0) PG8_BAR; }
        if constexpr (!Epi::AFTER_DRAIN) { E(acc, cur, wr, wc, fr, fq); S.done(cur); }
        if (!has_next) break;
#pragma unroll
        for (int a = 0; a < 2; ++a)
#pragma unroll
            for (int b = 0; b < 2; ++b)
#pragma unroll
                for (int m = 0; m < 4; ++m)
#pragma unroll
                    for (int n = 0; n < 2; ++n) acc[a][b][m][n] = (acc_t){};
        cur = nxt; cA = nA; cB = nB; ++ui;
        if constexpr (ALIGN_EPI) { if (wr == 1) PG8_BAR; }
    }
    PG8_WAIT_V(0);
    if constexpr (!ALIGN_EPI) { if (wr == 0) PG8_BAR; }
    PG8_BAR;
    if constexpr (Epi::AFTER_DRAIN) { E.fused(acc, cur, wr, wc, fr, fq, lds, wid, lane); S.done(cur); }
#undef PG8_SA
#undef PG8_SB
#undef PG8_STAGE
#undef PG8_LDA
#undef PG8_LDB
#undef PG8_MMA
#undef PG8_WAIT_V
#undef PG8_WAIT_L
#undef PG8_BAR
#undef PG8_SCHED
}
}
constexpr int NWAVES = 8;
constexpr int DM = 1024, MTOK = 32768, MPAD = pg8::MP_ROWS, NIN = 2304, DFF = 2816, NGU = 2 * DFF;
constexpr float LOG2E = 1.4426950408889634f;
constexpr float EPS = 1e-6f;
constexpr size_t MiB = 1u << 20;
constexpr size_t WS_CTL = 0, CTL_ZERO_BYTES = 65536;
constexpr size_t WS_SMA = 1 * MiB, WS_SMB = WS_SMA + 131072;
constexpr size_t WS_SWO = 9 * MiB + 524288 - 4096;
constexpr size_t WS_WOQ = 404 * MiB;
constexpr size_t WS_WDN = 3 * MiB;
constexpr size_t WS_R1 = 9 * MiB;
constexpr size_t WS_SX = WS_R1 + 262144, WS_SW = WS_R1 + 524288;
constexpr size_t WS_MIX = 10 * MiB;
constexpr size_t WS_X1Q = WS_MIX;
constexpr size_t WS_QKV = 74 * MiB;
constexpr size_t SZ_Q = (size_t)MPAD * 512 * 2, SZ_KB = (size_t)MPAD * 128 * 2;
constexpr size_t WS_QA = WS_QKV, WS_KA = WS_QA + SZ_Q, WS_VAT = WS_KA + SZ_Q, WS_QB = WS_VAT + SZ_Q, WS_KB = WS_QB + SZ_Q, WS_VBT = WS_KB + SZ_KB, WS_QKV_END = WS_VBT + SZ_KB;
constexpr size_t WS_H = 74 * MiB;
constexpr size_t WS_X1B = 250 * MiB;
constexpr size_t WS_XN = 314 * MiB;
constexpr size_t WS_WGQ = 405 * MiB;
constexpr size_t WS_WGU = 385 * MiB;
constexpr size_t WS_WIN = 396 * MiB;
constexpr size_t WS_WOUT = 383 * MiB;
constexpr size_t WS_END = 411 * MiB;
static_assert(WS_SMB + 131072 <= WS_WDN && WS_WDN + (size_t)DM * DFF * 2 <= WS_R1 && WS_R1 + (size_t)MPAD * 4 <= WS_SX && WS_SX + (size_t)MTOK * 4 <= WS_SWO && WS_SWO + 4096 == WS_SW && WS_SW + (size_t)NGU * 4 <= WS_MIX
              && WS_MIX + (size_t)MTOK * DM <= WS_QKV && WS_QKV_END <= WS_X1B && WS_H + (size_t)MTOK * DFF * 2 <= WS_X1B && WS_X1B + (size_t)MTOK * DM * 2 <= WS_XN
              && WS_XN + (size_t)MPAD * DM * 2 <= WS_WOUT && WS_WOUT + (size_t)DM * DM * 2 == WS_WGU && WS_WGU + (size_t)NGU * DM * 2 <= WS_WIN && WS_WIN + (size_t)NIN * DM * 2 <= WS_WOQ && WS_WOQ + (size_t)DM * DM == WS_WGQ
              && WS_WGQ + (size_t)NGU * DM <= WS_END, "d_ws map");
constexpr int CW_TMO = 0, CW_CODE = 1, CW_BAR = 4096;
constexpr int RING_OFF = 0, RING_BYTES = 131072;
constexpr int LDSCTL_OFF = 162816, MISC_OFF = LDSCTL_OFF + 320;
constexpr int LDS_BYTES = 163840;
#define GAS __attribute__((address_space(1)))
#define LAS __attribute__((address_space(3)))
typedef unsigned short bf16;
typedef unsigned v4u __attribute__((ext_vector_type(4)));
typedef float f32x4 __attribute__((ext_vector_type(4)));
typedef short bf16x8 __attribute__((ext_vector_type(8)));
typedef GAS unsigned gu32;
typedef GAS unsigned long long gu64;
#define RLX_AGENT __ATOMIC_RELAXED, __HIP_MEMORY_SCOPE_AGENT
#define LDS_WAIT() asm volatile("s_waitcnt lgkmcnt(0)" ::: "memory")
#define VM_WAIT() asm volatile("s_waitcnt vmcnt(0)" ::: "memory")
__device__ __forceinline__ unsigned long long rt() { return __builtin_amdgcn_s_memrealtime(); }
__device__ __forceinline__ unsigned f2bf(float f) { unsigned u = __builtin_bit_cast(unsigned, f); return (u + 0x7fffu + ((u >> 16) & 1u)) >> 16; }
__device__ __forceinline__ unsigned pk2(float lo, float hi) { return f2bf(lo) | (f2bf(hi) << 16); }

#define XB_TMO      128
#define XB_XCNT(j)  (256  + 64 * (j))
#define XB_XSUB(j)  (1280 + 64 * (j))
#define XB_XGEN(j)  (2304 + 64 * (j))
#define XB_TOP      3328
#define XB_TOPGEN   3392
#define XB_LSUB(j)  (3456 + 64 * (j))
#define XCD_BAR_WORDS 4480
#define XB_SPIN_CAP (1u << 18)

__device__ __forceinline__ unsigned xb_ld(unsigned* p)              { return __hip_atomic_load(p, __ATOMIC_RELAXED, __HIP_MEMORY_SCOPE_AGENT); }
__device__ __forceinline__ unsigned xb_add(unsigned* p, unsigned v) { return __hip_atomic_fetch_add(p, v, __ATOMIC_RELAXED, __HIP_MEMORY_SCOPE_AGENT); }
__device__ __forceinline__ unsigned xb_xcc_id() { return (unsigned)__builtin_amdgcn_s_getreg((3 << 11) | 20) & 0xFu; }
#define XB_SPIN(cond, bar) do { unsigned _sp = 0; while (cond) { __builtin_amdgcn_s_sleep(1); \
    if ((++_sp & 255u) == 0u) { if (xb_ld(&(bar)[XB_TMO])) break; if (_sp > XB_SPIN_CAP) { atomicAdd(&(bar)[XB_TMO], 1u); break; } } } } while (0)

struct XcdBarrier {
    unsigned* bar; unsigned x;
    volatile LAS unsigned* st;
};

__device__ __forceinline__ XcdBarrier xcd_barrier_post(unsigned* bar, volatile LAS unsigned* st) {
    XcdBarrier b; b.bar = bar; b.x = xb_xcc_id(); b.st = st;
    if (threadIdx.x == 0) st[3] = xb_add(&bar[XB_XCNT(b.x)], 1u);
    return b;
}
__device__ __forceinline__ void xcd_barrier_complete(unsigned* bar, unsigned x, unsigned& nloc, unsigned& nx, unsigned& xi) {
    const unsigned G = gridDim.x * gridDim.y * gridDim.z;
    unsigned sum, cnt, mine, below, sp = 0u;
    for (;;) {
        sum = 0u; cnt = 0u; mine = 0u; below = 0u;
#pragma unroll
        for (unsigned j = 0; j < 16; ++j) { const unsigned c = xb_ld(&bar[XB_XCNT(j)]); sum += c; cnt += (c > 0u) ? 1u : 0u; mine = (j == x) ? c : mine; below += (j < x && c > 0u) ? 1u : 0u; }
        if (sum == G) break;
        __builtin_amdgcn_s_sleep(1);
        if ((++sp & 255u) == 0u) { if (xb_ld(&bar[XB_TMO])) break; if (sp > XB_SPIN_CAP) { atomicAdd(&bar[XB_TMO], 1u); break; } }
    }
    nloc = mine > 0u ? mine : 1u; nx = cnt > 0u ? cnt : 1u; xi = below < nx ? below : nx - 1u;
}

__device__ __forceinline__ void xcd_barrier(const XcdBarrier& b) {
    asm volatile("s_waitcnt vmcnt(0)" ::: "memory");
    __syncthreads();
    if (threadIdx.x == 0) {
        unsigned* bar = b.bar;
        __builtin_amdgcn_s_waitcnt(0);
        unsigned nloc = b.st[0], nx = b.st[1];
        if (nloc == 0u) { unsigned xi; xcd_barrier_complete(bar, b.x, nloc, nx, xi); b.st[0] = nloc; b.st[1] = nx; b.st[2] = xi; }
        const unsigned old = xb_add(&bar[XB_XSUB(b.x)], 1u);
        const unsigned gen = old / nloc;
        if (old + 1u == (gen + 1u) * nloc) {
            __builtin_amdgcn_fence(__ATOMIC_RELEASE, "agent");
            asm volatile("s_waitcnt vmcnt(0)" ::: "memory");
            const unsigned og = xb_add(&bar[XB_TOP], 1u);
            const unsigned tg = og / nx;
            if (og + 1u == (tg + 1u) * nx) xb_add(&bar[XB_TOPGEN], 1u);
            else XB_SPIN(xb_ld(&bar[XB_TOPGEN]) == tg, bar);
            __builtin_amdgcn_fence(__ATOMIC_ACQUIRE, "agent");
            xb_add(&bar[XB_XGEN(b.x)], 1u);
            asm volatile("s_waitcnt vmcnt(0)" ::: "memory");
        } else {
            XB_SPIN(xb_ld(&bar[XB_XGEN(b.x)]) == gen, bar);
            __builtin_amdgcn_fence(__ATOMIC_ACQUIRE, "agent");
            asm volatile("s_waitcnt vmcnt(0)" ::: "memory");
        }
    }
    __syncthreads();
}

struct XcdEnv { int nloc, nx, xi, rank; };
__device__ __forceinline__ XcdEnv xcd_env(const XcdBarrier& b) {
    if (threadIdx.x == 0 && b.st[0] == 0u) { unsigned nloc, nx, xi; xcd_barrier_complete(b.bar, b.x, nloc, nx, xi); b.st[1] = nx; b.st[2] = xi; b.st[0] = nloc; }
    __syncthreads();
    XcdEnv e; e.nloc = __builtin_amdgcn_readfirstlane((int)b.st[0]); e.nx = __builtin_amdgcn_readfirstlane((int)b.st[1]); e.xi = __builtin_amdgcn_readfirstlane((int)b.st[2]); e.rank = __builtin_amdgcn_readfirstlane((int)b.st[3]);
    return e;
}
__device__ __forceinline__ void xcd_local_barrier(const XcdBarrier& b) {
    asm volatile("s_waitcnt vmcnt(0)" ::: "memory");
    __syncthreads();
    if (threadIdx.x == 0) {
        unsigned* bar = b.bar;
        __builtin_amdgcn_s_waitcnt(0);
        unsigned nloc = b.st[0];
        if (nloc == 0u) { unsigned nx, xi; xcd_barrier_complete(bar, b.x, nloc, nx, xi); b.st[1] = nx; b.st[2] = xi; b.st[0] = nloc; }
        const unsigned old = xb_add(&bar[XB_LSUB(b.x)], 1u);
        const unsigned target = (old / nloc + 1u) * nloc;
        XB_SPIN(xb_ld(&bar[XB_LSUB(b.x)]) < target, bar);
        __builtin_amdgcn_fence(__ATOMIC_ACQUIRE, "agent");
        asm volatile("s_waitcnt vmcnt(0)" ::: "memory");
    }
    __syncthreads();
}

static_assert((CW_BAR + 2 * XCD_BAR_WORDS) * 4 <= (int)CTL_ZERO_BYTES, "barrier words inside the memset region");
typedef float f32x16 __attribute__((ext_vector_type(16)));
typedef short s16x4 __attribute__((ext_vector_type(4)));
typedef unsigned u32x2 __attribute__((ext_vector_type(2)));
typedef unsigned u32x4 __attribute__((ext_vector_type(4)));
struct Frame {
    LAS unsigned char* lds;
    volatile LAS unsigned* MISC;
    gu32* ctl;
    int wave;
    int vcu, G;
};
__device__ __forceinline__ int fresh_lane() { int t = threadIdx.x; asm volatile("" : "+v"(t)); return t & 63; }
__device__ __forceinline__ float wave_sum(float v) {
#pragma unroll
    for (int o = 1; o < 64; o <<= 1) v += __shfl_xor(v, o);
    return v;
}
__device__ __forceinline__ unsigned q8x4(float a, float b, float c, float d, float qs) {
    const unsigned ua = __float_as_uint(__builtin_fmaf(a, qs, 12582912.0f)), ub = __float_as_uint(__builtin_fmaf(b, qs, 12582912.0f));
    const unsigned uc = __float_as_uint(__builtin_fmaf(c, qs, 12582912.0f)), ud = __float_as_uint(__builtin_fmaf(d, qs, 12582912.0f));
    const unsigned lo = __builtin_amdgcn_perm(ub, ua, 0x0c0c0400u), hi = __builtin_amdgcn_perm(ud, uc, 0x04000c0cu);
    return lo | hi;
}
constexpr int NBT_LD = 1028;
__device__ __forceinline__ void p0_nblock_task(const float* W, int N, int n0, const float* g, signed char* dstq, float* scl, int drow0, LAS float* T, int wave, int lane) {
    const int kq = lane >> 3, c4 = lane & 7;
#pragma unroll
    for (int kb2 = 0; kb2 < 2; ++kb2) { const int k0 = 64 * (2 * wave + kb2);
        f32x4 v[8];
#pragma unroll
        for (int i = 0; i < 8; ++i) v[i] = __builtin_nontemporal_load((const GAS f32x4*)(W + (size_t)(k0 + 8 * i + kq) * N + n0 + 4 * c4));
        if (g) {
#pragma unroll
            for (int i = 0; i < 8; ++i) v[i] = v[i] * g[k0 + 8 * i + kq]; }
#pragma unroll
        for (int i = 0; i < 8; ++i) { LAS float* d = T + (4 * c4) * NBT_LD + k0 + 8 * i + kq; d[0] = v[i].x; d[NBT_LD] = v[i].y; d[2 * NBT_LD] = v[i].z; d[3 * NBT_LD] = v[i].w; } }
    LDS_WAIT(); __syncthreads();
    LAS float* bm = T + 32 * NBT_LD;
    { float amw = 0.f;
#pragma unroll
      for (int c = 0; c < 4; ++c) { const LAS f32x4* rp = (const LAS f32x4*)(T + (4 * wave + c) * NBT_LD + 16 * lane);
          const f32x4 a = rp[0], b = rp[1], cc = rp[2], d = rp[3];
          float am = fmaxf(fmaxf(fmaxf(fabsf(a[0]), fabsf(a[1])), fmaxf(fabsf(a[2]), fabsf(a[3]))), fmaxf(fmaxf(fabsf(b[0]), fabsf(b[1])), fmaxf(fabsf(b[2]), fabsf(b[3]))));
          am = fmaxf(am, fmaxf(fmaxf(fmaxf(fabsf(cc[0]), fabsf(cc[1])), fmaxf(fabsf(cc[2]), fabsf(cc[3]))), fmaxf(fmaxf(fabsf(d[0]), fabsf(d[1])), fmaxf(fabsf(d[2]), fabsf(d[3])))));
          amw = fmaxf(amw, am); }
#pragma unroll
      for (int o = 1; o < 64; o <<= 1) amw = fmaxf(amw, __shfl_xor(amw, o));
      if (lane == 0) bm[wave] = amw; }
    LDS_WAIT(); __syncthreads();
    { const f32x4 m0 = *(const LAS f32x4*)bm, m1 = *(const LAS f32x4*)(bm + 4);
      const float am = fmaxf(fmaxf(fmaxf(m0[0], m0[1]), fmaxf(m0[2], m0[3])), fmaxf(fmaxf(m1[0], m1[1]), fmaxf(m1[2], m1[3])));
      const float qs = am > 0.f ? 127.0f / am : 0.f, sc = am > 0.f ? am * (1.0f / 127.0f) : 1.0f;
#pragma unroll
      for (int c = 0; c < 4; ++c) { const int ch = 4 * wave + c; const LAS f32x4* rp = (const LAS f32x4*)(T + ch * NBT_LD + 16 * lane);
          const f32x4 a = rp[0], b = rp[1], cc = rp[2], d = rp[3];
          v4u q; q.x = q8x4(a[0], a[1], a[2], a[3], qs); q.y = q8x4(b[0], b[1], b[2], b[3], qs); q.z = q8x4(cc[0], cc[1], cc[2], cc[3], qs); q.w = q8x4(d[0], d[1], d[2], d[3], qs);
          *(GAS v4u*)(dstq + (size_t)(drow0 + ch) * DM + 16 * lane) = q;
          if (lane == 0) scl[drow0 + ch] = sc; } }
    LDS_WAIT(); __syncthreads();
}
constexpr int P0_NTASKS = DM / 32 + 2 * (DFF / 32);
__device__ __forceinline__ void p0_weight_tasks(Frame& F, const float* w_out, const float* g2, const float* w_gate, const float* w_up, signed char* WOQ, float* SWO, signed char* WGQ, float* SW, int wg, int nwg) {
    LAS float* T = (LAS float*)(F.lds + RING_OFF);
    __syncthreads();
    for (int t = wg; t < P0_NTASKS; t += nwg) {
        if (t < DM / 32) { p0_nblock_task(w_out, DM, 32 * t, nullptr, WOQ, SWO, 32 * t, T, F.wave, fresh_lane()); continue; }
        const int r = t - DM / 32; const bool up = r >= DFF / 32; const int n0 = 32 * (up ? r - DFF / 32 : r);
        p0_nblock_task(up ? w_up : w_gate, DFF, n0, g2, WGQ, SW, 256 * (n0 >> 7) + (up ? 128 : 0) + (n0 & 127), T, F.wave, fresh_lane());
    }
}
__device__ __forceinline__ void p0_transpose_item(const float* W, int K, int N, bf16* WT, int k0, int n0, int drow, const float* g, LAS float* scr, int lane) {
    f32x4 v[8]; const int kq = lane >> 3, c4 = lane & 7;
#pragma unroll
    for (int i = 0; i < 8; ++i) v[i] = __builtin_nontemporal_load((const GAS f32x4*)(W + (size_t)(k0 + 8 * i + kq) * N + n0 + 4 * c4));
    if (g) {
#pragma unroll
        for (int i = 0; i < 8; ++i) v[i] = v[i] * g[k0 + 8 * i + kq]; }
#pragma unroll
    for (int i = 0; i < 8; ++i) { LAS float* d = scr + (8 * i + kq) * 33 + 4 * c4; d[0] = v[i].x; d[1] = v[i].y; d[2] = v[i].z; d[3] = v[i].w; }
    LDS_WAIT(); asm volatile("" ::: "memory");
    const int c = lane & 7;
#pragma unroll
    for (int j = 0; j < 4; ++j) { const int n = (lane >> 3) + 8 * j; const LAS float* s = scr + (8 * c) * 33 + n;
        v4u o; o.x = pk2(s[0 * 33], s[1 * 33]); o.y = pk2(s[2 * 33], s[3 * 33]); o.z = pk2(s[4 * 33], s[5 * 33]); o.w = pk2(s[6 * 33], s[7 * 33]);
        *(GAS v4u*)(WT + (size_t)(drow + n) * K + k0 + 8 * c) = o; }
    LDS_WAIT(); asm volatile("" ::: "memory");
}
constexpr int P0_I_IN = (DM / 64) * (NIN / 32), P0_I_DN = (DFF / 64) * (DM / 32), P0_NITEMS = P0_I_IN + P0_I_DN;
__device__ __forceinline__ void p0_weight_items(Frame& F, const float* g1, const float* w_in, const float* w_down, bf16* WIN, bf16* WDN, LAS float* scr, int lo, int hi, int worker, int nworkers) {
    constexpr int I_IN = P0_I_IN;
    for (int it = lo + worker; it < hi; it += nworkers) {
        int r = it;
        if (r < I_IN) { const int nb = r % (NIN / 32), kb = r / (NIN / 32), n0 = 32 * nb, g = n0 >> 6;
            const int drow = 256 * (g >> 2) + 128 * ((n0 & 63) >> 5) + 32 * (g & 3);
            p0_transpose_item(w_in, DM, NIN, WIN, 64 * kb, n0, drow, g1, scr, fresh_lane()); continue; } r -= I_IN;
        { const int nb = r % (DM / 32), kb = r / (DM / 32); p0_transpose_item(w_down, DFF, DM, WDN, 64 * kb, 32 * nb, 32 * nb, nullptr, scr, fresh_lane()); }
    }
}
__device__ __forceinline__ void p0_prologue(Frame& F, const float* xp, const float* xs, const float* meta, const float* g1, const float* w_in, const float* w_out, const float* g2, const float* w_gate, const float* w_up, const float* w_down,
        bf16* WIN, signed char* WOQ, float* SWO, signed char* WGQ, float* SW, bf16* WDN, bf16* XN, float* R1, bool defer) {
    LAS float* scr = (LAS float*)(F.lds + RING_OFF + F.wave * 16384);
    const int lane_ = fresh_lane();
    const int gw = F.vcu * NWAVES + F.wave, NGW = F.G * NWAVES;
    constexpr int I_IN = (DM / 64) * (NIN / 32);
    p0_weight_items(F, g1, w_in, w_down, WIN, WDN, scr, 0, defer ? I_IN : P0_NITEMS, gw, NGW);
    if (!defer) p0_weight_tasks(F, w_out, g2, w_gate, w_up, WOQ, SWO, WGQ, SW, F.vcu, F.G);
    for (int m0 = gw; m0 < MPAD; m0 += 4 * NGW) {
        f32x4 v[4][4];
#pragma unroll
        for (int b = 0; b < 4; ++b) { const int m = m0 + b * NGW;
            if (m < MTOK + 16) { const float* xrow = m < 16384 ? xp + (size_t)m * DM : (m < MTOK ? xs + (size_t)(m - 16384) * DM : meta + (size_t)(m - MTOK) * DM);
                const GAS f32x4* xr = (const GAS f32x4*)xrow + lane_;
#pragma unroll
                for (int j = 0; j < 4; ++j) v[b][j] = __builtin_nontemporal_load(xr + 64 * j); }
            else {
#pragma unroll
                for (int j = 0; j < 4; ++j) v[b][j] = (f32x4){0.f, 0.f, 0.f, 0.f}; } }
#pragma unroll
        for (int b = 0; b < 4; ++b) { const int m = m0 + b * NGW; if (m >= MPAD) continue;
            float sq = 0.f;
#pragma unroll
            for (int j = 0; j < 4; ++j) sq += (v[b][j].x * v[b][j].x + v[b][j].y * v[b][j].y) + (v[b][j].z * v[b][j].z + v[b][j].w * v[b][j].w);
            const float rstd = __builtin_amdgcn_rsqf(wave_sum(sq) * (1.f / DM) + EPS);
            if (lane_ == 0) R1[m] = rstd;
            GAS unsigned long long* o8 = (GAS unsigned long long*)(XN + (size_t)m * DM) + lane_;
#pragma unroll
            for (int j = 0; j < 4; ++j) { const f32x4 y = v[b][j];
                o8[64 * j] = (unsigned long long)pk2(y.x, y.y) | ((unsigned long long)pk2(y.z, y.w) << 32); } }
    }
}
__device__ __forceinline__ unsigned cvtpk(float lo, float hi) { return pg8::cvt_pk_bf16(lo, hi); }
__device__ __forceinline__ void attn_load_kv(bf16x8 (&kf)[4], bf16x8 (&vf)[2][2], const bf16* krow, const bf16* vcol) {
#pragma unroll
    for (int s = 0; s < 4; ++s) kf[s] = *(const bf16x8*)(krow + 16 * s);
#pragma unroll
    for (int db = 0; db < 2; ++db)
#pragma unroll
        for (int s = 0; s < 2; ++s) { const bf16* p = vcol + (size_t)(32 * db) * MPAD + 16 * s;
            const s16x4 lo = *(const s16x4*)p, hi = *(const s16x4*)(p + 8);
            vf[db][s] = (bf16x8){lo[0], lo[1], lo[2], lo[3], hi[0], hi[1], hi[2], hi[3]}; }
}
__device__ __forceinline__ void attn_load_k(bf16x8 (&kf)[4], const bf16* kt) {
#pragma unroll
    for (int s = 0; s < 4; ++s) kf[s] = *(const bf16x8*)(kt + 512 * s);
}
__device__ __forceinline__ void attn_load_v(bf16x8 (&vf)[2][2], const bf16* vt) {
#pragma unroll
    for (int db = 0; db < 2; ++db)
#pragma unroll
        for (int s = 0; s < 2; ++s) vf[db][s] = *(const bf16x8*)(vt + 512 * (2 * db + s));
}
__device__ __forceinline__ f32x16 attn_qk(const bf16x8 (&kf)[4], const LAS bf16x8* qf, f32x16 S = (f32x16){}) {
#pragma unroll
    for (int s = 0; s < 4; ++s) S = __builtin_amdgcn_mfma_f32_32x32x16_bf16(kf[s], qf[64 * s], S, 0, 0, 0);
    return S;
}
__device__ __forceinline__ void attn_pv_half(f32x16 (&O)[2], const float (&p)[8], const bf16x8 (&vf)[2][2], int s) {
    u32x4 pw; pw.x = cvtpk(p[0], p[1]); pw.y = cvtpk(p[2], p[3]); pw.z = cvtpk(p[4], p[5]); pw.w = cvtpk(p[6], p[7]);
    const bf16x8 pb = __builtin_bit_cast(bf16x8, pw);
#pragma unroll
    for (int db = 0; db < 2; ++db) O[db] = __builtin_amdgcn_mfma_f32_32x32x16_bf16(vf[db][s], pb, O[db], 0, 0, 0);
}
__device__ __forceinline__ f32x16 attn_tab16(const LAS float* tab4, int cstride, int I) {
    const int a = I & 3; const LAS f32x4* p = (const LAS f32x4*)(tab4 + a * cstride + (I - a));
    const f32x4 v0 = p[0], v1 = p[2], v2 = p[4], v3 = p[6];
    return (f32x16){v0[0], v0[1], v0[2], v0[3], v1[0], v1[1], v1[2], v1[3], v2[0], v2[1], v2[2], v2[3], v3[0], v3[1], v3[2], v3[3]};
}
constexpr int TA_CS = 608, TB_CS = 324, TM_CS = 132;
template <bool ISB, int CB>
__device__ __forceinline__ void attn_win_tile(f32x16 (&O)[2][2], float (&l)[2], const bf16x8 (&kf)[4], const bf16x8 (&vf)[2][2], const LAS bf16x8* qf,
                                              const LAS float* tabAB, const LAS float* tabM, int wt, int rowoff, int jlo, int q, int h) {
#pragma unroll
    for (int qb = 0; qb < 2; ++qb) {
        if (ISB) { const int j = jlo + wt; if ((qb == 0 && j == 9) || (qb == 1 && j == 0)) continue; }
        constexpr int cb = CB;
        f32x16 C, Bv = (f32x16){};
        if (!ISB) {
            const int c = 32 * qb + q; int cs = c - 8; cs = cs < 0 ? 0 : (cs > 48 ? 48 : cs);
            const int kcb = 32 * cb + 4 * h;
            C = attn_tab16(tabM, TM_CS, 63 + kcb - cs);
            Bv = attn_tab16(tabAB, TA_CS, rowoff + 63 + kcb - c);
        } else {
            C = attn_tab16(tabAB, TB_CS, 32 * (jlo + wt) - 128 - 32 * qb - q + 4 * h + 160);
        }
        const f32x16 S = attn_qk(kf, qf + 256 * qb, C);
        float ls0 = 0.f, ls1 = 0.f;
#pragma unroll
        for (int s2 = 0; s2 < 2; ++s2) {
            if (!ISB && qb != cb && s2 == cb) continue;
            float p[8];
#pragma unroll
            for (int j = 0; j < 8; ++j) { const int rg = 8 * s2 + j;
                float x = S[rg]; if (!ISB) x += Bv[rg];
                p[j] = __builtin_amdgcn_exp2f(x); }
            ls0 += (p[0] + p[1]) + (p[2] + p[3]); ls1 += (p[4] + p[5]) + (p[6] + p[7]);
            attn_pv_half(O[qb], p, vf, s2);
        }
        l[qb] += ls0 + ls1;
        __builtin_amdgcn_sched_barrier(0);
    }
}
struct AttnPtrs { const bf16 *QA, *KA, *VAT, *QB, *KB, *VBT; unsigned char* MIX; float *SMA, *SMB; const float *ona, *onb; };
template <bool ISB>
__device__ __forceinline__ void attn_unit(Frame& F, const AttnPtrs& T, int t0, const LAS float* tabAB, const LAS float* tabM, float sinkexp, LAS float* ssx, LAS bf16x8* qlds) {
    const int lane = fresh_lane(), w = F.wave, q = lane & 31, h = lane >> 5;
    int sb, N; if (t0 < 16384) { sb = t0 & ~8191; N = 8192; } else { sb = 16384 + ((t0 - 16384) & ~4095); N = 4096; }
    const int q0 = t0 - sb;
    constexpr int NT = MPAD / 32;
    const bf16* Qp = (ISB ? T.QB : T.QA) + ((size_t)w * NT + (t0 >> 5)) * 2048 + lane * 8;
    const int khead = ISB ? (w >> 2) : w;
    const bf16* Kp = (ISB ? T.KB : T.KA) + (size_t)khead * NT * 2048 + lane * 8;
    const bf16* Vp = (ISB ? T.VBT : T.VAT) + (size_t)khead * NT * 2048 + lane * 8;
    int nw, jlo = 0, tbase0, rs = 0, rq = 0;
    if (!ISB) { const int rows = N >> 6; rq = q0 >> 6; rs = rq - 4; rs = rs < 0 ? 0 : (rs > rows - 8 ? rows - 8 : rs); nw = 16; tbase0 = sb + 64 * rs; }
    else { jlo = q0 >= 128 ? 0 : (128 - q0) >> 5; int jhi = (N - q0 + 128) >> 5; jhi = jhi > 10 ? 10 : jhi; nw = jhi - jlo; tbase0 = sb + q0 - 128 + 32 * jlo; }
#define ATT_KROW(wt_) (rs + ((((wt_) >> 1) - rs) & 7))
#define ATT_TB(wt_) (ISB ? tbase0 + 32 * (wt_) : sb + 64 * ATT_KROW(wt_) + 32 * ((wt_) & 1))
    bf16x8 kfX[4], kfY[4], vfX[2][2], vfY[2][2];
    attn_load_k(kfX, Kp + (size_t)(MTOK >> 5) * 2048); attn_load_v(vfX, Vp + (size_t)(MTOK >> 5) * 2048);
    { const int tb = ATT_TB(0); attn_load_k(kfY, Kp + (size_t)(tb >> 5) * 2048); attn_load_v(vfY, Vp + (size_t)(tb >> 5) * 2048); }
    LAS bf16x8* qf = qlds + lane;
#pragma unroll
    for (int qb = 0; qb < 2; ++qb)
#pragma unroll
        for (int s = 0; s < 4; ++s) qf[256 * qb + 64 * s] = __builtin_nontemporal_load((const bf16x8*)(Qp + 2048 * qb + 512 * s));
    f32x16 O[2][2]; float l[2] = {0.f, 0.f};
#pragma unroll
    for (int qb = 0; qb < 2; ++qb)
#pragma unroll
        for (int db = 0; db < 2; ++db) O[qb][db] = (f32x16){};
#pragma unroll
    for (int qb = 0; qb < 2; ++qb) {
        const f32x16 S = attn_qk(kfX, qf + 256 * qb); float ls = 0.f;
        const int ib = 144 - q0 - 32 * qb - q + 4 * h;
        float p[8];
#pragma unroll
        for (int r = 0; r < 8; ++r) { float b = 0.f; if (ISB) { int idx = ib + (r & 3) + 8 * (r >> 2); idx = idx < 32 ? 32 : idx; b = tabAB[idx]; }
            p[r] = __builtin_amdgcn_exp2f(S[r] + b); ls += p[r]; }
        l[qb] += ls; attn_pv_half(O[qb], p, vfX, 0);
        __builtin_amdgcn_sched_barrier(0);
    }
#pragma unroll 1
    for (int wt = 0; wt < nw; wt += 2) {
        { const int tb = ATT_TB(wt + 1); attn_load_k(kfX, Kp + (size_t)(tb >> 5) * 2048); attn_load_v(vfX, Vp + (size_t)(tb >> 5) * 2048); }
        attn_win_tile<ISB, 0>(O, l, kfY, vfY, qf, tabAB, tabM, wt, ISB ? 0 : (ATT_KROW(wt) - rq + 7) * 32, jlo, q, h);
        { const int wn = wt + 2 < nw ? wt + 2 : wt; const int tb = ATT_TB(wn); attn_load_k(kfY, Kp + (size_t)(tb >> 5) * 2048); attn_load_v(vfY, Vp + (size_t)(tb >> 5) * 2048); }
        attn_win_tile<ISB, 1>(O, l, kfX, vfX, qf, tabAB, tabM, wt + 1, ISB ? 0 : (ATT_KROW(wt + 1) - rq + 7) * 32, jlo, q, h);
    }
#undef ATT_KROW
#undef ATT_TB
    f32x4 gvv[2][4];
    { const float* gain = (ISB ? T.onb : T.ona) + w * 64 + 4 * h;
#pragma unroll
      for (int db = 0; db < 2; ++db)
#pragma unroll
          for (int g = 0; g < 4; ++g) gvv[db][g] = *(const f32x4*)(gain + 32 * db + 8 * g); }
    float inv[2];
    LAS float* amx = ssx + 16896;
#pragma unroll
    for (int qb = 0; qb < 2; ++qb) { float lt = l[qb] + __shfl_xor(l[qb], 32); if (ISB) lt += sinkexp; inv[qb] = __builtin_amdgcn_rcpf(lt);
        float ss = 0.f, am = 0.f;
#pragma unroll
        for (int db = 0; db < 2; ++db)
#pragma unroll
            for (int rg = 0; rg < 16; ++rg) { const float o = O[qb][db][rg] * inv[qb]; ss += o * o; const float og = o * gvv[db][rg >> 2][rg & 3]; O[qb][db][rg] = og; am = fmaxf(am, fabsf(og)); }
        ss += __shfl_xor(ss, 32); am = fmaxf(am, __shfl_xor(am, 32));
        if (h == 0) { ssx[(32 * qb + q) * 8 + w] = ss; amx[(32 * qb + q) * 8 + w] = am; } }
    LDS_WAIT(); __syncthreads();
    unsigned char* Mp = T.MIX + (size_t)(t0 + q) * DM + (ISB ? 512 : 0) + w * 64 + 8 * h;
#pragma unroll
    for (int qb = 0; qb < 2; ++qb) {
        const f32x4 s0 = *(const LAS f32x4*)(ssx + (32 * qb + q) * 8), s1 = *(const LAS f32x4*)(ssx + (32 * qb + q) * 8 + 4);
        const f32x4 a0 = *(const LAS f32x4*)(amx + (32 * qb + q) * 8), a1 = *(const LAS f32x4*)(amx + (32 * qb + q) * 8 + 4);
        const float tot = ((s0[0] + s0[1]) + (s0[2] + s0[3])) + ((s1[0] + s1[1]) + (s1[2] + s1[3]));
        const float amax = fmaxf(fmaxf(fmaxf(a0[0], a0[1]), fmaxf(a0[2], a0[3])), fmaxf(fmaxf(a1[0], a1[1]), fmaxf(a1[2], a1[3])));
        const float rn = __builtin_amdgcn_rsqf(tot * (1.0f / 512.0f) + EPS);
        const float qs = amax > 0.f ? 127.0f / amax : 0.f;
        if (w == 0 && h == 0) (ISB ? T.SMB : T.SMA)[t0 + 32 * qb + q] = amax > 0.f ? amax * rn * (1.0f / 127.0f) : 1.0f;
#pragma unroll
        for (int db = 0; db < 2; ++db)
#pragma unroll
            for (int gp = 0; gp < 2; ++gp) {
                const unsigned a = q8x4(O[qb][db][8 * gp + 0], O[qb][db][8 * gp + 1], O[qb][db][8 * gp + 2], O[qb][db][8 * gp + 3], qs), b = q8x4(O[qb][db][8 * gp + 4], O[qb][db][8 * gp + 5], O[qb][db][8 * gp + 6], O[qb][db][8 * gp + 7], qs);
                const u32x2 r = __builtin_amdgcn_permlane32_swap(a, b, false, false);
                *(u32x2*)(Mp + (size_t)(32 * qb) * DM + 32 * db + 16 * gp) = r; }
    }
    LDS_WAIT(); __syncthreads();
}
__device__ __forceinline__ f32x16 attn_qk_r(const bf16x8 (&kf)[4], const bf16x8 (&qf)[4], f32x16 S) {
#pragma unroll
    for (int s = 0; s < 4; ++s) S = __builtin_amdgcn_mfma_f32_32x32x16_bf16(kf[s], qf[s], S, 0, 0, 0);
    return S;
}
template <int I> struct AWin { static constexpr int W0 = I == 0 ? 0 : (I == 1 ? 8 : (I == 2 ? 24 : 32)); };
__device__ __forceinline__ void attn_a_load_k(bf16x8 (&kf)[4], const bf16* kp) {
#pragma unroll
    for (int s = 0; s < 4; ++s) kf[s] = *(const bf16x8*)(kp + 512 * s);
}
template <int I>
__device__ __forceinline__ void attn_a_load_v(bf16x8 (&vf)[2][2], const bf16* vp) {
    constexpr int W0 = AWin<I>::W0;
#pragma unroll
    for (int db = 0; db < 2; ++db)
#pragma unroll
        for (int s = 0; s < 2; ++s) {
            constexpr int dummy = 0; (void)dummy;
            const int c0 = W0 + 16 * s, c1 = W0 + 16 * s + 8;
            const s16x4 lo = *(const s16x4*)(vp + (c0 >> 5) * 2048 + (2 * db + ((c0 & 31) >> 4)) * 512 + (((c0 & 31) >> 3) & 1) * 4);
            const s16x4 hi = *(const s16x4*)(vp + (c1 >> 5) * 2048 + (2 * db + ((c1 & 31) >> 4)) * 512 + (((c1 & 31) >> 3) & 1) * 4);
            vf[db][s] = (bf16x8){lo[0], lo[1], lo[2], lo[3], hi[0], hi[1], hi[2], hi[3]}; }
}
__device__ __forceinline__ void attn_a_step(f32x16 (&O)[2], float& l, const bf16x8 (&kf)[4], const bf16x8 (&vf)[2][2], const bf16x8 (&qf)[4], const f32x16& C, const f32x16& Bv) {
    const f32x16 S = attn_qk_r(kf, qf, C);
    float ls0 = 0.f, ls1 = 0.f;
#pragma unroll
    for (int s2 = 0; s2 < 2; ++s2) {
        float p[8];
#pragma unroll
        for (int j = 0; j < 8; ++j) p[j] = __builtin_amdgcn_exp2f(S[8 * s2 + j] + Bv[8 * s2 + j]);
        ls0 += (p[0] + p[1]) + (p[2] + p[3]); ls1 += (p[4] + p[5]) + (p[6] + p[7]);
        attn_pv_half(O, p, vf, s2);
    }
    l += ls0 + ls1;
    __builtin_amdgcn_sched_barrier(0);
}
template <int I>
__device__ __forceinline__ void attn_a_block(Frame& F, const AttnPtrs& T, int t0, int sb, int r0, int rows, const LAS float* tabA4, const LAS float* tabM4, LAS float* ssx) {
    constexpr int W0 = AWin<I>::W0; constexpr int NT = MPAD / 32;
    const int lane = fresh_lane(), w = F.wave, n = lane & 31, h = lane >> 5;
    const int qrow = r0 + (n >> 4), qcol = 16 * I + (n & 15), tq = 64 * (n >> 4) + qcol;
    int rsq = qrow - 4; rsq = rsq < 0 ? 0 : (rsq > rows - 8 ? rows - 8 : rsq);
    int rs0 = r0 - 4; rs0 = rs0 < 0 ? 0 : (rs0 > rows - 8 ? rows - 8 : rs0);
    int rs1 = r0 - 3; rs1 = rs1 < 0 ? 0 : (rs1 > rows - 8 ? rows - 8 : rs1);
    const int nk = rs1 + 8 - rs0;
    int cs = qcol - 8; cs = cs < 0 ? 0 : (cs > 48 ? 48 : cs);
    const int imv = 63 + W0 + 4 * h - cs;
    const int ibb = 63 + W0 + 4 * h - qcol - 32 * qrow + 32 * 7;
    const int colk = W0 + n;
    const bf16* Kp = T.KA + (size_t)w * NT * 2048 + (size_t)(colk >> 5) * 2048 + (32 * h + (colk & 31)) * 8;
    const bf16* Vp = T.VAT + (size_t)w * NT * 2048 + (32 * h + n) * 8;
    const bf16* Qp = T.QA + ((size_t)w * NT + ((t0 + tq) >> 5)) * 2048 + (32 * h + ((t0 + tq) & 31)) * 8;
    bf16x8 kfX[4], kfY[4], vfX[2][2], vfY[2][2], qf[4];
    attn_load_k(kfX, T.KA + (size_t)w * NT * 2048 + (size_t)(MTOK >> 5) * 2048 + lane * 8); attn_load_v(vfX, T.VAT + (size_t)w * NT * 2048 + (size_t)(MTOK >> 5) * 2048 + lane * 8);
    { const size_t to = (size_t)((sb + 64 * rs0) >> 5) * 2048; attn_a_load_k(kfY, Kp + to); attn_a_load_v<I>(vfY, Vp + to); }
#pragma unroll
    for (int s = 0; s < 4; ++s) qf[s] = __builtin_nontemporal_load((const bf16x8*)(Qp + 512 * s));
    f32x16 O[2]; O[0] = (f32x16){}; O[1] = (f32x16){}; float l = 0.f;
    f32x16 Cc = attn_tab16(tabM4, TM_CS, ((unsigned)(rs0 - rsq) < 8u) ? imv : 96), Bc = attn_tab16(tabA4, TA_CS, ibb + 32 * rs0);
    { const f32x16 S = attn_qk_r(kfX, qf, (f32x16){}); float p[8], ls = 0.f;
#pragma unroll
      for (int r = 0; r < 8; ++r) { p[r] = __builtin_amdgcn_exp2f(S[r]); ls += p[r]; }
      l += ls; attn_pv_half(O, p, vfX, 0);
      __builtin_amdgcn_sched_barrier(0); }
#pragma unroll 1
    for (int k = 0; k + 1 < nk; k += 2) {
        { const int kr = rs0 + k + 1; const size_t to = (size_t)((sb + 64 * kr) >> 5) * 2048; attn_a_load_k(kfX, Kp + to); attn_a_load_v<I>(vfX, Vp + to); }
        const f32x16 Cn = attn_tab16(tabM4, TM_CS, ((unsigned)(rs0 + k + 1 - rsq) < 8u) ? imv : 96), Bn = attn_tab16(tabA4, TA_CS, ibb + 32 * (rs0 + k + 1));
        attn_a_step(O, l, kfY, vfY, qf, Cc, Bc);
        { const int kn = k + 2 < nk ? k + 2 : nk - 1; const int kr = rs0 + kn; const size_t to = (size_t)((sb + 64 * kr) >> 5) * 2048; attn_a_load_k(kfY, Kp + to); attn_a_load_v<I>(vfY, Vp + to);
          Cc = attn_tab16(tabM4, TM_CS, ((unsigned)(kr - rsq) < 8u) ? imv : 96); Bc = attn_tab16(tabA4, TA_CS, ibb + 32 * kr); }
        attn_a_step(O, l, kfX, vfX, qf, Cn, Bn);
    }
    if (nk & 1) attn_a_step(O, l, kfY, vfY, qf, Cc, Bc);
    f32x4 gvv[2][4];
    { const float* gain = T.ona + w * 64 + 4 * h;
#pragma unroll
      for (int db = 0; db < 2; ++db)
#pragma unroll
          for (int g = 0; g < 4; ++g) gvv[db][g] = *(const f32x4*)(gain + 32 * db + 8 * g); }
    { const float lt = l + __shfl_xor(l, 32); const float inv = __builtin_amdgcn_rcpf(lt);
      float ss = 0.f, am = 0.f;
#pragma unroll
      for (int db = 0; db < 2; ++db)
#pragma unroll
          for (int rg = 0; rg < 16; ++rg) { const float o = O[db][rg] * inv; ss += o * o; const float og = o * gvv[db][rg >> 2][rg & 3]; O[db][rg] = og; am = fmaxf(am, fabsf(og)); }
      ss += __shfl_xor(ss, 32); am = fmaxf(am, __shfl_xor(am, 32));
      if (h == 0) { ssx[n * 8 + w] = ss; (ssx + 16896)[n * 8 + w] = am; } }
    LDS_WAIT(); __syncthreads();
    { unsigned char* Mp = T.MIX + (size_t)(t0 + tq) * DM + w * 64 + 8 * h;
      const LAS float* amx = ssx + 16896;
      const f32x4 s0 = *(const LAS f32x4*)(ssx + n * 8), s1 = *(const LAS f32x4*)(ssx + n * 8 + 4);
      const f32x4 a0 = *(const LAS f32x4*)(amx + n * 8), a1 = *(const LAS f32x4*)(amx + n * 8 + 4);
      const float tot = ((s0[0] + s0[1]) + (s0[2] + s0[3])) + ((s1[0] + s1[1]) + (s1[2] + s1[3]));
      const float amax = fmaxf(fmaxf(fmaxf(a0[0], a0[1]), fmaxf(a0[2], a0[3])), fmaxf(fmaxf(a1[0], a1[1]), fmaxf(a1[2], a1[3])));
      const float rn = __builtin_amdgcn_rsqf(tot * (1.0f / 512.0f) + EPS);
      const float qs = amax > 0.f ? 127.0f / amax : 0.f;
      if (w == 0 && h == 0) T.SMA[t0 + tq] = amax > 0.f ? amax * rn * (1.0f / 127.0f) : 1.0f;
#pragma unroll
      for (int db = 0; db < 2; ++db)
#pragma unroll
          for (int gp = 0; gp < 2; ++gp) {
              const unsigned a = q8x4(O[db][8 * gp + 0], O[db][8 * gp + 1], O[db][8 * gp + 2], O[db][8 * gp + 3], qs), b = q8x4(O[db][8 * gp + 4], O[db][8 * gp + 5], O[db][8 * gp + 6], O[db][8 * gp + 7], qs);
              const u32x2 r = __builtin_amdgcn_permlane32_swap(a, b, false, false);
              *(u32x2*)(Mp + 32 * db + 16 * gp) = r; } }
    LDS_WAIT(); __syncthreads();
}
__device__ __forceinline__ void attn_a_unit(Frame& F, const AttnPtrs& T, int t0, const LAS float* tabA4, const LAS float* tabM4, LAS float* ssx) {
    int sb, N; if (t0 < 16384) { sb = t0 & ~8191; N = 8192; } else { sb = 16384 + ((t0 - 16384) & ~4095); N = 4096; }
    const int r0 = (t0 - sb) >> 6, rows = N >> 6;
    attn_a_block<0>(F, T, t0, sb, r0, rows, tabA4, tabM4, ssx);
    attn_a_block<1>(F, T, t0, sb, r0, rows, tabA4, tabM4, ssx);
    attn_a_block<2>(F, T, t0, sb, r0, rows, tabA4, tabM4, ssx);
    attn_a_block<3>(F, T, t0, sb, r0, rows, tabA4, tabM4, ssx);
}
__device__ __forceinline__ void attn_phase(Frame& F, const AttnPtrs& T, const float* rpb, const float* t5, const float* sink) {
    const int lane = fresh_lane(), w = F.wave;
    LAS float* tabAB = (LAS float*)(F.lds + RING_OFF + w * 10240);
    LAS float* tabM = (LAS float*)(F.lds + RING_OFF + 81920);
    LAS float* ssx = (LAS float*)(F.lds + RING_OFF + 84480);
    LAS bf16x8* qlds = (LAS bf16x8*)(F.lds + RING_OFF + 86528 + w * 8192);
    for (int i = lane; i < 4 * TA_CS; i += 64) tabAB[i] = 0.f;
#pragma unroll
    for (int k = 0; k < 8; ++k) { int i = lane + 64 * k; i = i < 465 ? i : 464; const int dr = i / 31, dc = i - 31 * dr; const float v = rpb[w * 465 + i] * LOG2E; const int pos = 48 + 32 * dr + dc;
#pragma unroll
        for (int a = 0; a < 4; ++a) tabAB[a * TA_CS + pos - a] = v; }
    if (w == 0) for (int i = lane; i < TM_CS; i += 64) { const float v = (i >= 63 && i < 79) ? 0.f : -INFINITY;
#pragma unroll
        for (int a = 0; a < 4; ++a) if (i - a >= 0) tabM[a * TM_CS + i - a] = v; }
    const float sinkexp = __builtin_amdgcn_exp2f(sink[w] * LOG2E);
    LDS_WAIT(); __syncthreads();
#pragma unroll 1
    for (int u = F.vcu; u < 256; u += F.G) attn_a_unit(F, T, u * 128, tabAB, tabM, ssx);
#pragma unroll
    for (int k = 0; k < 6; ++k) { int i = lane + 64 * k; i = i < TB_CS ? i : TB_CS - 1; const int rel = i - 160; int n = rel < 0 ? -rel : rel; const bool ok = n <= 128; n = ok ? n : 128;
        const int lg = n < 8 ? n : (33 - __clz(n * n)); const int bk = (rel > 0 ? 16 : 0) + (lg > 15 ? 15 : lg); float v = t5[bk * 8 + w] * LOG2E; v = ok ? v : -INFINITY;
#pragma unroll
        for (int a = 0; a < 4; ++a) if (i - a >= 0) tabAB[a * TB_CS + i - a] = v; }
    LDS_WAIT(); asm volatile("" ::: "memory");
#pragma unroll 1
    for (int u = F.vcu; u < 512; u += F.G) attn_unit<true>(F, T, u * 64, tabAB, tabM, sinkexp, ssx, qlds);
}
template <bool NORM>
__device__ __forceinline__ void quant_rows(const bf16* src, signed char* dstq, float* scl, int nrows, int worker, int nworkers) {
    const int lane = threadIdx.x & 63;
    for (int m0 = worker; m0 < nrows; m0 += 4 * nworkers) {
        v4u v[4][2];
#pragma unroll
        for (int b = 0; b < 4; ++b) { int m = m0 + b * nworkers; m = m < nrows ? m : nrows - 1; const bf16* sp = src + (size_t)m * DM;
            v[b][0] = *(const GAS v4u*)(sp + lane * 16); v[b][1] = *(const GAS v4u*)(sp + lane * 16 + 8); }
#pragma unroll
        for (int b = 0; b < 4; ++b) { const int m = m0 + b * nworkers; if (m >= nrows) continue;
            float x[16];
#pragma unroll
            for (int k = 0; k < 2; ++k) { const v4u w = v[b][k];
                x[8 * k + 0] = __uint_as_float(w.x << 16); x[8 * k + 1] = __uint_as_float(w.x & 0xffff0000u); x[8 * k + 2] = __uint_as_float(w.y << 16); x[8 * k + 3] = __uint_as_float(w.y & 0xffff0000u);
                x[8 * k + 4] = __uint_as_float(w.z << 16); x[8 * k + 5] = __uint_as_float(w.z & 0xffff0000u); x[8 * k + 6] = __uint_as_float(w.w << 16); x[8 * k + 7] = __uint_as_float(w.w & 0xffff0000u); }
            float am = 0.f, ss = 0.f;
#pragma unroll
            for (int i = 0; i < 16; ++i) { am = fmaxf(am, fabsf(x[i])); ss += x[i] * x[i]; }
#pragma unroll
            for (int o = 1; o < 64; o <<= 1) { am = fmaxf(am, __shfl_xor(am, o)); if (NORM) ss += __shfl_xor(ss, o); }
            const float sc = am > 0.f ? am * (1.0f / 127.0f) : 1.0f, qs = am > 0.f ? 127.0f / am : 0.f;
            v4u q; q.x = q8x4(x[0], x[1], x[2], x[3], qs); q.y = q8x4(x[4], x[5], x[6], x[7], qs); q.z = q8x4(x[8], x[9], x[10], x[11], qs); q.w = q8x4(x[12], x[13], x[14], x[15], qs);
            *(GAS v4u*)(dstq + (size_t)m * DM + lane * 16) = q;
            if (lane == 0) scl[m] = NORM ? sc * __builtin_amdgcn_rsqf(ss * (1.0f / 1024.0f) + EPS) : sc;
        }
    }
}
#ifndef PROBE_PHASE
#define PROBE_PHASE -1
#endif
#ifndef MK_N_LAUNCHES
#define MK_N_LAUNCHES 1
#endif
constexpr int N_LAUNCHES = MK_N_LAUNCHES;
constexpr int PER_PHASE = 7;
struct Args { const float* in[19]; float* out; unsigned char* ws; int ph_lo, ph_hi, li, pad; };
__global__ void __launch_bounds__(NWAVES * 64, 2) hybrid_fwd(Args args_by_value) {
    __shared__ __attribute__((aligned(16))) unsigned char lds[LDS_BYTES];
    typedef const __attribute__((address_space(4))) Args* KArgs;
#define ENV() KArgs ap_ = (KArgs)__builtin_amdgcn_kernarg_segment_ptr(); asm volatile("" : "+s"(ap_)); \
    unsigned char* ws = ap_->ws; unsigned char* dout = (unsigned char*)ap_->out; \
    Frame F; F.lds = (LAS unsigned char*)lds; F.MISC = (volatile LAS unsigned*)(F.lds + MISC_OFF); F.wave = __builtin_amdgcn_readfirstlane((int)threadIdx.x >> 6); \
    F.G = gridDim.x; { const int bx = blockIdx.x; F.vcu = (F.G % 8 == 0) ? (bx % 8) * (F.G / 8) + bx / 8 : bx; } F.ctl = (gu32*)(ws + WS_CTL); \
    XcdBarrier bar; bar.bar = (unsigned*)(F.ctl + CW_BAR) + ap_->li * XCD_BAR_WORDS; bar.x = xb_xcc_id(); bar.st = F.MISC + 8; (void)dout; (void)bar
#define AIN(k) ((const float*)ap_->in[k])
    (void)args_by_value;
    int lo, hi;
    { ENV(); lo = ap_->ph_lo; hi = ap_->ph_hi;
      for (int u = threadIdx.x; u < (LDS_BYTES - LDSCTL_OFF) / 4; u += NWAVES * 64) ((LAS unsigned*)(F.lds + LDSCTL_OFF))[u] = 0u;
      __syncthreads();
      if (N_LAUNCHES != PER_PHASE) (void)xcd_barrier_post((unsigned*)(F.ctl + CW_BAR) + ap_->li * XCD_BAR_WORDS, F.MISC + 8); }
#define GRID_BAR() do { if (N_LAUNCHES != PER_PHASE) xcd_barrier(bar); } while (0)
#define LOCAL_BAR() do { if (N_LAUNCHES != PER_PHASE) xcd_local_barrier(bar); } while (0)
#ifndef PH_MASK
#define PH_MASK 127
#endif
#define IN(k) (((PH_MASK >> (k)) & 1) && lo <= (k) && (k) < hi)
#define BOTH(k) (IN(k) && IN((k) + 1))
#define P1_RAGGED() const int p1_units = (MPAD / 256) * (NIN / 256), p1_last = (p1_units - 1) / (int)gridDim.x, p1_busy = p1_units - p1_last * (int)gridDim.x, p1_idle = (int)gridDim.x - p1_busy; const bool defer_w = p1_idle >= 64
    if (IN(0)) { ENV(); P1_RAGGED(); p0_prologue(F, AIN(0), AIN(1), AIN(2), AIN(4), AIN(5), AIN(14), AIN(15), AIN(16), AIN(17), AIN(18),
            (bf16*)(ws + WS_WIN), (signed char*)(ws + WS_WOQ), (float*)(ws + WS_SWO), (signed char*)(ws + WS_WGQ), (float*)(ws + WS_SW), (bf16*)(ws + WS_WDN), (bf16*)(ws + WS_XN), (float*)(ws + WS_R1), defer_w); if (BOTH(0)) GRID_BAR(); }
    if (IN(1)) { ENV();
        pg8::Gemm g{(bf16*)(ws + WS_XN), (bf16*)(ws + WS_WIN), MPAD, NIN, DM}; pg8::StaticOrder S; S.init(MPAD, NIN, F.G, (int)blockIdx.x);
        pg8::EpiQKV E{ws, (PG8_LAS unsigned char*)(F.lds + RING_OFF + RING_BYTES), AIN(6), AIN(7), AIN(9), AIN(10), WS_QA, WS_KA, WS_VAT, WS_QB, WS_KB, WS_VBT, WS_R1};
        pg8::gemm_phase<pg8::EpiQKV, pg8::StaticOrder, true, true>(F.lds + RING_OFF, g, S, E);
    }
    if (IN(1)) { ENV();
        P1_RAGGED();
        if (defer_w && (int)blockIdx.x >= p1_busy) {
            p0_weight_tasks(F, AIN(14), AIN(15), AIN(16), AIN(17), (signed char*)(ws + WS_WOQ), (float*)(ws + WS_SWO), (signed char*)(ws + WS_WGQ), (float*)(ws + WS_SW), (int)blockIdx.x - p1_busy, p1_idle);
            p0_weight_items(F, AIN(4), AIN(5), AIN(18), (bf16*)(ws + WS_WIN), (bf16*)(ws + WS_WDN),
                            (LAS float*)(F.lds + RING_OFF + F.wave * 16384), P0_I_IN, P0_NITEMS, ((int)blockIdx.x - p1_busy) * NWAVES + F.wave, p1_idle * NWAVES);
        }
        if (BOTH(1)) GRID_BAR();
    }
    if (IN(2)) { ENV(); const AttnPtrs T{(bf16*)(ws + WS_QA), (bf16*)(ws + WS_KA), (bf16*)(ws + WS_VAT), (bf16*)(ws + WS_QB), (bf16*)(ws + WS_KB), (bf16*)(ws + WS_VBT), ws + WS_MIX, (float*)(ws + WS_SMA), (float*)(ws + WS_SMB), AIN(12), AIN(13)};
        attn_phase(F, T, AIN(8), AIN(3), AIN(11)); if (BOTH(2)) GRID_BAR(); }
    if (IN(3)) { ENV(); const XcdEnv xe = xcd_env(bar);
        pg8::Gemm g{(bf16*)(ws + WS_MIX), (bf16*)(ws + WS_WOQ), MTOK, DM, DM / 2}; pg8::XcdOrder S; S.init(MTOK, DM, xe.nloc, xe.rank, xe.nx, xe.xi);
        pg8::EpiOut E{(bf16*)(ws + WS_XN), (bf16*)(ws + WS_X1B), (const float*)(ws + WS_SMA), (const float*)(ws + WS_SMB), (const float*)(ws + WS_SWO)};
        pg8::gemm_phase<pg8::EpiOut, pg8::XcdOrder, true, true>(F.lds + RING_OFF, g, S, E);
        if (BOTH(3)) LOCAL_BAR();
    }
    if (IN(4)) { ENV(); const XcdEnv xe = xcd_env(bar);
        const int nM = MTOK / 256, r0 = (int)((long)xe.xi * nM / xe.nx) * 256, r1 = (int)((long)(xe.xi + 1) * nM / xe.nx) * 256;
        quant_rows<true>((const bf16*)(ws + WS_X1B) + (size_t)r0 * DM, (signed char*)(ws + WS_X1Q) + (size_t)r0 * DM, (float*)(ws + WS_SX) + r0, r1 - r0, xe.rank * NWAVES + F.wave, xe.nloc * NWAVES);
        if (BOTH(4)) LOCAL_BAR(); }
    if (IN(5)) { ENV(); const XcdEnv xe = xcd_env(bar);
        pg8::Gemm g{(bf16*)(ws + WS_X1Q), (bf16*)(ws + WS_WGQ), MTOK, NGU, DM / 2}; pg8::XcdOrder S; S.init(MTOK, NGU, xe.nloc, xe.rank, xe.nx, xe.xi);
        pg8::EpiGU E{nullptr, (const float*)(ws + WS_SX), (const float*)(ws + WS_SW), (bf16*)(ws + WS_H)};
        pg8::gemm_phase<pg8::EpiGU, pg8::XcdOrder, true, true>(F.lds + RING_OFF, g, S, E);
        if (BOTH(5)) LOCAL_BAR();
    }
    if (IN(6)) { ENV(); const XcdEnv xe = xcd_env(bar);
        pg8::Gemm g{(bf16*)(ws + WS_H), (bf16*)(ws + WS_WDN), MTOK, DM, DFF}; pg8::XcdOrder S; S.init(MTOK, DM, xe.nloc, xe.rank, xe.nx, xe.xi);
        pg8::EpiDown E{(bf16*)(ws + WS_X1B), (float*)ap_->out};
        pg8::gemm_phase<pg8::EpiDown, pg8::XcdOrder, true, true>(F.lds + RING_OFF, g, S, E);
    }
#undef IN
#undef BOTH
}

extern "C" void kernel_launch(void* const* d_in, const int* in_sizes, int n_in, void* d_out, int out_size, void* d_ws, size_t ws_size, hipStream_t stream) {
    static int grid = 0;
    if (grid == 0) {
        if (n_in != 19 || out_size != MTOK * DM || ws_size < WS_END) { fprintf(stderr, "kernel_launch: unexpected shapes: n_in %d out %d ws %zu; nothing launched\n", n_in, out_size, ws_size); grid = -1; return; }
        int dev = 0, cus = 0;
        if (hipGetDevice(&dev) != hipSuccess || hipDeviceGetAttribute(&cus, hipDeviceAttributeMultiprocessorCount, dev) != hipSuccess) { grid = -1; return; }
        (void)hipGetLastError();
        grid = cus;
    }
    if (grid < 0) return;
    if (hipMemsetAsync((char*)d_ws + WS_CTL, 0, CTL_ZERO_BYTES, stream) != hipSuccess) { fprintf(stderr, "kernel_launch: memset failed\n"); return; }
    Args a{};
    for (int i = 0; i < 19; ++i) a.in[i] = (const float*)d_in[i];
    a.out = (float*)d_out; a.ws = (unsigned char*)d_ws;
#if PROBE_PHASE >= 0
    const int nl = 2; const int los[2] = {0, PROBE_PHASE}, his[2] = {PROBE_PHASE + 1, PER_PHASE};
#else
    const int nl = N_LAUNCHES;
#endif
    for (int li = 0; li < nl; ++li) {
#if PROBE_PHASE >= 0
        a.ph_lo = los[li]; a.ph_hi = his[li]; a.li = li;
#else
        a.ph_lo = (N_LAUNCHES == PER_PHASE) ? li : 0; a.ph_hi = (N_LAUNCHES == PER_PHASE) ? li + 1 : PER_PHASE; a.li = 0;
#endif
        hipLaunchKernelGGL(hybrid_fwd, dim3(grid), dim3(NWAVES * 64), 0, stream, a);
        const hipError_t le = hipPeekAtLastError();
        if (le != hipSuccess) { fprintf(stderr, "kernel_launch: launch %d failed: %s\n", li, hipGetErrorName(le)); break; }
    }
}
```

```cpp
#include <hip/hip_runtime.h>
#include <cstdio>
#include <cstdint>
namespace pg8 {
#define PG8_LAS __attribute__((address_space(3)))
typedef unsigned short bf16_t;
typedef short bf16x8 __attribute__((ext_vector_type(8)));
typedef float f32x4 __attribute__((ext_vector_type(4)));
typedef unsigned u32x4 __attribute__((ext_vector_type(4)));
typedef int i32x4 __attribute__((ext_vector_type(4)));
constexpr int BM = 256, BK = 64, HALF = 128, HTB = HALF * BK * 2  , STAGE_BYTES = 8 * HTB, NXCD = 8, WGM = 8;

__host__ __device__ __forceinline__ int lds_byte(int r, int c) { const int st = (r >> 4) * 2 + (c >> 5), rr = r & 15, cc = c & 31, ob = rr * 64 + cc * 2; return st * 1024 + (ob ^ (((ob >> 9) & 1) << 5)); }
__host__ __device__ __forceinline__ void stage_rc(int b, int& R, int& C) { const int st = b / 1024, sb = b % 1024, swz = sb ^ (((sb >> 9) & 1) << 5); R = (st >> 1) * 16 + swz / 64; C = (st & 1) * 32 + (swz % 64) / 2; }
__host__ __device__ __forceinline__ int perm32(int rho) { const int n = rho >> 4, i = rho & 15; return 8 * (i >> 2) + 4 * n + (i & 3); }

struct Unit { int pm, pn; };
struct Gemm { const bf16_t* A; const bf16_t* Bt; int M, N, K; };

struct StaticOrder {
    int nM, nN, nwg, G, c;
    __host__ __device__ void init(int M, int N, int G_, int c_) { nM = M / BM; nN = N / BM; nwg = nM * nN; G = G_; c = c_; }
    __host__ __device__ bool next(int i, Unit& u) const {
        const long L = (long)i * G + c; if (L >= nwg) return false;
        int wgid = (int)L; { const int q = nwg / NXCD, r = nwg % NXCD, xcd = wgid % NXCD, off = wgid / NXCD; wgid = (xcd < r ? xcd * (q + 1) : r * (q + 1) + (xcd - r) * q) + off; }
        const int nig = WGM * nN, gid = wgid / nig, fm = gid * WGM, gsz = (nM - fm) < WGM ? (nM - fm) : WGM;
        u.pm = fm + ((wgid % nig) % gsz); u.pn = (wgid % nig) / gsz; return true;
    }
    __device__ __forceinline__ void a_ready(const Unit&) const {}
    __device__ __forceinline__ void done(const Unit&) const {}
};

struct XcdOrder {
    int nN, p0, cnt, nloc, rank;
    __host__ __device__ void init(int M, int N, int nloc_, int rank_, int nx, int xi) { const int nM = M / BM; nN = N / BM; p0 = (int)((long)xi * nM / nx); const int p1 = (int)((long)(xi + 1) * nM / nx); cnt = (p1 - p0) * nN; nloc = nloc_; rank = rank_; }
    __host__ __device__ bool next(int i, Unit& u) const {
        const long L = (long)i * nloc + rank; if (L >= cnt) return false;
        const int w = (int)L, np = cnt / nN, nig = WGM * nN, gid = w / nig, fm = gid * WGM, gsz = (np - fm) < WGM ? (np - fm) : WGM;
        u.pm = p0 + fm + ((w % nig) % gsz); u.pn = (w % nig) / gsz; return true;
    }
    __device__ __forceinline__ void a_ready(const Unit&) const {}
    __device__ __forceinline__ void done(const Unit&) const {}
};
struct RevOrder {
    StaticOrder s;
    __host__ __device__ void init(int M, int N, int G_, int c_) { s.init(M, N, G_, c_); }
    __host__ __device__ bool next(int i, Unit& u) const { const bool r = s.next(i, u); u.pm = s.nM - 1 - u.pm; return r; }
    __device__ __forceinline__ void a_ready(const Unit&) const {}
    __device__ __forceinline__ void done(const Unit&) const {}
};

typedef float f32x2_t __attribute__((ext_vector_type(2))); typedef __bf16 bf16x2_t __attribute__((ext_vector_type(2)));
__device__ __forceinline__ unsigned cvt_pk_bf16(float lo, float hi) { f32x2_t v = {lo, hi}; bf16x2_t b = __builtin_convertvector(v, bf16x2_t); return __builtin_bit_cast(unsigned, b); }
constexpr int MP_ROWS = 33024, MP_TOK = 32768;
constexpr float RMS_EPS = 1e-6f;
constexpr float QSCALE = 0.125f * 1.4426950408889634f;

struct EpiQKV {
    typedef f32x4 acc_t;
    static constexpr bool PERM = true, AFTER_DRAIN = false, MIDK = false, TILED = false;
    unsigned char* ws; PG8_LAS unsigned char* vtl; const float *qna, *kna, *qnb, *knb;
    size_t oQA, oKA, oVAt, oQB, oKB, oVBt, oR1;
    __device__ __forceinline__ void operator()(const f32x4 (&acc)[2][2][4][2], const Unit& u, int wr, int wc, int fr, int fq) const {
        constexpr int NT = MP_ROWS / 32;
        const int pn = u.pn, row0 = u.pm * BM + wr * 64 + fr, sec = pn >> 1;
        bf16_t* dst; int head = 4 * (pn & 1) + wc; const float* gain = nullptr; float sc = 1.f; bool isV = false;
        const float* R1 = (const float*)(ws + oR1);
        if (sec == 0) { dst = (bf16_t*)(ws + oQA); gain = qna; sc = QSCALE; }
        else if (sec == 1) { dst = (bf16_t*)(ws + oKA); gain = kna; }
        else if (sec == 2) { dst = (bf16_t*)(ws + oVAt); isV = true; }
        else if (sec == 3) { dst = (bf16_t*)(ws + oQB); gain = qnb; sc = QSCALE; }
        else { if (wc < 2) { dst = (bf16_t*)(ws + oKB); head = wc; gain = knb; } else { dst = (bf16_t*)(ws + oVBt); head = wc - 2; isV = true; } }
        bf16_t* hbase = dst + (size_t)head * NT * 2048;
#define EPI_R1V() float r1v[2][4]; _Pragma("unroll") for (int ai = 0; ai < 2; ++ai) _Pragma("unroll") for (int m = 0; m < 4; ++m) r1v[ai][m] = R1[row0 + ai * HALF + m * 16]
        if (!isV) {
            EPI_R1V();
            f32x4 gv[2][2];
#pragma unroll
            for (int bj = 0; bj < 2; ++bj)
#pragma unroll
                for (int n = 0; n < 2; ++n) gv[bj][n] = *(const f32x4*)(gain + 32 * bj + 8 * fq + 4 * n) * sc;
#pragma unroll
            for (int ai = 0; ai < 2; ++ai)
#pragma unroll
                for (int m = 0; m < 4; ++m) {
                    float ss = 0.f;
#pragma unroll
                    for (int bj = 0; bj < 2; ++bj)
#pragma unroll
                        for (int n = 0; n < 2; ++n) { const f32x4 x = acc[ai][bj][m][n]; ss += (x[0] * x[0] + x[1] * x[1]) + (x[2] * x[2] + x[3] * x[3]); }
                    ss += __shfl_xor(ss, 16); ss += __shfl_xor(ss, 32);
                    const int row = row0 + ai * HALF + m * 16;
                    const float r1 = r1v[ai][m];
                    const float r = r1 * __builtin_amdgcn_rsqf(ss * (r1 * r1) * (1.0f / 64.0f) + RMS_EPS);
                    bf16_t* rowp = hbase + (size_t)(row >> 5) * 2048 + (fq >> 1) * 512 + ((fq & 1) * 32 + (row & 31)) * 8;
#pragma unroll
                    for (int bj = 0; bj < 2; ++bj) { const f32x4 v0 = acc[ai][bj][m][0] * r * gv[bj][0], v1 = acc[ai][bj][m][1] * r * gv[bj][1];
                        u32x4 w; w.x = cvt_pk_bf16(v0[0], v0[1]); w.y = cvt_pk_bf16(v0[2], v0[3]); w.z = cvt_pk_bf16(v1[0], v1[1]); w.w = cvt_pk_bf16(v1[2], v1[3]);
                        *(u32x4*)(rowp + bj * 1024) = w; }
                }
        } else {
            EPI_R1V();
            PG8_LAS unsigned short* vt = (PG8_LAS unsigned short*)(vtl + (wr * 4 + wc) * 2048);
            const int hh = (fr >> 2) & 1, jj = 4 * ((fr >> 3) & 1) + (fr & 3), wofs = (32 * hh + 8 * fq) * 8 + jj, ln = fq * 16 + fr;
#pragma unroll
            for (int ai = 0; ai < 2; ++ai)
#pragma unroll
                for (int m = 0; m < 4; ++m) { const int row = row0 + ai * HALF + m * 16; const float r1 = r1v[ai][m];
                    bf16_t* tb = hbase + (size_t)(row >> 5) * 2048 + (m & 1) * 512 + ln * 8;
#pragma unroll
                    for (int bj = 0; bj < 2; ++bj) { PG8_LAS unsigned short* buf = vt + bj * 512;
#pragma unroll
                        for (int n = 0; n < 2; ++n) { const f32x4 x = acc[ai][bj][m][n] * r1; const unsigned w0 = cvt_pk_bf16(x[0], x[1]), w1 = cvt_pk_bf16(x[2], x[3]);
                            buf[wofs + (4 * n + 0) * 8] = (unsigned short)(w0 & 0xffffu); buf[wofs + (4 * n + 1) * 8] = (unsigned short)(w0 >> 16);
                            buf[wofs + (4 * n + 2) * 8] = (unsigned short)(w1 & 0xffffu); buf[wofs + (4 * n + 3) * 8] = (unsigned short)(w1 >> 16); }
                        const u32x4 w = *(const PG8_LAS u32x4*)(buf + ln * 8);
                        *(u32x4*)(tb + bj * 1024) = w; }
                }
        }
    }
};
struct EpiOut {
    typedef i32x4 acc_t;
    static constexpr bool PERM = true, AFTER_DRAIN = false, MIDK = true, TILED = false;
    const bf16_t* XB; bf16_t* X1B; const float *SMA, *SMB, *SWO;
    __device__ __forceinline__ void pre(float (&rsc)[2][4], const Unit& u, int wr, int fr) const {
        const int row0 = u.pm * BM + wr * 64 + fr; float sa[2][4], sb[2][4];
#pragma unroll
        for (int ai = 0; ai < 2; ++ai)
#pragma unroll
            for (int m = 0; m < 4; ++m) { sa[ai][m] = SMA[row0 + ai * HALF + m * 16]; sb[ai][m] = SMB[row0 + ai * HALF + m * 16]; }
#pragma unroll
        for (int ai = 0; ai < 2; ++ai)
#pragma unroll
            for (int m = 0; m < 4; ++m) rsc[ai][m] = sa[ai][m] / sb[ai][m];
    }
    __device__ __forceinline__ void mid(i32x4 (&acc)[2][2][4][2], const float (&rsc)[2][4]) const {
#pragma unroll
        for (int ai = 0; ai < 2; ++ai)
#pragma unroll
            for (int bj = 0; bj < 2; ++bj)
#pragma unroll
                for (int m = 0; m < 4; ++m)
#pragma unroll
                    for (int n = 0; n < 2; ++n)
#pragma unroll
                        for (int i = 0; i < 4; ++i) acc[ai][bj][m][n][i] = (int)__builtin_rintf((float)acc[ai][bj][m][n][i] * rsc[ai][m]);
    }
    __device__ __forceinline__ void operator()(const i32x4 (&acc)[2][2][4][2], const Unit& u, int wr, int wc, int fr, int fq) const {
        const int row0 = u.pm * BM + wr * 64 + fr, colb = u.pn * BM + wc * 32 + 8 * fq;
        f32x4 swv[2][2];
#pragma unroll
        for (int bj = 0; bj < 2; ++bj)
#pragma unroll
            for (int n = 0; n < 2; ++n) swv[bj][n] = *(const f32x4*)(SWO + colb + bj * HALF + 4 * n);
#pragma unroll
        for (int ai = 0; ai < 2; ++ai) {
            u32x4 xb[4][2]; float sb[4];
#pragma unroll
            for (int m = 0; m < 4; ++m) { sb[m] = SMB[row0 + ai * HALF + m * 16];
#pragma unroll
                for (int bj = 0; bj < 2; ++bj) xb[m][bj] = __builtin_nontemporal_load((const u32x4*)(XB + (size_t)(row0 + ai * HALF + m * 16) * 1024 + colb + bj * HALF)); }
#pragma unroll
            for (int m = 0; m < 4; ++m) { const int row = row0 + ai * HALF + m * 16;
#pragma unroll
                for (int bj = 0; bj < 2; ++bj) { const u32x4 w = xb[m][bj];
                    f32x4 x0, x1; x0[0] = __uint_as_float(w.x << 16); x0[1] = __uint_as_float(w.x & 0xffff0000u); x0[2] = __uint_as_float(w.y << 16); x0[3] = __uint_as_float(w.y & 0xffff0000u);
                    x1[0] = __uint_as_float(w.z << 16); x1[1] = __uint_as_float(w.z & 0xffff0000u); x1[2] = __uint_as_float(w.w << 16); x1[3] = __uint_as_float(w.w & 0xffff0000u);
                    f32x4 v0, v1;
#pragma unroll
                    for (int i = 0; i < 4; ++i) { v0[i] = (float)acc[ai][bj][m][0][i] * (sb[m] * swv[bj][0][i]) + x0[i]; v1[i] = (float)acc[ai][bj][m][1][i] * (sb[m] * swv[bj][1][i]) + x1[i]; }
                    u32x4 o; o.x = cvt_pk_bf16(v0[0], v0[1]); o.y = cvt_pk_bf16(v0[2], v0[3]); o.z = cvt_pk_bf16(v1[0], v1[1]); o.w = cvt_pk_bf16(v1[2], v1[3]);
                    *(u32x4*)(X1B + (size_t)row * 1024 + colb + bj * HALF) = o; }
            }
        }
    }
};
struct EpiGU {
    typedef i32x4 acc_t;
    static constexpr bool PERM = true, AFTER_DRAIN = false, MIDK = false, TILED = false;
    const float *SS2, *SX, *SW; bf16_t* H;
    __device__ __forceinline__ void operator()(const i32x4 (&acc)[2][2][4][2], const Unit& u, int wr, int wc, int fr, int fq) const {
        const int row0 = u.pm * BM + wr * 64 + fr, colb = u.pn * HALF + wc * 32 + 8 * fq;
        float sx[2][4]; f32x4 swv[2][2];
#pragma unroll
        for (int ai = 0; ai < 2; ++ai)
#pragma unroll
            for (int m = 0; m < 4; ++m) sx[ai][m] = SX[row0 + ai * HALF + m * 16];
#pragma unroll
        for (int bj = 0; bj < 2; ++bj)
#pragma unroll
            for (int n = 0; n < 2; ++n) swv[bj][n] = *(const f32x4*)(SW + u.pn * BM + bj * HALF + wc * 32 + 8 * fq + 4 * n);
#pragma unroll
        for (int ai = 0; ai < 2; ++ai)
#pragma unroll
            for (int m = 0; m < 4; ++m) { const int row = row0 + ai * HALF + m * 16;
                const float r = sx[ai][m];
                float hv[8];
#pragma unroll
                for (int n = 0; n < 2; ++n)
#pragma unroll
                    for (int i = 0; i < 4; ++i) { const float g = (float)acc[ai][0][m][n][i] * (r * swv[0][n][i]), up = (float)acc[ai][1][m][n][i] * (r * swv[1][n][i]);
                        const float e = __builtin_amdgcn_exp2f(g * -1.4426950408889634f); hv[4 * n + i] = g * up * __builtin_amdgcn_rcpf(1.0f + e); }
                u32x4 w; w.x = cvt_pk_bf16(hv[0], hv[1]); w.y = cvt_pk_bf16(hv[2], hv[3]); w.z = cvt_pk_bf16(hv[4], hv[5]); w.w = cvt_pk_bf16(hv[6], hv[7]);
                *(u32x4*)(H + ((size_t)(colb >> 6) * MP_TOK + row) * 64 + (colb & 63)) = w;
            }
    }
};
struct EpiDown {
    typedef f32x4 acc_t;
    static constexpr bool PERM = true, AFTER_DRAIN = false, MIDK = false, TILED = true;
    const bf16_t* X1B; float* out;
    __device__ __forceinline__ void operator()(const f32x4 (&acc)[2][2][4][2], const Unit& u, int wr, int wc, int fr, int fq) const {
        const int row0 = u.pm * BM + wr * 64 + fr, colb = u.pn * BM + wc * 32 + 8 * fq;
        u32x4 xb[2][4][2];
#pragma unroll
        for (int ai = 0; ai < 2; ++ai)
#pragma unroll
            for (int m = 0; m < 4; ++m)
#pragma unroll
                for (int bj = 0; bj < 2; ++bj) xb[ai][m][bj] = __builtin_nontemporal_load((const u32x4*)(X1B + (size_t)(row0 + ai * HALF + m * 16) * 1024 + colb + bj * HALF));
#pragma unroll
        for (int ai = 0; ai < 2; ++ai)
#pragma unroll
            for (int m = 0; m < 4; ++m) { const size_t off = (size_t)(row0 + ai * HALF + m * 16) * 1024 + colb;
#pragma unroll
                for (int bj = 0; bj < 2; ++bj) { const u32x4 w = xb[ai][m][bj];
                    f32x4 x0, x1; x0[0] = __uint_as_float(w.x << 16); x0[1] = __uint_as_float(w.x & 0xffff0000u); x0[2] = __uint_as_float(w.y << 16); x0[3] = __uint_as_float(w.y & 0xffff0000u);
                    x1[0] = __uint_as_float(w.z << 16); x1[1] = __uint_as_float(w.z & 0xffff0000u); x1[2] = __uint_as_float(w.w << 16); x1[3] = __uint_as_float(w.w & 0xffff0000u);
                    *(f32x4*)(out + off + bj * HALF) = acc[ai][bj][m][0] + x0; *(f32x4*)(out + off + bj * HALF + 4) = acc[ai][bj][m][1] + x1; }
            }
    }
};

__device__ __forceinline__ f32x4 mma16(bf16x8 a, bf16x8 b, f32x4 c) { return __builtin_amdgcn_mfma_f32_16x16x32_bf16(a, b, c, 0, 0, 0); }
__device__ __forceinline__ i32x4 mma16(bf16x8 a, bf16x8 b, i32x4 c) { return __builtin_amdgcn_mfma_i32_16x16x64_i8(__builtin_bit_cast(i32x4, a), __builtin_bit_cast(i32x4, b), c, 0, 0, 0); }
template <class Epi, class Sched, bool ALIGN_EPI = false, bool SP2 = false>
__device__ __forceinline__ void gemm_phase(PG8_LAS unsigned char* lds, const Gemm g, const Sched& S, const Epi& E) {
    const int tid = threadIdx.x, wid = __builtin_amdgcn_readfirstlane(tid >> 6), lane = tid & 63, wr = wid >> 2, wc = wid & 3, fr = lane & 15, fq = lane >> 4;
    const int K = g.K, nt = K / BK;
    constexpr bool TILED = Epi::TILED;
    const int ldE = TILED ? BK : K;
    unsigned voffA[2], voffB[2];
#pragma unroll
    for (int i = 0; i < 2; ++i) { int R, C; stage_rc(tid * 16 + i * 8192, R, C); const int Rb = Epi::PERM ? ((R & ~31) + perm32(R & 31)) : R;
        voffA[i] = (unsigned)(R * ldE + C) * 2u; voffB[i] = (unsigned)(Rb * ldE + C) * 2u; }
    const size_t kstepA = TILED ? (size_t)g.M * BK * 2 : (size_t)(BK * 2);
    const size_t kstepB = TILED ? (size_t)g.N * BK * 2 : (size_t)(BK * 2);
    const size_t hstep = (size_t)HALF * ldE * 2;
    const size_t tstep = 2 * hstep;
    const unsigned ldsw = (unsigned)wid * 1024u;
    const int aoff = lds_byte(wr * 64 + fr, fq * 8), boff = lds_byte(wc * 32 + fr, fq * 8);
#define PG8_SA(b, h) (((b) * 2 + (h)) * HTB)
#define PG8_SB(b, h) ((4 + (b) * 2 + (h)) * HTB)
#define PG8_STAGE(bufoff, gbase, voff) do { _Pragma("unroll") for (int _i = 0; _i < 2; ++_i) \
        __builtin_amdgcn_global_load_lds((const unsigned*)((const char*)(gbase) + (voff)[_i]), (PG8_LAS unsigned*)(lds + (bufoff) + ldsw + _i * 8192), 16, 0, 0); } while (0)
#define PG8_LDA(dst, b, h) do { _Pragma("unroll") for (int m = 0; m < 4; ++m) _Pragma("unroll") for (int k = 0; k < 2; ++k) dst[m][k] = *(const PG8_LAS bf16x8*)(lds + PG8_SA(b, h) + aoff + m * 2048 + k * 1024); } while (0)
#define PG8_LDB(dst, b, h) do { _Pragma("unroll") for (int n = 0; n < 2; ++n) _Pragma("unroll") for (int k = 0; k < 2; ++k) dst[n][k] = *(const PG8_LAS bf16x8*)(lds + PG8_SB(b, h) + boff + n * 2048 + k * 1024); } while (0)
#define PG8_MMA(ai, bj, At, Bt) do { __builtin_amdgcn_s_setprio(1); _Pragma("unroll") for (int m = 0; m < 4; ++m) _Pragma("unroll") for (int n = 0; n < 2; ++n) _Pragma("unroll") for (int k = 0; k < 2; ++k) \
        acc[ai][bj][m][n] = mma16(Bt[n][k], At[m][k], acc[ai][bj][m][n]); __builtin_amdgcn_s_setprio(0); } while (0)
#define PG8_WAIT_V(n) asm volatile("s_waitcnt vmcnt(" #n ")" ::: "memory")
#define PG8_WAIT_L(n) asm volatile("s_waitcnt lgkmcnt(" #n ")" ::: "memory")
#define PG8_BAR __builtin_amdgcn_s_barrier()
#define PG8_SCHED __builtin_amdgcn_sched_barrier(0)
    Unit cur, nxt; int ui = 0;
    if (!S.next(0, cur)) return;
    typedef typename Epi::acc_t acc_t;
    acc_t acc[2][2][4][2];
#pragma unroll
    for (int a = 0; a < 2; ++a)
#pragma unroll
        for (int b = 0; b < 2; ++b)
#pragma unroll
            for (int m = 0; m < 4; ++m)
#pragma unroll
                for (int n = 0; n < 2; ++n) acc[a][b][m][n] = (acc_t){};
    bf16x8 At[4][2], B0[2][2], B1[2][2];
    const char* cA = (const char*)g.A + (size_t)cur.pm * tstep; const char* cB = (const char*)g.Bt + (size_t)cur.pn * tstep;
    S.a_ready(cur);
    if constexpr (SP2) {
        PG8_STAGE(PG8_SB(0, 0), cB, voffB); PG8_STAGE(PG8_SB(0, 1), cB + hstep, voffB); PG8_STAGE(PG8_SA(0, 0), cA, voffA); PG8_STAGE(PG8_SA(0, 1), cA + hstep, voffA);
        if (wr == 1) PG8_BAR;
        PG8_WAIT_V(2); PG8_BAR;
        PG8_STAGE(PG8_SB(1, 0), cB + kstepB, voffB); PG8_STAGE(PG8_SA(1, 0), cA + kstepA, voffA); PG8_STAGE(PG8_SB(1, 1), cB + hstep + kstepB, voffB);
        PG8_WAIT_V(6); PG8_BAR;
    } else {
        PG8_STAGE(PG8_SB(0, 0), cB, voffB); PG8_STAGE(PG8_SA(0, 0), cA, voffA); PG8_STAGE(PG8_SB(0, 1), cB + hstep, voffB); PG8_STAGE(PG8_SA(0, 1), cA + hstep, voffA);
        if (wr == 1) PG8_BAR;
        PG8_WAIT_V(4); PG8_BAR;
        PG8_STAGE(PG8_SB(1, 0), cB + kstepB, voffB); PG8_STAGE(PG8_SA(1, 0), cA + kstepA, voffA); PG8_STAGE(PG8_SB(1, 1), cB + hstep + kstepB, voffB);
        PG8_WAIT_V(6); PG8_BAR;
    }
    for (;;) {
        const bool has_next = S.next(ui + 1, nxt);
        float rsc[2][4];
        if constexpr (Epi::MIDK) E.pre(rsc, cur, wr, fr);
        const char* nA = has_next ? (const char*)g.A + (size_t)nxt.pm * tstep : cA; const char* nB = has_next ? (const char*)g.Bt + (size_t)nxt.pn * tstep : cB;
        for (int t = 0; t < nt; t += 2) {
            const bool last = (t == nt - 2);
            const char* a1 = cA + (size_t)(t + 1) * kstepA;
            const char* a2 = last ? nA : cA + (size_t)(t + 2) * kstepA; const char* b2 = last ? nB : cB + (size_t)(t + 2) * kstepB;
            const char* a3 = a2 + kstepA; const char* b3 = b2 + kstepB;
            if (last && has_next) S.a_ready(nxt);
            if constexpr (Epi::MIDK) { if (t == nt / 2) E.mid(acc, rsc); }
            if constexpr (SP2) {
            PG8_LDB(B0, 0, 0); PG8_LDB(B1, 0, 1); PG8_SCHED; PG8_LDA(At, 0, 0); PG8_STAGE(PG8_SA(1, 1), a1 + hstep, voffA);
            PG8_WAIT_V(8); PG8_WAIT_L(0); PG8_BAR; PG8_MMA(0, 0, At, B0); PG8_MMA(0, 1, At, B1); PG8_BAR; PG8_SCHED;
            PG8_LDA(At, 0, 1); PG8_STAGE(PG8_SB(0, 0), b2, voffB); PG8_STAGE(PG8_SB(0, 1), b2 + hstep, voffB); PG8_STAGE(PG8_SA(0, 0), a2, voffA);
            PG8_WAIT_V(8); PG8_WAIT_L(0); PG8_BAR; PG8_MMA(1, 0, At, B0); PG8_MMA(1, 1, At, B1); PG8_BAR; PG8_SCHED;
            PG8_LDB(B0, 1, 0); PG8_LDB(B1, 1, 1); PG8_SCHED; PG8_LDA(At, 1, 0); PG8_STAGE(PG8_SA(0, 1), a2 + hstep, voffA);
            PG8_WAIT_V(8); PG8_WAIT_L(0); PG8_BAR; PG8_MMA(0, 0, At, B0); PG8_MMA(0, 1, At, B1); PG8_BAR; PG8_SCHED;
            PG8_LDA(At, 1, 1); PG8_STAGE(PG8_SB(1, 0), b3, voffB); PG8_STAGE(PG8_SB(1, 1), b3 + hstep, voffB); PG8_STAGE(PG8_SA(1, 0), a3, voffA);
            PG8_WAIT_V(8); PG8_WAIT_L(0); PG8_BAR; PG8_MMA(1, 0, At, B0); PG8_MMA(1, 1, At, B1); PG8_BAR; PG8_SCHED;
            } else {
            PG8_LDB(B0, 0, 0); PG8_SCHED; PG8_LDA(At, 0, 0); PG8_STAGE(PG8_SA(1, 1), a1 + hstep, voffA);
            PG8_WAIT_L(8); PG8_BAR; PG8_WAIT_L(0); PG8_MMA(0, 0, At, B0); PG8_BAR; PG8_SCHED;
            PG8_LDB(B1, 0, 1); PG8_STAGE(PG8_SB(0, 0), b2, voffB);
            PG8_BAR; PG8_WAIT_L(0); PG8_MMA(0, 1, At, B1); PG8_BAR;
            PG8_LDA(At, 0, 1); PG8_STAGE(PG8_SA(0, 0), a2, voffA);
            PG8_BAR; PG8_WAIT_L(0); PG8_MMA(1, 0, At, B0); PG8_BAR; PG8_SCHED;
            PG8_STAGE(PG8_SB(0, 1), b2 + hstep, voffB);
            PG8_WAIT_V(6); PG8_BAR; PG8_MMA(1, 1, At, B1); PG8_BAR;
            PG8_LDB(B0, 1, 0); PG8_SCHED; PG8_LDA(At, 1, 0); PG8_STAGE(PG8_SA(0, 1), a2 + hstep, voffA);
            PG8_WAIT_L(8); PG8_BAR; PG8_WAIT_L(0); PG8_MMA(0, 0, At, B0); PG8_BAR; PG8_SCHED;
            PG8_LDB(B1, 1, 1); PG8_STAGE(PG8_SB(1, 0), b3, voffB);
            PG8_BAR; PG8_WAIT_L(0); PG8_MMA(0, 1, At, B1); PG8_BAR;
            PG8_LDA(At, 1, 1); PG8_STAGE(PG8_SA(1, 0), a3, voffA);
            PG8_BAR; PG8_WAIT_L(0); PG8_MMA(1, 0, At, B0); PG8_BAR; PG8_SCHED;
            PG8_STAGE(PG8_SB(1, 1), b3 + hstep, voffB);
            PG8_WAIT_V(6); PG8_BAR; PG8_MMA(1, 1, At, B1); PG8_BAR;
            }
        }
        if constexpr (ALIGN_EPI) { if (wr == 0) PG8_BAR; }
        if constexpr (!Epi::AFTER_DRAIN) { E(acc, cur, wr, wc, fr, fq); S.done(cur); }
        if (!has_next) break;
#pragma unroll
        for (int a = 0; a < 2; ++a)
#pragma unroll
            for (int b = 0; b < 2; ++b)
#pragma unroll
                for (int m = 0; m < 4; ++m)
#pragma unroll
                    for (int n = 0; n < 2; ++n) acc[a][b][m][n] = (acc_t){};
        cur = nxt; cA = nA; cB = nB; ++ui;
        if constexpr (ALIGN_EPI) { if (wr == 1) PG8_BAR; }
    }
    PG8_WAIT_V(0);
    if constexpr (!ALIGN_EPI) { if (wr == 0) PG8_BAR; }
    PG8_BAR;
    if constexpr (Epi::AFTER_DRAIN) { E.fused(acc, cur, wr, wc, fr, fq, lds, wid, lane); S.done(cur); }
#undef PG8_SA
#undef PG8_SB
#undef PG8_STAGE
#undef PG8_LDA
#undef PG8_LDB
#undef PG8_MMA
#undef PG8_WAIT_V
#undef PG8_WAIT_L
#undef PG8_BAR
#undef PG8_SCHED
}
}
constexpr int NWAVES = 8;
constexpr int DM = 1024, MTOK = 32768, MPAD = pg8::MP_ROWS, NIN = 2304, DFF = 2816, NGU = 2 * DFF;
constexpr float LOG2E = 1.4426950408889634f;
constexpr float EPS = 1e-6f;
constexpr size_t MiB = 1u << 20;
constexpr size_t WS_CTL = 0, CTL_ZERO_BYTES = 65536;
constexpr size_t WS_SMA = 1 * MiB, WS_SMB = WS_SMA + 131072;
constexpr size_t WS_SWO = 9 * MiB + 524288 - 4096;
constexpr size_t WS_WOQ = 404 * MiB;
constexpr size_t WS_WDN = 3 * MiB;
constexpr size_t WS_R1 = 9 * MiB;
constexpr size_t WS_SX = WS_R1 + 262144, WS_SW = WS_R1 + 524288;
constexpr size_t WS_MIX = 10 * MiB;
constexpr size_t WS_X1Q = WS_MIX;
constexpr size_t WS_QKV = 74 * MiB;
constexpr size_t SZ_Q = (size_t)MPAD * 512 * 2, SZ_KB = (size_t)MPAD * 128 * 2;
constexpr size_t WS_QA = WS_QKV, WS_KA = WS_QA + SZ_Q, WS_VAT = WS_KA + SZ_Q, WS_QB = WS_VAT + SZ_Q, WS_KB = WS_QB + SZ_Q, WS_VBT = WS_KB + SZ_KB, WS_QKV_END = WS_VBT + SZ_KB;
constexpr size_t WS_H = 74 * MiB;
constexpr size_t WS_X1B = 250 * MiB;
constexpr size_t WS_XN = 314 * MiB;
constexpr size_t WS_WGQ = 405 * MiB;
constexpr size_t WS_WGU = 385 * MiB;
constexpr size_t WS_WIN = 396 * MiB;
constexpr size_t WS_WOUT = 383 * MiB;
constexpr size_t WS_END = 411 * MiB;
static_assert(WS_SMB + 131072 <= WS_WDN && WS_WDN + (size_t)DM * DFF * 2 <= WS_R1 && WS_R1 + (size_t)MPAD * 4 <= WS_SX && WS_SX + (size_t)MTOK * 4 <= WS_SWO && WS_SWO + 4096 == WS_SW && WS_SW + (size_t)NGU * 4 <= WS_MIX
              && WS_MIX + (size_t)MTOK * DM <= WS_QKV && WS_QKV_END <= WS_X1B && WS_H + (size_t)MTOK * DFF * 2 <= WS_X1B && WS_X1B + (size_t)MTOK * DM * 2 <= WS_XN
              && WS_XN + (size_t)MPAD * DM * 2 <= WS_WOUT && WS_WOUT + (size_t)DM * DM * 2 == WS_WGU && WS_WGU + (size_t)NGU * DM * 2 <= WS_WIN && WS_WIN + (size_t)NIN * DM * 2 <= WS_WOQ && WS_WOQ + (size_t)DM * DM == WS_WGQ
              && WS_WGQ + (size_t)NGU * DM <= WS_END, "d_ws map");
constexpr int CW_TMO = 0, CW_CODE = 1, CW_BAR = 4096;
constexpr int RING_OFF = 0, RING_BYTES = 131072;
constexpr int LDSCTL_OFF = 162816, MISC_OFF = LDSCTL_OFF + 320;
constexpr int LDS_BYTES = 163840;
#define GAS __attribute__((address_space(1)))
#define LAS __attribute__((address_space(3)))
typedef unsigned short bf16;
typedef unsigned v4u __attribute__((ext_vector_type(4)));
typedef float f32x4 __attribute__((ext_vector_type(4)));
typedef short bf16x8 __attribute__((ext_vector_type(8)));
typedef GAS unsigned gu32;
typedef GAS unsigned long long gu64;
#define RLX_AGENT __ATOMIC_RELAXED, __HIP_MEMORY_SCOPE_AGENT
#define LDS_WAIT() asm volatile("s_waitcnt lgkmcnt(0)" ::: "memory")
#define VM_WAIT() asm volatile("s_waitcnt vmcnt(0)" ::: "memory")
__device__ __forceinline__ unsigned long long rt() { return __builtin_amdgcn_s_memrealtime(); }
__device__ __forceinline__ unsigned f2bf(float f) { unsigned u = __builtin_bit_cast(unsigned, f); return (u + 0x7fffu + ((u >> 16) & 1u)) >> 16; }
__device__ __forceinline__ unsigned pk2(float lo, float hi) { return f2bf(lo) | (f2bf(hi) << 16); }

#define XB_TMO      128
#define XB_XCNT(j)  (256  + 64 * (j))
#define XB_XSUB(j)  (1280 + 64 * (j))
#define XB_XGEN(j)  (2304 + 64 * (j))
#define XB_TOP      3328
#define XB_TOPGEN   3392
#define XB_LSUB(j)  (3456 + 64 * (j))
#define XCD_BAR_WORDS 4480
#define XB_SPIN_CAP (1u << 18)

__device__ __forceinline__ unsigned xb_ld(unsigned* p)              { return __hip_atomic_load(p, __ATOMIC_RELAXED, __HIP_MEMORY_SCOPE_AGENT); }
__device__ __forceinline__ unsigned xb_add(unsigned* p, unsigned v) { return __hip_atomic_fetch_add(p, v, __ATOMIC_RELAXED, __HIP_MEMORY_SCOPE_AGENT); }
__device__ __forceinline__ unsigned xb_xcc_id() { return (unsigned)__builtin_amdgcn_s_getreg((3 << 11) | 20) & 0xFu; }
#define XB_SPIN(cond, bar) do { unsigned _sp = 0; while (cond) { __builtin_amdgcn_s_sleep(1); \
    if ((++_sp & 255u) == 0u) { if (xb_ld(&(bar)[XB_TMO])) break; if (_sp > XB_SPIN_CAP) { atomicAdd(&(bar)[XB_TMO], 1u); break; } } } } while (0)

struct XcdBarrier {
    unsigned* bar; unsigned x;
    volatile LAS unsigned* st;
};

__device__ __forceinline__ XcdBarrier xcd_barrier_post(unsigned* bar, volatile LAS unsigned* st) {
    XcdBarrier b; b.bar = bar; b.x = xb_xcc_id(); b.st = st;
    if (threadIdx.x == 0) st[3] = xb_add(&bar[XB_XCNT(b.x)], 1u);
    return b;
}
__device__ __forceinline__ void xcd_barrier_complete(unsigned* bar, unsigned x, unsigned& nloc, unsigned& nx, unsigned& xi) {
    const unsigned G = gridDim.x * gridDim.y * gridDim.z;
    unsigned sum, cnt, mine, below, sp = 0u;
    for (;;) {
        sum = 0u; cnt = 0u; mine = 0u; below = 0u;
#pragma unroll
        for (unsigned j = 0; j < 16; ++j) { const unsigned c = xb_ld(&bar[XB_XCNT(j)]); sum += c; cnt += (c > 0u) ? 1u : 0u; mine = (j == x) ? c : mine; below += (j < x && c > 0u) ? 1u : 0u; }
        if (sum == G) break;
        __builtin_amdgcn_s_sleep(1);
        if ((++sp & 255u) == 0u) { if (xb_ld(&bar[XB_TMO])) break; if (sp > XB_SPIN_CAP) { atomicAdd(&bar[XB_TMO], 1u); break; } }
    }
    nloc = mine > 0u ? mine : 1u; nx = cnt > 0u ? cnt : 1u; xi = below < nx ? below : nx - 1u;
}

__device__ __forceinline__ void xcd_barrier(const XcdBarrier& b) {
    asm volatile("s_waitcnt vmcnt(0)" ::: "memory");
    __syncthreads();
    if (threadIdx.x == 0) {
        unsigned* bar = b.bar;
        __builtin_amdgcn_s_waitcnt(0);
        unsigned nloc = b.st[0], nx = b.st[1];
        if (nloc == 0u) { unsigned xi; xcd_barrier_complete(bar, b.x, nloc, nx, xi); b.st[0] = nloc; b.st[1] = nx; b.st[2] = xi; }
        const unsigned old = xb_add(&bar[XB_XSUB(b.x)], 1u);
        const unsigned gen = old / nloc;
        if (old + 1u == (gen + 1u) * nloc) {
            __builtin_amdgcn_fence(__ATOMIC_RELEASE, "agent");
            asm volatile("s_waitcnt vmcnt(0)" ::: "memory");
            const unsigned og = xb_add(&bar[XB_TOP], 1u);
            const unsigned tg = og / nx;
            if (og + 1u == (tg + 1u) * nx) xb_add(&bar[XB_TOPGEN], 1u);
            else XB_SPIN(xb_ld(&bar[XB_TOPGEN]) == tg, bar);
            __builtin_amdgcn_fence(__ATOMIC_ACQUIRE, "agent");
            xb_add(&bar[XB_XGEN(b.x)], 1u);
            asm volatile("s_waitcnt vmcnt(0)" ::: "memory");
        } else {
            XB_SPIN(xb_ld(&bar[XB_XGEN(b.x)]) == gen, bar);
            __builtin_amdgcn_fence(__ATOMIC_ACQUIRE, "agent");
            asm volatile("s_waitcnt vmcnt(0)" ::: "memory");
        }
    }
    __syncthreads();
}

struct XcdEnv { int nloc, nx, xi, rank; };
__device__ __forceinline__ XcdEnv xcd_env(const XcdBarrier& b) {
    if (threadIdx.x == 0 && b.st[0] == 0u) { unsigned nloc, nx, xi; xcd_barrier_complete(b.bar, b.x, nloc, nx, xi); b.st[1] = nx; b.st[2] = xi; b.st[0] = nloc; }
    __syncthreads();
    XcdEnv e; e.nloc = __builtin_amdgcn_readfirstlane((int)b.st[0]); e.nx = __builtin_amdgcn_readfirstlane((int)b.st[1]); e.xi = __builtin_amdgcn_readfirstlane((int)b.st[2]); e.rank = __builtin_amdgcn_readfirstlane((int)b.st[3]);
    return e;
}
__device__ __forceinline__ void xcd_local_barrier(const XcdBarrier& b) {
    asm volatile("s_waitcnt vmcnt(0)" ::: "memory");
    __syncthreads();
    if (threadIdx.x == 0) {
        unsigned* bar = b.bar;
        __builtin_amdgcn_s_waitcnt(0);
        unsigned nloc = b.st[0];
        if (nloc == 0u) { unsigned nx, xi; xcd_barrier_complete(bar, b.x, nloc, nx, xi); b.st[1] = nx; b.st[2] = xi; b.st[0] = nloc; }
        const unsigned old = xb_add(&bar[XB_LSUB(b.x)], 1u);
        const unsigned target = (old / nloc + 1u) * nloc;
        XB_SPIN(xb_ld(&bar[XB_LSUB(b.x)]) < target, bar);
        __builtin_amdgcn_fence(__ATOMIC_ACQUIRE, "agent");
        asm volatile("s_waitcnt vmcnt(0)" ::: "memory");
    }
    __syncthreads();
}

static_assert((CW_BAR + 2 * XCD_BAR_WORDS) * 4 <= (int)CTL_ZERO_BYTES, "barrier words inside the memset region");
typedef float f32x16 __attribute__((ext_vector_type(16)));
typedef short s16x4 __attribute__((ext_vector_type(4)));
typedef unsigned u32x2 __attribute__((ext_vector_type(2)));
typedef unsigned u32x4 __attribute__((ext_vector_type(4)));
struct Frame {
    LAS unsigned char* lds;
    volatile LAS unsigned* MISC;
    gu32* ctl;
    int wave;
    int vcu, G;
};
__device__ __forceinline__ int fresh_lane() { int t = threadIdx.x; asm volatile("" : "+v"(t)); return t & 63; }
__device__ __forceinline__ float wave_sum(float v) {
#pragma unroll
    for (int o = 1; o < 64; o <<= 1) v += __shfl_xor(v, o);
    return v;
}
__device__ __forceinline__ unsigned q8x4(float a, float b, float c, float d, float qs) {
    const unsigned ua = __float_as_uint(__builtin_fmaf(a, qs, 12582912.0f)), ub = __float_as_uint(__builtin_fmaf(b, qs, 12582912.0f));
    const unsigned uc = __float_as_uint(__builtin_fmaf(c, qs, 12582912.0f)), ud = __float_as_uint(__builtin_fmaf(d, qs, 12582912.0f));
    const unsigned lo = __builtin_amdgcn_perm(ub, ua, 0x0c0c0400u), hi = __builtin_amdgcn_perm(ud, uc, 0x04000c0cu);
    return lo | hi;
}
constexpr int NBT_LD = 1028;
__device__ __forceinline__ void p0_nblock_task(const float* W, int N, int n0, const float* g, signed char* dstq, float* scl, int drow0, LAS float* T, int wave, int lane) {
    const int kq = lane >> 3, c4 = lane & 7;
#pragma unroll
    for (int kb2 = 0; kb2 < 2; ++kb2) { const int k0 = 64 * (2 * wave + kb2);
        f32x4 v[8];
#pragma unroll
        for (int i = 0; i < 8; ++i) v[i] = __builtin_nontemporal_load((const GAS f32x4*)(W + (size_t)(k0 + 8 * i + kq) * N + n0 + 4 * c4));
        if (g) {
#pragma unroll
            for (int i = 0; i < 8; ++i) v[i] = v[i] * g[k0 + 8 * i + kq]; }
#pragma unroll
        for (int i = 0; i < 8; ++i) { LAS float* d = T + (4 * c4) * NBT_LD + k0 + 8 * i + kq; d[0] = v[i].x; d[NBT_LD] = v[i].y; d[2 * NBT_LD] = v[i].z; d[3 * NBT_LD] = v[i].w; } }
    LDS_WAIT(); __syncthreads();
#pragma unroll
    for (int c = 0; c < 4; ++c) { const int ch = 4 * wave + c; const LAS f32x4* rp = (const LAS f32x4*)(T + ch * NBT_LD + 16 * lane);
        const f32x4 a = rp[0], b = rp[1], cc = rp[2], d = rp[3];
        float am = fmaxf(fmaxf(fmaxf(fabsf(a[0]), fabsf(a[1])), fmaxf(fabsf(a[2]), fabsf(a[3]))), fmaxf(fmaxf(fabsf(b[0]), fabsf(b[1])), fmaxf(fabsf(b[2]), fabsf(b[3]))));
        am = fmaxf(am, fmaxf(fmaxf(fmaxf(fabsf(cc[0]), fabsf(cc[1])), fmaxf(fabsf(cc[2]), fabsf(cc[3]))), fmaxf(fmaxf(fabsf(d[0]), fabsf(d[1])), fmaxf(fabsf(d[2]), fabsf(d[3])))));
#pragma unroll
        for (int o = 1; o < 64; o <<= 1) am = fmaxf(am, __shfl_xor(am, o));
        const float qs = am > 0.f ? 127.0f / am : 0.f;
        v4u q; q.x = q8x4(a[0], a[1], a[2], a[3], qs); q.y = q8x4(b[0], b[1], b[2], b[3], qs); q.z = q8x4(cc[0], cc[1], cc[2], cc[3], qs); q.w = q8x4(d[0], d[1], d[2], d[3], qs);
        *(GAS v4u*)(dstq + (size_t)(drow0 + ch) * DM + 16 * lane) = q;
        if (lane == 0) scl[drow0 + ch] = am > 0.f ? am * (1.0f / 127.0f) : 1.0f; }
    LDS_WAIT(); __syncthreads();
}
constexpr int P0_NTASKS = DM / 32 + 2 * (DFF / 32);
__device__ __forceinline__ void p0_weight_tasks(Frame& F, const float* w_out, const float* g2, const float* w_gate, const float* w_up, signed char* WOQ, float* SWO, signed char* WGQ, float* SW, int wg, int nwg) {
    LAS float* T = (LAS float*)(F.lds + RING_OFF);
    __syncthreads();
    for (int t = wg; t < P0_NTASKS; t += nwg) {
        if (t < DM / 32) { p0_nblock_task(w_out, DM, 32 * t, nullptr, WOQ, SWO, 32 * t, T, F.wave, fresh_lane()); continue; }
        const int r = t - DM / 32; const bool up = r >= DFF / 32; const int n0 = 32 * (up ? r - DFF / 32 : r);
        p0_nblock_task(up ? w_up : w_gate, DFF, n0, g2, WGQ, SW, 256 * (n0 >> 7) + (up ? 128 : 0) + (n0 & 127), T, F.wave, fresh_lane());
    }
}
__device__ __forceinline__ void p0_transpose_item(const float* W, int K, int N, bf16* WT, int k0, int n0, int drow, const float* g, LAS float* scr, int lane, int tiled_rows = 0) {
    f32x4 v[8]; const int kq = lane >> 3, c4 = lane & 7;
#pragma unroll
    for (int i = 0; i < 8; ++i) v[i] = __builtin_nontemporal_load((const GAS f32x4*)(W + (size_t)(k0 + 8 * i + kq) * N + n0 + 4 * c4));
    if (g) {
#pragma unroll
        for (int i = 0; i < 8; ++i) v[i] = v[i] * g[k0 + 8 * i + kq]; }
#pragma unroll
    for (int i = 0; i < 8; ++i) { LAS float* d = scr + (8 * i + kq) * 33 + 4 * c4; d[0] = v[i].x; d[1] = v[i].y; d[2] = v[i].z; d[3] = v[i].w; }
    LDS_WAIT(); asm volatile("" ::: "memory");
    const int c = lane & 7;
#pragma unroll
    for (int j = 0; j < 4; ++j) { const int n = (lane >> 3) + 8 * j; const LAS float* s = scr + (8 * c) * 33 + n;
        v4u o; o.x = pk2(s[0 * 33], s[1 * 33]); o.y = pk2(s[2 * 33], s[3 * 33]); o.z = pk2(s[4 * 33], s[5 * 33]); o.w = pk2(s[6 * 33], s[7 * 33]);
        *(GAS v4u*)(WT + (tiled_rows ? ((size_t)(k0 >> 6) * tiled_rows + drow + n) * 64 + 8 * c : (size_t)(drow + n) * K + k0 + 8 * c)) = o; }
    LDS_WAIT(); asm volatile("" ::: "memory");
}
constexpr int P0_I_IN = (DM / 64) * (NIN / 32), P0_I_DN = (DFF / 64) * (DM / 32), P0_NITEMS = P0_I_IN + P0_I_DN;
__device__ __forceinline__ void p0_weight_items(Frame& F, const float* g1, const float* w_in, const float* w_down, bf16* WIN, bf16* WDN, LAS float* scr, int lo, int hi, int worker, int nworkers) {
    constexpr int I_IN = P0_I_IN;
    for (int it = lo + worker; it < hi; it += nworkers) {
        int r = it;
        if (r < I_IN) { const int nb = r % (NIN / 32), kb = r / (NIN / 32), n0 = 32 * nb, g = n0 >> 6;
            const int drow = 256 * (g >> 2) + 128 * ((n0 & 63) >> 5) + 32 * (g & 3);
            p0_transpose_item(w_in, DM, NIN, WIN, 64 * kb, n0, drow, g1, scr, fresh_lane()); continue; } r -= I_IN;
        { const int nb = r % (DM / 32), kb = r / (DM / 32); p0_transpose_item(w_down, DFF, DM, WDN, 64 * kb, 32 * nb, 32 * nb, nullptr, scr, fresh_lane(), DM); }
    }
}
__device__ __forceinline__ void p0_prologue(Frame& F, const float* xp, const float* xs, const float* meta, const float* g1, const float* w_in, const float* w_out, const float* g2, const float* w_gate, const float* w_up, const float* w_down,
        bf16* WIN, signed char* WOQ, float* SWO, signed char* WGQ, float* SW, bf16* WDN, bf16* XN, float* R1, bool defer) {
    LAS float* scr = (LAS float*)(F.lds + RING_OFF + F.wave * 16384);
    const int lane_ = fresh_lane();
    const int gw = F.vcu * NWAVES + F.wave, NGW = F.G * NWAVES;
    constexpr int I_IN = (DM / 64) * (NIN / 32);
    p0_weight_items(F, g1, w_in, w_down, WIN, WDN, scr, 0, defer ? I_IN : P0_NITEMS, gw, NGW);
    if (!defer) p0_weight_tasks(F, w_out, g2, w_gate, w_up, WOQ, SWO, WGQ, SW, F.vcu, F.G);
    for (int m0 = gw; m0 < MPAD; m0 += 4 * NGW) {
        f32x4 v[4][4];
#pragma unroll
        for (int b = 0; b < 4; ++b) { const int m = m0 + b * NGW;
            if (m < MTOK + 16) { const float* xrow = m < 16384 ? xp + (size_t)m * DM : (m < MTOK ? xs + (size_t)(m - 16384) * DM : meta + (size_t)(m - MTOK) * DM);
                const GAS f32x4* xr = (const GAS f32x4*)xrow + lane_;
#pragma unroll
                for (int j = 0; j < 4; ++j) v[b][j] = __builtin_nontemporal_load(xr + 64 * j); }
            else {
#pragma unroll
                for (int j = 0; j < 4; ++j) v[b][j] = (f32x4){0.f, 0.f, 0.f, 0.f}; } }
#pragma unroll
        for (int b = 0; b < 4; ++b) { const int m = m0 + b * NGW; if (m >= MPAD) continue;
            float sq = 0.f;
#pragma unroll
            for (int j = 0; j < 4; ++j) sq += (v[b][j].x * v[b][j].x + v[b][j].y * v[b][j].y) + (v[b][j].z * v[b][j].z + v[b][j].w * v[b][j].w);
            const float rstd = __builtin_amdgcn_rsqf(wave_sum(sq) * (1.f / DM) + EPS);
            if (lane_ == 0) R1[m] = rstd;
            GAS unsigned long long* o8 = (GAS unsigned long long*)(XN + (size_t)m * DM) + lane_;
#pragma unroll
            for (int j = 0; j < 4; ++j) { const f32x4 y = v[b][j];
                o8[64 * j] = (unsigned long long)pk2(y.x, y.y) | ((unsigned long long)pk2(y.z, y.w) << 32); } }
    }
}
__device__ __forceinline__ unsigned cvtpk(float lo, float hi) { return pg8::cvt_pk_bf16(lo, hi); }
__device__ __forceinline__ void attn_load_kv(bf16x8 (&kf)[4], bf16x8 (&vf)[2][2], const bf16* krow, const bf16* vcol) {
#pragma unroll
    for (int s = 0; s < 4; ++s) kf[s] = *(const bf16x8*)(krow + 16 * s);
#pragma unroll
    for (int db = 0; db < 2; ++db)
#pragma unroll
        for (int s = 0; s < 2; ++s) { const bf16* p = vcol + (size_t)(32 * db) * MPAD + 16 * s;
            const s16x4 lo = *(const s16x4*)p, hi = *(const s16x4*)(p + 8);
            vf[db][s] = (bf16x8){lo[0], lo[1], lo[2], lo[3], hi[0], hi[1], hi[2], hi[3]}; }
}
__device__ __forceinline__ void attn_load_k(bf16x8 (&kf)[4], const bf16* kt) {
#pragma unroll
    for (int s = 0; s < 4; ++s) kf[s] = *(const bf16x8*)(kt + 512 * s);
}
__device__ __forceinline__ void attn_load_v(bf16x8 (&vf)[2][2], const bf16* vt) {
#pragma unroll
    for (int db = 0; db < 2; ++db)
#pragma unroll
        for (int s = 0; s < 2; ++s) vf[db][s] = *(const bf16x8*)(vt + 512 * (2 * db + s));
}
__device__ __forceinline__ f32x16 attn_qk(const bf16x8 (&kf)[4], const LAS bf16x8* qf, f32x16 S = (f32x16){}) {
#pragma unroll
    for (int s = 0; s < 4; ++s) S = __builtin_amdgcn_mfma_f32_32x32x16_bf16(kf[s], qf[64 * s], S, 0, 0, 0);
    return S;
}
__device__ __forceinline__ void attn_pv_half(f32x16 (&O)[2], const float (&p)[8], const bf16x8 (&vf)[2][2], int s) {
    u32x4 pw; pw.x = cvtpk(p[0], p[1]); pw.y = cvtpk(p[2], p[3]); pw.z = cvtpk(p[4], p[5]); pw.w = cvtpk(p[6], p[7]);
    const bf16x8 pb = __builtin_bit_cast(bf16x8, pw);
#pragma unroll
    for (int db = 0; db < 2; ++db) O[db] = __builtin_amdgcn_mfma_f32_32x32x16_bf16(vf[db][s], pb, O[db], 0, 0, 0);
}
__device__ __forceinline__ f32x16 attn_tab16(const LAS float* tab4, int cstride, int I) {
    const int a = I & 3; const LAS f32x4* p = (const LAS f32x4*)(tab4 + a * cstride + (I - a));
    const f32x4 v0 = p[0], v1 = p[2], v2 = p[4], v3 = p[6];
    return (f32x16){v0[0], v0[1], v0[2], v0[3], v1[0], v1[1], v1[2], v1[3], v2[0], v2[1], v2[2], v2[3], v3[0], v3[1], v3[2], v3[3]};
}
constexpr int TA_CS = 608, TB_CS = 324, TM_CS = 132;
template <bool ISB, int CB>
__device__ __forceinline__ void attn_win_tile(f32x16 (&O)[2][2], float (&l)[2], const bf16x8 (&kf)[4], const bf16x8 (&vf)[2][2], const LAS bf16x8* qf,
                                              const LAS float* tabAB, const LAS float* tabM, int wt, int rowoff, int jlo, int q, int h) {
#pragma unroll
    for (int qb = 0; qb < 2; ++qb) {
        if (ISB) { const int j = jlo + wt; if ((qb == 0 && j == 9) || (qb == 1 && j == 0)) continue; }
        constexpr int cb = CB;
        f32x16 C, Bv = (f32x16){};
        if (!ISB) {
            const int c = 32 * qb + q; int cs = c - 8; cs = cs < 0 ? 0 : (cs > 48 ? 48 : cs);
            const int kcb = 32 * cb + 4 * h;
            C = attn_tab16(tabM, TM_CS, 63 + kcb - cs);
            Bv = attn_tab16(tabAB, TA_CS, rowoff + 63 + kcb - c);
        } else {
            C = attn_tab16(tabAB, TB_CS, 32 * (jlo + wt) - 128 - 32 * qb - q + 4 * h + 160);
        }
        const f32x16 S = attn_qk(kf, qf + 256 * qb, C);
        float ls0 = 0.f, ls1 = 0.f;
#pragma unroll
        for (int s2 = 0; s2 < 2; ++s2) {
            if (!ISB && qb != cb && s2 == cb) continue;
            float p[8];
#pragma unroll
            for (int j = 0; j < 8; ++j) { const int rg = 8 * s2 + j;
                float x = S[rg]; if (!ISB) x += Bv[rg];
                p[j] = __builtin_amdgcn_exp2f(x); }
            ls0 += (p[0] + p[1]) + (p[2] + p[3]); ls1 += (p[4] + p[5]) + (p[6] + p[7]);
            attn_pv_half(O[qb], p, vf, s2);
        }
        l[qb] += ls0 + ls1;
        __builtin_amdgcn_sched_barrier(0);
    }
}
struct AttnPtrs { const bf16 *QA, *KA, *VAT, *QB, *KB, *VBT; unsigned char* MIX; float *SMA, *SMB; const float *ona, *onb; };
template <bool ISB>
__device__ __forceinline__ void attn_unit(Frame& F, const AttnPtrs& T, int t0, const LAS float* tabAB, const LAS float* tabM, float sinkexp, LAS float* ssx, LAS bf16x8* qlds) {
    const int lane = fresh_lane(), w = F.wave, q = lane & 31, h = lane >> 5;
    int sb, N; if (t0 < 16384) { sb = t0 & ~8191; N = 8192; } else { sb = 16384 + ((t0 - 16384) & ~4095); N = 4096; }
    const int q0 = t0 - sb;
    constexpr int NT = MPAD / 32;
    const bf16* Qp = (ISB ? T.QB : T.QA) + ((size_t)w * NT + (t0 >> 5)) * 2048 + lane * 8;
    const int khead = ISB ? (w >> 2) : w;
    const bf16* Kp = (ISB ? T.KB : T.KA) + (size_t)khead * NT * 2048 + lane * 8;
    const bf16* Vp = (ISB ? T.VBT : T.VAT) + (size_t)khead * NT * 2048 + lane * 8;
    int nw, jlo = 0, tbase0, rs = 0, rq = 0;
    if (!ISB) { const int rows = N >> 6; rq = q0 >> 6; rs = rq - 4; rs = rs < 0 ? 0 : (rs > rows - 8 ? rows - 8 : rs); nw = 16; tbase0 = sb + 64 * rs; }
    else { jlo = q0 >= 128 ? 0 : (128 - q0) >> 5; int jhi = (N - q0 + 128) >> 5; jhi = jhi > 10 ? 10 : jhi; nw = jhi - jlo; tbase0 = sb + q0 - 128 + 32 * jlo; }
#define ATT_KROW(wt_) (rs + ((((wt_) >> 1) - rs) & 7))
#define ATT_TB(wt_) (ISB ? tbase0 + 32 * (wt_) : sb + 64 * ATT_KROW(wt_) + 32 * ((wt_) & 1))
    bf16x8 kfX[4], kfY[4], vfX[2][2], vfY[2][2];
    attn_load_k(kfX, Kp + (size_t)(MTOK >> 5) * 2048); attn_load_v(vfX, Vp + (size_t)(MTOK >> 5) * 2048);
    { const int tb = ATT_TB(0); attn_load_k(kfY, Kp + (size_t)(tb >> 5) * 2048); attn_load_v(vfY, Vp + (size_t)(tb >> 5) * 2048); }
    LAS bf16x8* qf = qlds + lane;
#pragma unroll
    for (int qb = 0; qb < 2; ++qb)
#pragma unroll
        for (int s = 0; s < 4; ++s) qf[256 * qb + 64 * s] = __builtin_nontemporal_load((const bf16x8*)(Qp + 2048 * qb + 512 * s));
    f32x16 O[2][2]; float l[2] = {0.f, 0.f};
#pragma unroll
    for (int qb = 0; qb < 2; ++qb)
#pragma unroll
        for (int db = 0; db < 2; ++db) O[qb][db] = (f32x16){};
#pragma unroll
    for (int qb = 0; qb < 2; ++qb) {
        const f32x16 S = attn_qk(kfX, qf + 256 * qb); float ls = 0.f;
        const int ib = 144 - q0 - 32 * qb - q + 4 * h;
        float p[8];
#pragma unroll
        for (int r = 0; r < 8; ++r) { float b = 0.f; if (ISB) { int idx = ib + (r & 3) + 8 * (r >> 2); idx = idx < 32 ? 32 : idx; b = tabAB[idx]; }
            p[r] = __builtin_amdgcn_exp2f(S[r] + b); ls += p[r]; }
        l[qb] += ls; attn_pv_half(O[qb], p, vfX, 0);
        __builtin_amdgcn_sched_barrier(0);
    }
#pragma unroll 1
    for (int wt = 0; wt < nw; wt += 2) {
        { const int tb = ATT_TB(wt + 1); attn_load_k(kfX, Kp + (size_t)(tb >> 5) * 2048); attn_load_v(vfX, Vp + (size_t)(tb >> 5) * 2048); }
        attn_win_tile<ISB, 0>(O, l, kfY, vfY, qf, tabAB, tabM, wt, ISB ? 0 : (ATT_KROW(wt) - rq + 7) * 32, jlo, q, h);
        { const int wn = wt + 2 < nw ? wt + 2 : wt; const int tb = ATT_TB(wn); attn_load_k(kfY, Kp + (size_t)(tb >> 5) * 2048); attn_load_v(vfY, Vp + (size_t)(tb >> 5) * 2048); }
        attn_win_tile<ISB, 1>(O, l, kfX, vfX, qf, tabAB, tabM, wt + 1, ISB ? 0 : (ATT_KROW(wt + 1) - rq + 7) * 32, jlo, q, h);
    }
#undef ATT_KROW
#undef ATT_TB
    f32x4 gvv[2][4];
    { const float* gain = (ISB ? T.onb : T.ona) + w * 64 + 4 * h;
#pragma unroll
      for (int db = 0; db < 2; ++db)
#pragma unroll
          for (int g = 0; g < 4; ++g) gvv[db][g] = *(const f32x4*)(gain + 32 * db + 8 * g); }
    float inv[2];
    LAS float* amx = ssx + 16896;
#pragma unroll
    for (int qb = 0; qb < 2; ++qb) { float lt = l[qb] + __shfl_xor(l[qb], 32); if (ISB) lt += sinkexp; inv[qb] = __builtin_amdgcn_rcpf(lt);
        float ss = 0.f, am = 0.f;
#pragma unroll
        for (int db = 0; db < 2; ++db)
#pragma unroll
            for (int rg = 0; rg < 16; ++rg) { const float o = O[qb][db][rg] * inv[qb]; ss += o * o; const float og = o * gvv[db][rg >> 2][rg & 3]; O[qb][db][rg] = og; am = fmaxf(am, fabsf(og)); }
        ss += __shfl_xor(ss, 32); am = fmaxf(am, __shfl_xor(am, 32));
        if (h == 0) { ssx[(32 * qb + q) * 8 + w] = ss; amx[(32 * qb + q) * 8 + w] = am; } }
    LDS_WAIT(); __syncthreads();
    unsigned char* Mp = T.MIX + (size_t)(t0 + q) * DM + (ISB ? 512 : 0) + w * 64 + 8 * h;
#pragma unroll
    for (int qb = 0; qb < 2; ++qb) {
        const f32x4 s0 = *(const LAS f32x4*)(ssx + (32 * qb + q) * 8), s1 = *(const LAS f32x4*)(ssx + (32 * qb + q) * 8 + 4);
        const f32x4 a0 = *(const LAS f32x4*)(amx + (32 * qb + q) * 8), a1 = *(const LAS f32x4*)(amx + (32 * qb + q) * 8 + 4);
        const float tot = ((s0[0] + s0[1]) + (s0[2] + s0[3])) + ((s1[0] + s1[1]) + (s1[2] + s1[3]));
        const float amax = fmaxf(fmaxf(fmaxf(a0[0], a0[1]), fmaxf(a0[2], a0[3])), fmaxf(fmaxf(a1[0], a1[1]), fmaxf(a1[2], a1[3])));
        const float rn = __builtin_amdgcn_rsqf(tot * (1.0f / 512.0f) + EPS);
        const float qs = amax > 0.f ? 127.0f / amax : 0.f;
        if (w == 0 && h == 0) (ISB ? T.SMB : T.SMA)[t0 + 32 * qb + q] = amax > 0.f ? amax * rn * (1.0f / 127.0f) : 1.0f;
#pragma unroll
        for (int db = 0; db < 2; ++db)
#pragma unroll
            for (int gp = 0; gp < 2; ++gp) {
                const unsigned a = q8x4(O[qb][db][8 * gp + 0], O[qb][db][8 * gp + 1], O[qb][db][8 * gp + 2], O[qb][db][8 * gp + 3], qs), b = q8x4(O[qb][db][8 * gp + 4], O[qb][db][8 * gp + 5], O[qb][db][8 * gp + 6], O[qb][db][8 * gp + 7], qs);
                const u32x2 r = __builtin_amdgcn_permlane32_swap(a, b, false, false);
                *(u32x2*)(Mp + (size_t)(32 * qb) * DM + 32 * db + 16 * gp) = r; }
    }
    LDS_WAIT(); __syncthreads();
}
__device__ __forceinline__ f32x16 attn_qk_r(const bf16x8 (&kf)[4], const bf16x8 (&qf)[4], f32x16 S) {
#pragma unroll
    for (int s = 0; s < 4; ++s) S = __builtin_amdgcn_mfma_f32_32x32x16_bf16(kf[s], qf[s], S, 0, 0, 0);
    return S;
}
template <int I> struct AWin { static constexpr int W0 = I == 0 ? 0 : (I == 1 ? 8 : (I == 2 ? 24 : 32)); };
__device__ __forceinline__ void attn_a_load_k(bf16x8 (&kf)[4], const bf16* kp) {
#pragma unroll
    for (int s = 0; s < 4; ++s) kf[s] = *(const bf16x8*)(kp + 512 * s);
}
template <int I>
__device__ __forceinline__ void attn_a_load_v(bf16x8 (&vf)[2][2], const bf16* vp) {
    constexpr int W0 = AWin<I>::W0;
#pragma unroll
    for (int db = 0; db < 2; ++db)
#pragma unroll
        for (int s = 0; s < 2; ++s) {
            constexpr int dummy = 0; (void)dummy;
            const int c0 = W0 + 16 * s, c1 = W0 + 16 * s + 8;
            const s16x4 lo = *(const s16x4*)(vp + (c0 >> 5) * 2048 + (2 * db + ((c0 & 31) >> 4)) * 512 + (((c0 & 31) >> 3) & 1) * 4);
            const s16x4 hi = *(const s16x4*)(vp + (c1 >> 5) * 2048 + (2 * db + ((c1 & 31) >> 4)) * 512 + (((c1 & 31) >> 3) & 1) * 4);
            vf[db][s] = (bf16x8){lo[0], lo[1], lo[2], lo[3], hi[0], hi[1], hi[2], hi[3]}; }
}
__device__ __forceinline__ void attn_a_step(f32x16 (&O)[2], float& l, const bf16x8 (&kf)[4], const bf16x8 (&vf)[2][2], const bf16x8 (&qf)[4], const f32x16& C, const f32x16& Bv) {
    const f32x16 S = attn_qk_r(kf, qf, C);
    float ls0 = 0.f, ls1 = 0.f;
#pragma unroll
    for (int s2 = 0; s2 < 2; ++s2) {
        float p[8];
#pragma unroll
        for (int j = 0; j < 8; ++j) p[j] = __builtin_amdgcn_exp2f(S[8 * s2 + j] + Bv[8 * s2 + j]);
        ls0 += (p[0] + p[1]) + (p[2] + p[3]); ls1 += (p[4] + p[5]) + (p[6] + p[7]);
        attn_pv_half(O, p, vf, s2);
    }
    l += ls0 + ls1;
    __builtin_amdgcn_sched_barrier(0);
}
template <int I>
__device__ __forceinline__ void attn_a_block(Frame& F, const AttnPtrs& T, int t0, int sb, int r0, int rows, const LAS float* tabA4, const LAS float* tabM4, LAS float* ssx) {
    constexpr int W0 = AWin<I>::W0; constexpr int NT = MPAD / 32;
    const int lane = fresh_lane(), w = F.wave, n = lane & 31, h = lane >> 5;
    const int qrow = r0 + (n >> 4), qcol = 16 * I + (n & 15), tq = 64 * (n >> 4) + qcol;
    int rsq = qrow - 4; rsq = rsq < 0 ? 0 : (rsq > rows - 8 ? rows - 8 : rsq);
    int rs0 = r0 - 4; rs0 = rs0 < 0 ? 0 : (rs0 > rows - 8 ? rows - 8 : rs0);
    int rs1 = r0 - 3; rs1 = rs1 < 0 ? 0 : (rs1 > rows - 8 ? rows - 8 : rs1);
    const int nk = rs1 + 8 - rs0;
    int cs = qcol - 8; cs = cs < 0 ? 0 : (cs > 48 ? 48 : cs);
    const int imv = 63 + W0 + 4 * h - cs;
    const int ibb = 63 + W0 + 4 * h - qcol - 32 * qrow + 32 * 7;
    const int colk = W0 + n;
    const bf16* Kp = T.KA + (size_t)w * NT * 2048 + (size_t)(colk >> 5) * 2048 + (32 * h + (colk & 31)) * 8;
    const bf16* Vp = T.VAT + (size_t)w * NT * 2048 + (32 * h + n) * 8;
    const bf16* Qp = T.QA + ((size_t)w * NT + ((t0 + tq) >> 5)) * 2048 + (32 * h + ((t0 + tq) & 31)) * 8;
    bf16x8 kfX[4], kfY[4], vfX[2][2], vfY[2][2], qf[4];
    attn_load_k(kfX, T.KA + (size_t)w * NT * 2048 + (size_t)(MTOK >> 5) * 2048 + lane * 8); attn_load_v(vfX, T.VAT + (size_t)w * NT * 2048 + (size_t)(MTOK >> 5) * 2048 + lane * 8);
    { const size_t to = (size_t)((sb + 64 * rs0) >> 5) * 2048; attn_a_load_k(kfY, Kp + to); attn_a_load_v<I>(vfY, Vp + to); }
#pragma unroll
    for (int s = 0; s < 4; ++s) qf[s] = __builtin_nontemporal_load((const bf16x8*)(Qp + 512 * s));
    f32x16 O[2]; O[0] = (f32x16){}; O[1] = (f32x16){}; float l = 0.f;
    f32x16 Cc = attn_tab16(tabM4, TM_CS, ((unsigned)(rs0 - rsq) < 8u) ? imv : 96), Bc = attn_tab16(tabA4, TA_CS, ibb + 32 * rs0);
    { const f32x16 S = attn_qk_r(kfX, qf, (f32x16){}); float p[8], ls = 0.f;
#pragma unroll
      for (int r = 0; r < 8; ++r) { p[r] = __builtin_amdgcn_exp2f(S[r]); ls += p[r]; }
      l += ls; attn_pv_half(O, p, vfX, 0);
      __builtin_amdgcn_sched_barrier(0); }
#pragma unroll 1
    for (int k = 0; k + 1 < nk; k += 2) {
        { const int kr = rs0 + k + 1; const size_t to = (size_t)((sb + 64 * kr) >> 5) * 2048; attn_a_load_k(kfX, Kp + to); attn_a_load_v<I>(vfX, Vp + to); }
        const f32x16 Cn = attn_tab16(tabM4, TM_CS, ((unsigned)(rs0 + k + 1 - rsq) < 8u) ? imv : 96), Bn = attn_tab16(tabA4, TA_CS, ibb + 32 * (rs0 + k + 1));
        attn_a_step(O, l, kfY, vfY, qf, Cc, Bc);
        { const int kn = k + 2 < nk ? k + 2 : nk - 1; const int kr = rs0 + kn; const size_t to = (size_t)((sb + 64 * kr) >> 5) * 2048; attn_a_load_k(kfY, Kp + to); attn_a_load_v<I>(vfY, Vp + to);
          Cc = attn_tab16(tabM4, TM_CS, ((unsigned)(kr - rsq) < 8u) ? imv : 96); Bc = attn_tab16(tabA4, TA_CS, ibb + 32 * kr); }
        attn_a_step(O, l, kfX, vfX, qf, Cn, Bn);
    }
    if (nk & 1) attn_a_step(O, l, kfY, vfY, qf, Cc, Bc);
    f32x4 gvv[2][4];
    { const float* gain = T.ona + w * 64 + 4 * h;
#pragma unroll
      for (int db = 0; db < 2; ++db)
#pragma unroll
          for (int g = 0; g < 4; ++g) gvv[db][g] = *(const f32x4*)(gain + 32 * db + 8 * g); }
    { const float lt = l + __shfl_xor(l, 32); const float inv = __builtin_amdgcn_rcpf(lt);
      float ss = 0.f, am = 0.f;
#pragma unroll
      for (int db = 0; db < 2; ++db)
#pragma unroll
          for (int rg = 0; rg < 16; ++rg) { const float o = O[db][rg] * inv; ss += o * o; const float og = o * gvv[db][rg >> 2][rg & 3]; O[db][rg] = og; am = fmaxf(am, fabsf(og)); }
      ss += __shfl_xor(ss, 32); am = fmaxf(am, __shfl_xor(am, 32));
      if (h == 0) { ssx[n * 8 + w] = ss; (ssx + 16896)[n * 8 + w] = am; } }
    LDS_WAIT(); __syncthreads();
    { unsigned char* Mp = T.MIX + (size_t)(t0 + tq) * DM + w * 64 + 8 * h;
      const LAS float* amx = ssx + 16896;
      const f32x4 s0 = *(const LAS f32x4*)(ssx + n * 8), s1 = *(const LAS f32x4*)(ssx + n * 8 + 4);
      const f32x4 a0 = *(const LAS f32x4*)(amx + n * 8), a1 = *(const LAS f32x4*)(amx + n * 8 + 4);
      const float tot = ((s0[0] + s0[1]) + (s0[2] + s0[3])) + ((s1[0] + s1[1]) + (s1[2] + s1[3]));
      const float amax = fmaxf(fmaxf(fmaxf(a0[0], a0[1]), fmaxf(a0[2], a0[3])), fmaxf(fmaxf(a1[0], a1[1]), fmaxf(a1[2], a1[3])));
      const float rn = __builtin_amdgcn_rsqf(tot * (1.0f / 512.0f) + EPS);
      const float qs = amax > 0.f ? 127.0f / amax : 0.f;
      if (w == 0 && h == 0) T.SMA[t0 + tq] = amax > 0.f ? amax * rn * (1.0f / 127.0f) : 1.0f;
#pragma unroll
      for (int db = 0; db < 2; ++db)
#pragma unroll
          for (int gp = 0; gp < 2; ++gp) {
              const unsigned a = q8x4(O[db][8 * gp + 0], O[db][8 * gp + 1], O[db][8 * gp + 2], O[db][8 * gp + 3], qs), b = q8x4(O[db][8 * gp + 4], O[db][8 * gp + 5], O[db][8 * gp + 6], O[db][8 * gp + 7], qs);
              const u32x2 r = __builtin_amdgcn_permlane32_swap(a, b, false, false);
              *(u32x2*)(Mp + 32 * db + 16 * gp) = r; } }
    LDS_WAIT(); __syncthreads();
}
__device__ __forceinline__ void attn_a_unit(Frame& F, const AttnPtrs& T, int t0, const LAS float* tabA4, const LAS float* tabM4, LAS float* ssx) {
    int sb, N; if (t0 < 16384) { sb = t0 & ~8191; N = 8192; } else { sb = 16384 + ((t0 - 16384) & ~4095); N = 4096; }
    const int r0 = (t0 - sb) >> 6, rows = N >> 6;
    attn_a_block<0>(F, T, t0, sb, r0, rows, tabA4, tabM4, ssx);
    attn_a_block<1>(F, T, t0, sb, r0, rows, tabA4, tabM4, ssx);
    attn_a_block<2>(F, T, t0, sb, r0, rows, tabA4, tabM4, ssx);
    attn_a_block<3>(F, T, t0, sb, r0, rows, tabA4, tabM4, ssx);
}
__device__ __forceinline__ void attn_phase(Frame& F, const AttnPtrs& T, const float* rpb, const float* t5, const float* sink) {
    const int lane = fresh_lane(), w = F.wave;
    LAS float* tabAB = (LAS float*)(F.lds + RING_OFF + w * 10240);
    LAS float* tabM = (LAS float*)(F.lds + RING_OFF + 81920);
    LAS float* ssx = (LAS float*)(F.lds + RING_OFF + 84480);
    LAS bf16x8* qlds = (LAS bf16x8*)(F.lds + RING_OFF + 86528 + w * 8192);
    for (int i = lane; i < 4 * TA_CS; i += 64) tabAB[i] = 0.f;
#pragma unroll
    for (int k = 0; k < 8; ++k) { int i = lane + 64 * k; i = i < 465 ? i : 464; const int dr = i / 31, dc = i - 31 * dr; const float v = rpb[w * 465 + i] * LOG2E; const int pos = 48 + 32 * dr + dc;
#pragma unroll
        for (int a = 0; a < 4; ++a) tabAB[a * TA_CS + pos - a] = v; }
    if (w == 0) for (int i = lane; i < TM_CS; i += 64) { const float v = (i >= 63 && i < 79) ? 0.f : -INFINITY;
#pragma unroll
        for (int a = 0; a < 4; ++a) if (i - a >= 0) tabM[a * TM_CS + i - a] = v; }
    const float sinkexp = __builtin_amdgcn_exp2f(sink[w] * LOG2E);
    LDS_WAIT(); __syncthreads();
#pragma unroll 1
    for (int u = F.vcu; u < 256; u += F.G) attn_a_unit(F, T, u * 128, tabAB, tabM, ssx);
#pragma unroll
    for (int k = 0; k < 6; ++k) { int i = lane + 64 * k; i = i < TB_CS ? i : TB_CS - 1; const int rel = i - 160; int n = rel < 0 ? -rel : rel; const bool ok = n <= 128; n = ok ? n : 128;
        const int lg = n < 8 ? n : (33 - __clz(n * n)); const int bk = (rel > 0 ? 16 : 0) + (lg > 15 ? 15 : lg); float v = t5[bk * 8 + w] * LOG2E; v = ok ? v : -INFINITY;
#pragma unroll
        for (int a = 0; a < 4; ++a) if (i - a >= 0) tabAB[a * TB_CS + i - a] = v; }
    LDS_WAIT(); asm volatile("" ::: "memory");
#pragma unroll 1
    for (int u = F.vcu; u < 512; u += F.G) attn_unit<true>(F, T, u * 64, tabAB, tabM, sinkexp, ssx, qlds);
}
template <bool NORM>
__device__ __forceinline__ void quant_rows(const bf16* src, signed char* dstq, float* scl, int nrows, int worker, int nworkers) {
    const int lane = threadIdx.x & 63;
    for (int m0 = worker; m0 < nrows; m0 += 4 * nworkers) {
        v4u v[4][2];
#pragma unroll
        for (int b = 0; b < 4; ++b) { int m = m0 + b * nworkers; m = m < nrows ? m : nrows - 1; const bf16* sp = src + (size_t)m * DM;
            v[b][0] = *(const GAS v4u*)(sp + lane * 16); v[b][1] = *(const GAS v4u*)(sp + lane * 16 + 8); }
#pragma unroll
        for (int b = 0; b < 4; ++b) { const int m = m0 + b * nworkers; if (m >= nrows) continue;
            float x[16];
#pragma unroll
            for (int k = 0; k < 2; ++k) { const v4u w = v[b][k];
                x[8 * k + 0] = __uint_as_float(w.x << 16); x[8 * k + 1] = __uint_as_float(w.x & 0xffff0000u); x[8 * k + 2] = __uint_as_float(w.y << 16); x[8 * k + 3] = __uint_as_float(w.y & 0xffff0000u);
                x[8 * k + 4] = __uint_as_float(w.z << 16); x[8 * k + 5] = __uint_as_float(w.z & 0xffff0000u); x[8 * k + 6] = __uint_as_float(w.w << 16); x[8 * k + 7] = __uint_as_float(w.w & 0xffff0000u); }
            float am = 0.f, ss = 0.f;
#pragma unroll
            for (int i = 0; i < 16; ++i) { am = fmaxf(am, fabsf(x[i])); ss += x[i] * x[i]; }
#pragma unroll
            for (int o = 1; o < 64; o <<= 1) { am = fmaxf(am, __shfl_xor(am, o)); if (NORM) ss += __shfl_xor(ss, o); }
            const float sc = am > 0.f ? am * (1.0f / 127.0f) : 1.0f, qs = am > 0.f ? 127.0f / am : 0.f;
            v4u q; q.x = q8x4(x[0], x[1], x[2], x[3], qs); q.y = q8x4(x[4], x[5], x[6], x[7], qs); q.z = q8x4(x[8], x[9], x[10], x[11], qs); q.w = q8x4(x[12], x[13], x[14], x[15], qs);
            *(GAS v4u*)(dstq + (size_t)m * DM + lane * 16) = q;
            if (lane == 0) scl[m] = NORM ? sc * __builtin_amdgcn_rsqf(ss * (1.0f / 1024.0f) + EPS) : sc;
        }
    }
}
#ifndef PROBE_PHASE
#define PROBE_PHASE -1
#endif
#ifndef MK_N_LAUNCHES
#define MK_N_LAUNCHES 1
#endif
constexpr int N_LAUNCHES = MK_N_LAUNCHES;
constexpr int PER_PHASE = 7;
struct Args { const float* in[19]; float* out; unsigned char* ws; int ph_lo, ph_hi, li, pad; };
__global__ void __launch_bounds__(NWAVES * 64, 2) hybrid_fwd(Args args_by_value) {
    __shared__ __attribute__((aligned(16))) unsigned char lds[LDS_BYTES];
    typedef const __attribute__((address_space(4))) Args* KArgs;
#define ENV() KArgs ap_ = (KArgs)__builtin_amdgcn_kernarg_segment_ptr(); asm volatile("" : "+s"(ap_)); \
    unsigned char* ws = ap_->ws; unsigned char* dout = (unsigned char*)ap_->out; \
    Frame F; F.lds = (LAS unsigned char*)lds; F.MISC = (volatile LAS unsigned*)(F.lds + MISC_OFF); F.wave = __builtin_amdgcn_readfirstlane((int)threadIdx.x >> 6); \
    F.G = gridDim.x; { const int bx = blockIdx.x; F.vcu = (F.G % 8 == 0) ? (bx % 8) * (F.G / 8) + bx / 8 : bx; } F.ctl = (gu32*)(ws + WS_CTL); \
    XcdBarrier bar; bar.bar = (unsigned*)(F.ctl + CW_BAR) + ap_->li * XCD_BAR_WORDS; bar.x = xb_xcc_id(); bar.st = F.MISC + 8; (void)dout; (void)bar
#define AIN(k) ((const float*)ap_->in[k])
    (void)args_by_value;
    int lo, hi;
    { ENV(); lo = ap_->ph_lo; hi = ap_->ph_hi;
      for (int u = threadIdx.x; u < (LDS_BYTES - LDSCTL_OFF) / 4; u += NWAVES * 64) ((LAS unsigned*)(F.lds + LDSCTL_OFF))[u] = 0u;
      __syncthreads();
      if (N_LAUNCHES != PER_PHASE) (void)xcd_barrier_post((unsigned*)(F.ctl + CW_BAR) + ap_->li * XCD_BAR_WORDS, F.MISC + 8); }
#define GRID_BAR() do { if (N_LAUNCHES != PER_PHASE) xcd_barrier(bar); } while (0)
#define LOCAL_BAR() do { if (N_LAUNCHES != PER_PHASE) xcd_local_barrier(bar); } while (0)
#ifndef PH_MASK
#define PH_MASK 127
#endif
#define IN(k) (((PH_MASK >> (k)) & 1) && lo <= (k) && (k) < hi)
#define BOTH(k) (IN(k) && IN((k) + 1))
#define P1_RAGGED() const int p1_units = (MPAD / 256) * (NIN / 256), p1_last = (p1_units - 1) / (int)gridDim.x, p1_busy = p1_units - p1_last * (int)gridDim.x, p1_idle = (int)gridDim.x - p1_busy; const bool defer_w = p1_idle >= 64
    if (IN(0)) { ENV(); P1_RAGGED(); p0_prologue(F, AIN(0), AIN(1), AIN(2), AIN(4), AIN(5), AIN(14), AIN(15), AIN(16), AIN(17), AIN(18),
            (bf16*)(ws + WS_WIN), (signed char*)(ws + WS_WOQ), (float*)(ws + WS_SWO), (signed char*)(ws + WS_WGQ), (float*)(ws + WS_SW), (bf16*)(ws + WS_WDN), (bf16*)(ws + WS_XN), (float*)(ws + WS_R1), defer_w); if (BOTH(0)) GRID_BAR(); }
    if (IN(1)) { ENV();
        pg8::Gemm g{(bf16*)(ws + WS_XN), (bf16*)(ws + WS_WIN), MPAD, NIN, DM}; pg8::StaticOrder S; S.init(MPAD, NIN, F.G, (int)blockIdx.x);
        pg8::EpiQKV E{ws, (PG8_LAS unsigned char*)(F.lds + RING_OFF + RING_BYTES), AIN(6), AIN(7), AIN(9), AIN(10), WS_QA, WS_KA, WS_VAT, WS_QB, WS_KB, WS_VBT, WS_R1};
        pg8::gemm_phase<pg8::EpiQKV, pg8::StaticOrder, true, true>(F.lds + RING_OFF, g, S, E);
    }
    if (IN(1)) { ENV();
        P1_RAGGED();
        if (defer_w && (int)blockIdx.x >= p1_busy) {
            p0_weight_tasks(F, AIN(14), AIN(15), AIN(16), AIN(17), (signed char*)(ws + WS_WOQ), (float*)(ws + WS_SWO), (signed char*)(ws + WS_WGQ), (float*)(ws + WS_SW), (int)blockIdx.x - p1_busy, p1_idle);
            p0_weight_items(F, AIN(4), AIN(5), AIN(18), (bf16*)(ws + WS_WIN), (bf16*)(ws + WS_WDN),
                            (LAS float*)(F.lds + RING_OFF + F.wave * 16384), P0_I_IN, P0_NITEMS, ((int)blockIdx.x - p1_busy) * NWAVES + F.wave, p1_idle * NWAVES);
        }
        if (BOTH(1)) GRID_BAR();
    }
    if (IN(2)) { ENV(); const AttnPtrs T{(bf16*)(ws + WS_QA), (bf16*)(ws + WS_KA), (bf16*)(ws + WS_VAT), (bf16*)(ws + WS_QB), (bf16*)(ws + WS_KB), (bf16*)(ws + WS_VBT), ws + WS_MIX, (float*)(ws + WS_SMA), (float*)(ws + WS_SMB), AIN(12), AIN(13)};
        attn_phase(F, T, AIN(8), AIN(3), AIN(11)); if (BOTH(2)) GRID_BAR(); }
    if (IN(3)) { ENV(); const XcdEnv xe = xcd_env(bar);
        pg8::Gemm g{(bf16*)(ws + WS_MIX), (bf16*)(ws + WS_WOQ), MTOK, DM, DM / 2}; pg8::XcdOrder S; S.init(MTOK, DM, xe.nloc, xe.rank, xe.nx, xe.xi);
        pg8::EpiOut E{(bf16*)(ws + WS_XN), (bf16*)(ws + WS_X1B), (const float*)(ws + WS_SMA), (const float*)(ws + WS_SMB), (const float*)(ws + WS_SWO)};
        pg8::gemm_phase<pg8::EpiOut, pg8::XcdOrder, true, true>(F.lds + RING_OFF, g, S, E);
        if (BOTH(3)) LOCAL_BAR();
    }
    if (IN(4)) { ENV(); const XcdEnv xe = xcd_env(bar);
        const int nM = MTOK / 256, r0 = (int)((long)xe.xi * nM / xe.nx) * 256, r1 = (int)((long)(xe.xi + 1) * nM / xe.nx) * 256;
        quant_rows<true>((const bf16*)(ws + WS_X1B) + (size_t)r0 * DM, (signed char*)(ws + WS_X1Q) + (size_t)r0 * DM, (float*)(ws + WS_SX) + r0, r1 - r0, xe.rank * NWAVES + F.wave, xe.nloc * NWAVES);
        if (BOTH(4)) LOCAL_BAR(); }
    if (IN(5)) { ENV(); const XcdEnv xe = xcd_env(bar);
        pg8::Gemm g{(bf16*)(ws + WS_X1Q), (bf16*)(ws + WS_WGQ), MTOK, NGU, DM / 2}; pg8::XcdOrder S; S.init(MTOK, NGU, xe.nloc, xe.rank, xe.nx, xe.xi);
        pg8::EpiGU E{nullptr, (const float*)(ws + WS_SX), (const float*)(ws + WS_SW), (bf16*)(ws + WS_H)};
        pg8::gemm_phase<pg8::EpiGU, pg8::XcdOrder, true, true>(F.lds + RING_OFF, g, S, E);
        if (BOTH(5)) LOCAL_BAR();
    }
    if (IN(6)) { ENV(); const XcdEnv xe = xcd_env(bar);
        pg8::Gemm g{(bf16*)(ws + WS_H), (bf16*)(ws + WS_WDN), MTOK, DM, DFF}; pg8::XcdOrder S; S.init(MTOK, DM, xe.nloc, xe.rank, xe.nx, xe.xi);
        pg8::EpiDown E{(bf16*)(ws + WS_X1B), (float*)ap_->out};
        pg8::gemm_phase<pg8::EpiDown, pg8::XcdOrder, true, true>(F.lds + RING_OFF, g, S, E);
    }
#undef IN
#undef BOTH
}

extern "C" void kernel_launch(void* const* d_in, const int* in_sizes, int n_in, void* d_out, int out_size, void* d_ws, size_t ws_size, hipStream_t stream) {
    static int grid = 0;
    if (grid == 0) {
        if (n_in != 19 || out_size != MTOK * DM || ws_size < WS_END) { fprintf(stderr, "kernel_launch: unexpected shapes: n_in %d out %d ws %zu; nothing launched\n", n_in, out_size, ws_size); grid = -1; return; }
        int dev = 0, cus = 0;
        if (hipGetDevice(&dev) != hipSuccess || hipDeviceGetAttribute(&cus, hipDeviceAttributeMultiprocessorCount, dev) != hipSuccess) { grid = -1; return; }
        (void)hipGetLastError();
        grid = cus;
    }
    if (grid < 0) return;
    if (hipMemsetAsync((char*)d_ws + WS_CTL, 0, CTL_ZERO_BYTES, stream) != hipSuccess) { fprintf(stderr, "kernel_launch: memset failed\n"); return; }
    Args a{};
    for (int i = 0; i < 19; ++i) a.in[i] = (const float*)d_in[i];
    a.out = (float*)d_out; a.ws = (unsigned char*)d_ws;
#if PROBE_PHASE >= 0
    const int nl = 2; const int los[2] = {0, PROBE_PHASE}, his[2] = {PROBE_PHASE + 1, PER_PHASE};
#else
    const int nl = N_LAUNCHES;
#endif
    for (int li = 0; li < nl; ++li) {
#if PROBE_PHASE >= 0
        a.ph_lo = los[li]; a.ph_hi = his[li]; a.li = li;
#else
        a.ph_lo = (N_LAUNCHES == PER_PHASE) ? li : 0; a.ph_hi = (N_LAUNCHES == PER_PHASE) ? li + 1 : PER_PHASE; a.li = 0;
#endif
        hipLaunchKernelGGL(hybrid_fwd, dim3(grid), dim3(NWAVES * 64), 0, stream, a);
        const hipError_t le = hipPeekAtLastError();
        if (le != hipSuccess) { fprintf(stderr, "kernel_launch: launch %d failed: %s\n", li, hipGetErrorName(le)); break; }
    }
}
```

```cpp
#include <hip/hip_runtime.h>
#include <cstdio>
#include <cstdint>
namespace pg8 {
#define PG8_LAS __attribute__((address_space(3)))
typedef unsigned short bf16_t;
typedef short bf16x8 __attribute__((ext_vector_type(8)));
typedef float f32x4 __attribute__((ext_vector_type(4)));
typedef unsigned u32x4 __attribute__((ext_vector_type(4)));
typedef int i32x4 __attribute__((ext_vector_type(4)));
constexpr int BM = 256, BK = 64, HALF = 128, HTB = HALF * BK * 2  , STAGE_BYTES = 8 * HTB, NXCD = 8, WGM = 8;

__host__ __device__ __forceinline__ int lds_byte(int r, int c) { const int st = (r >> 4) * 2 + (c >> 5), rr = r & 15, cc = c & 31, ob = rr * 64 + cc * 2; return st * 1024 + (ob ^ (((ob >> 9) & 1) << 5)); }
__host__ __device__ __forceinline__ void stage_rc(int b, int& R, int& C) { const int st = b / 1024, sb = b % 1024, swz = sb ^ (((sb >> 9) & 1) << 5); R = (st >> 1) * 16 + swz / 64; C = (st & 1) * 32 + (swz % 64) / 2; }
__host__ __device__ __forceinline__ int perm32(int rho) { const int n = rho >> 4, i = rho & 15; return 8 * (i >> 2) + 4 * n + (i & 3); }

struct Unit { int pm, pn; };
struct Gemm { const bf16_t* A; const bf16_t* Bt; int M, N, K; };

struct StaticOrder {
    int nM, nN, nwg, G, c;
    __host__ __device__ void init(int M, int N, int G_, int c_) { nM = M / BM; nN = N / BM; nwg = nM * nN; G = G_; c = c_; }
    __host__ __device__ bool next(int i, Unit& u) const {
        const long L = (long)i * G + c; if (L >= nwg) return false;
        int wgid = (int)L; { const int q = nwg / NXCD, r = nwg % NXCD, xcd = wgid % NXCD, off = wgid / NXCD; wgid = (xcd < r ? xcd * (q + 1) : r * (q + 1) + (xcd - r) * q) + off; }
        const int nig = WGM * nN, gid = wgid / nig, fm = gid * WGM, gsz = (nM - fm) < WGM ? (nM - fm) : WGM;
        u.pm = fm + ((wgid % nig) % gsz); u.pn = (wgid % nig) / gsz; return true;
    }
    __device__ __forceinline__ void a_ready(const Unit&) const {}
    __device__ __forceinline__ void done(const Unit&) const {}
};

struct XcdOrder {
    int nN, p0, cnt, nloc, rank;
    __host__ __device__ void init(int M, int N, int nloc_, int rank_, int nx, int xi) { const int nM = M / BM; nN = N / BM; p0 = (int)((long)xi * nM / nx); const int p1 = (int)((long)(xi + 1) * nM / nx); cnt = (p1 - p0) * nN; nloc = nloc_; rank = rank_; }
    __host__ __device__ bool next(int i, Unit& u) const {
        const long L = (long)i * nloc + rank; if (L >= cnt) return false;
        const int w = (int)L, np = cnt / nN, nig = WGM * nN, gid = w / nig, fm = gid * WGM, gsz = (np - fm) < WGM ? (np - fm) : WGM;
        u.pm = p0 + fm + ((w % nig) % gsz); u.pn = (w % nig) / gsz; return true;
    }
    __device__ __forceinline__ void a_ready(const Unit&) const {}
    __device__ __forceinline__ void done(const Unit&) const {}
};
struct RevOrder {
    StaticOrder s;
    __host__ __device__ void init(int M, int N, int G_, int c_) { s.init(M, N, G_, c_); }
    __host__ __device__ bool next(int i, Unit& u) const { const bool r = s.next(i, u); u.pm = s.nM - 1 - u.pm; return r; }
    __device__ __forceinline__ void a_ready(const Unit&) const {}
    __device__ __forceinline__ void done(const Unit&) const {}
};

typedef float f32x2_t __attribute__((ext_vector_type(2))); typedef __bf16 bf16x2_t __attribute__((ext_vector_type(2)));
__device__ __forceinline__ unsigned cvt_pk_bf16(float lo, float hi) { f32x2_t v = {lo, hi}; bf16x2_t b = __builtin_convertvector(v, bf16x2_t); return __builtin_bit_cast(unsigned, b); }
constexpr int MP_ROWS = 33024, MP_TOK = 32768;
constexpr float RMS_EPS = 1e-6f;
constexpr float QSCALE = 0.125f * 1.4426950408889634f;

struct EpiQKV {
    typedef f32x4 acc_t;
    static constexpr bool PERM = true, AFTER_DRAIN = false, MIDK = false, TILED = false;
    unsigned char* ws; PG8_LAS unsigned char* vtl; const float *qna, *kna, *qnb, *knb;
    size_t oQA, oKA, oVAt, oQB, oKB, oVBt, oR1;
    __device__ __forceinline__ void operator()(const f32x4 (&acc)[2][2][4][2], const Unit& u, int wr, int wc, int fr, int fq) const {
        constexpr int NT = MP_ROWS / 32;
        const int pn = u.pn, row0 = u.pm * BM + wr * 64 + fr, sec = pn >> 1;
        bf16_t* dst; int head = 4 * (pn & 1) + wc; const float* gain = nullptr; float sc = 1.f; bool isV = false;
        const float* R1 = (const float*)(ws + oR1);
        if (sec == 0) { dst = (bf16_t*)(ws + oQA); gain = qna; sc = QSCALE; }
        else if (sec == 1) { dst = (bf16_t*)(ws + oKA); gain = kna; }
        else if (sec == 2) { dst = (bf16_t*)(ws + oVAt); isV = true; }
        else if (sec == 3) { dst = (bf16_t*)(ws + oQB); gain = qnb; sc = QSCALE; }
        else { if (wc < 2) { dst = (bf16_t*)(ws + oKB); head = wc; gain = knb; } else { dst = (bf16_t*)(ws + oVBt); head = wc - 2; isV = true; } }
        bf16_t* hbase = dst + (size_t)head * NT * 2048;
#define EPI_R1V() float r1v[2][4]; _Pragma("unroll") for (int ai = 0; ai < 2; ++ai) _Pragma("unroll") for (int m = 0; m < 4; ++m) r1v[ai][m] = R1[row0 + ai * HALF + m * 16]
        if (!isV) {
            EPI_R1V();
            f32x4 gv[2][2];
#pragma unroll
            for (int bj = 0; bj < 2; ++bj)
#pragma unroll
                for (int n = 0; n < 2; ++n) gv[bj][n] = *(const f32x4*)(gain + 32 * bj + 8 * fq + 4 * n) * sc;
#pragma unroll
            for (int ai = 0; ai < 2; ++ai)
#pragma unroll
                for (int m = 0; m < 4; ++m) {
                    float ss = 0.f;
#pragma unroll
                    for (int bj = 0; bj < 2; ++bj)
#pragma unroll
                        for (int n = 0; n < 2; ++n) { const f32x4 x = acc[ai][bj][m][n]; ss += (x[0] * x[0] + x[1] * x[1]) + (x[2] * x[2] + x[3] * x[3]); }
                    ss += __shfl_xor(ss, 16); ss += __shfl_xor(ss, 32);
                    const int row = row0 + ai * HALF + m * 16;
                    const float r1 = r1v[ai][m];
                    const float r = r1 * __builtin_amdgcn_rsqf(ss * (r1 * r1) * (1.0f / 64.0f) + RMS_EPS);
                    bf16_t* rowp = hbase + (size_t)(row >> 5) * 2048 + (fq >> 1) * 512 + ((fq & 1) * 32 + (row & 31)) * 8;
#pragma unroll
                    for (int bj = 0; bj < 2; ++bj) { const f32x4 v0 = acc[ai][bj][m][0] * r * gv[bj][0], v1 = acc[ai][bj][m][1] * r * gv[bj][1];
                        u32x4 w; w.x = cvt_pk_bf16(v0[0], v0[1]); w.y = cvt_pk_bf16(v0[2], v0[3]); w.z = cvt_pk_bf16(v1[0], v1[1]); w.w = cvt_pk_bf16(v1[2], v1[3]);
                        *(u32x4*)(rowp + bj * 1024) = w; }
                }
        } else {
            EPI_R1V();
            PG8_LAS unsigned short* vt = (PG8_LAS unsigned short*)(vtl + (wr * 4 + wc) * 2048);
            const int hh = (fr >> 2) & 1, jj = 4 * ((fr >> 3) & 1) + (fr & 3), wofs = (32 * hh + 8 * fq) * 8 + jj, ln = fq * 16 + fr;
#pragma unroll
            for (int ai = 0; ai < 2; ++ai)
#pragma unroll
                for (int m = 0; m < 4; ++m) { const int row = row0 + ai * HALF + m * 16; const float r1 = r1v[ai][m];
                    bf16_t* tb = hbase + (size_t)(row >> 5) * 2048 + (m & 1) * 512 + ln * 8;
#pragma unroll
                    for (int bj = 0; bj < 2; ++bj) { PG8_LAS unsigned short* buf = vt + bj * 512;
#pragma unroll
                        for (int n = 0; n < 2; ++n) { const f32x4 x = acc[ai][bj][m][n] * r1; const unsigned w0 = cvt_pk_bf16(x[0], x[1]), w1 = cvt_pk_bf16(x[2], x[3]);
                            buf[wofs + (4 * n + 0) * 8] = (unsigned short)(w0 & 0xffffu); buf[wofs + (4 * n + 1) * 8] = (unsigned short)(w0 >> 16);
                            buf[wofs + (4 * n + 2) * 8] = (unsigned short)(w1 & 0xffffu); buf[wofs + (4 * n + 3) * 8] = (unsigned short)(w1 >> 16); }
                        const u32x4 w = *(const PG8_LAS u32x4*)(buf + ln * 8);
                        *(u32x4*)(tb + bj * 1024) = w; }
                }
        }
    }
};
struct EpiOut {
    typedef i32x4 acc_t;
    static constexpr bool PERM = true, AFTER_DRAIN = false, MIDK = true, TILED = true;
    const bf16_t* XB; bf16_t* X1B; const float *SMA, *SMB, *SWO;
    __device__ __forceinline__ void pre(float (&rsc)[2][4], const Unit& u, int wr, int fr) const {
        const int row0 = u.pm * BM + wr * 64 + fr; float sa[2][4], sb[2][4];
#pragma unroll
        for (int ai = 0; ai < 2; ++ai)
#pragma unroll
            for (int m = 0; m < 4; ++m) { sa[ai][m] = SMA[row0 + ai * HALF + m * 16]; sb[ai][m] = SMB[row0 + ai * HALF + m * 16]; }
#pragma unroll
        for (int ai = 0; ai < 2; ++ai)
#pragma unroll
            for (int m = 0; m < 4; ++m) rsc[ai][m] = sa[ai][m] / sb[ai][m];
    }
    __device__ __forceinline__ void mid(i32x4 (&acc)[2][2][4][2], const float (&rsc)[2][4]) const {
#pragma unroll
        for (int ai = 0; ai < 2; ++ai)
#pragma unroll
            for (int bj = 0; bj < 2; ++bj)
#pragma unroll
                for (int m = 0; m < 4; ++m)
#pragma unroll
                    for (int n = 0; n < 2; ++n)
#pragma unroll
                        for (int i = 0; i < 4; ++i) acc[ai][bj][m][n][i] = (int)__builtin_rintf((float)acc[ai][bj][m][n][i] * rsc[ai][m]);
    }
    __device__ __forceinline__ void operator()(const i32x4 (&acc)[2][2][4][2], const Unit& u, int wr, int wc, int fr, int fq) const {
        const int row0 = u.pm * BM + wr * 64 + fr, colb = u.pn * BM + wc * 32 + 8 * fq;
        f32x4 swv[2][2];
#pragma unroll
        for (int bj = 0; bj < 2; ++bj)
#pragma unroll
            for (int n = 0; n < 2; ++n) swv[bj][n] = *(const f32x4*)(SWO + colb + bj * HALF + 4 * n);
#pragma unroll
        for (int ai = 0; ai < 2; ++ai) {
            u32x4 xb[4][2]; float sb[4];
#pragma unroll
            for (int m = 0; m < 4; ++m) { sb[m] = SMB[row0 + ai * HALF + m * 16];
#pragma unroll
                for (int bj = 0; bj < 2; ++bj) xb[m][bj] = __builtin_nontemporal_load((const u32x4*)(XB + (size_t)(row0 + ai * HALF + m * 16) * 1024 + colb + bj * HALF)); }
#pragma unroll
            for (int m = 0; m < 4; ++m) { const int row = row0 + ai * HALF + m * 16;
#pragma unroll
                for (int bj = 0; bj < 2; ++bj) { const u32x4 w = xb[m][bj];
                    f32x4 x0, x1; x0[0] = __uint_as_float(w.x << 16); x0[1] = __uint_as_float(w.x & 0xffff0000u); x0[2] = __uint_as_float(w.y << 16); x0[3] = __uint_as_float(w.y & 0xffff0000u);
                    x1[0] = __uint_as_float(w.z << 16); x1[1] = __uint_as_float(w.z & 0xffff0000u); x1[2] = __uint_as_float(w.w << 16); x1[3] = __uint_as_float(w.w & 0xffff0000u);
                    f32x4 v0, v1;
#pragma unroll
                    for (int i = 0; i < 4; ++i) { v0[i] = (float)acc[ai][bj][m][0][i] * (sb[m] * swv[bj][0][i]) + x0[i]; v1[i] = (float)acc[ai][bj][m][1][i] * (sb[m] * swv[bj][1][i]) + x1[i]; }
                    u32x4 o; o.x = cvt_pk_bf16(v0[0], v0[1]); o.y = cvt_pk_bf16(v0[2], v0[3]); o.z = cvt_pk_bf16(v1[0], v1[1]); o.w = cvt_pk_bf16(v1[2], v1[3]);
                    *(u32x4*)(X1B + (size_t)row * 1024 + colb + bj * HALF) = o; }
            }
        }
    }
};
struct EpiGU {
    typedef i32x4 acc_t;
    static constexpr bool PERM = true, AFTER_DRAIN = false, MIDK = false, TILED = true;
    const float *SS2, *SX, *SW; bf16_t* H;
    __device__ __forceinline__ void operator()(const i32x4 (&acc)[2][2][4][2], const Unit& u, int wr, int wc, int fr, int fq) const {
        const int row0 = u.pm * BM + wr * 64 + fr, colb = u.pn * HALF + wc * 32 + 8 * fq;
        float sx[2][4]; f32x4 swv[2][2];
#pragma unroll
        for (int ai = 0; ai < 2; ++ai)
#pragma unroll
            for (int m = 0; m < 4; ++m) sx[ai][m] = SX[row0 + ai * HALF + m * 16];
#pragma unroll
        for (int bj = 0; bj < 2; ++bj)
#pragma unroll
            for (int n = 0; n < 2; ++n) swv[bj][n] = *(const f32x4*)(SW + u.pn * BM + bj * HALF + wc * 32 + 8 * fq + 4 * n);
#pragma unroll
        for (int ai = 0; ai < 2; ++ai)
#pragma unroll
            for (int m = 0; m < 4; ++m) { const int row = row0 + ai * HALF + m * 16;
                const float r = sx[ai][m];
                float hv[8];
#pragma unroll
                for (int n = 0; n < 2; ++n)
#pragma unroll
                    for (int i = 0; i < 4; ++i) { const float g = (float)acc[ai][0][m][n][i] * (r * swv[0][n][i]), up = (float)acc[ai][1][m][n][i] * (r * swv[1][n][i]);
                        const float e = __builtin_amdgcn_exp2f(g * -1.4426950408889634f); hv[4 * n + i] = g * up * __builtin_amdgcn_rcpf(1.0f + e); }
                u32x4 w; w.x = cvt_pk_bf16(hv[0], hv[1]); w.y = cvt_pk_bf16(hv[2], hv[3]); w.z = cvt_pk_bf16(hv[4], hv[5]); w.w = cvt_pk_bf16(hv[6], hv[7]);
                *(u32x4*)(H + ((size_t)(colb >> 6) * MP_TOK + row) * 64 + (colb & 63)) = w;
            }
    }
};
struct EpiDown {
    typedef f32x4 acc_t;
    static constexpr bool PERM = true, AFTER_DRAIN = false, MIDK = false, TILED = true;
    const bf16_t* X1B; float* out;
    __device__ __forceinline__ void operator()(const f32x4 (&acc)[2][2][4][2], const Unit& u, int wr, int wc, int fr, int fq) const {
        const int row0 = u.pm * BM + wr * 64 + fr, colb = u.pn * BM + wc * 32 + 8 * fq;
        u32x4 xb[2][4][2];
#pragma unroll
        for (int ai = 0; ai < 2; ++ai)
#pragma unroll
            for (int m = 0; m < 4; ++m)
#pragma unroll
                for (int bj = 0; bj < 2; ++bj) xb[ai][m][bj] = __builtin_nontemporal_load((const u32x4*)(X1B + (size_t)(row0 + ai * HALF + m * 16) * 1024 + colb + bj * HALF));
#pragma unroll
        for (int ai = 0; ai < 2; ++ai)
#pragma unroll
            for (int m = 0; m < 4; ++m) { const size_t off = (size_t)(row0 + ai * HALF + m * 16) * 1024 + colb;
#pragma unroll
                for (int bj = 0; bj < 2; ++bj) { const u32x4 w = xb[ai][m][bj];
                    f32x4 x0, x1; x0[0] = __uint_as_float(w.x << 16); x0[1] = __uint_as_float(w.x & 0xffff0000u); x0[2] = __uint_as_float(w.y << 16); x0[3] = __uint_as_float(w.y & 0xffff0000u);
                    x1[0] = __uint_as_float(w.z << 16); x1[1] = __uint_as_float(w.z & 0xffff0000u); x1[2] = __uint_as_float(w.w << 16); x1[3] = __uint_as_float(w.w & 0xffff0000u);
                    *(f32x4*)(out + off + bj * HALF) = acc[ai][bj][m][0] + x0; *(f32x4*)(out + off + bj * HALF + 4) = acc[ai][bj][m][1] + x1; }
            }
    }
};

__device__ __forceinline__ f32x4 mma16(bf16x8 a, bf16x8 b, f32x4 c) { return __builtin_amdgcn_mfma_f32_16x16x32_bf16(a, b, c, 0, 0, 0); }
__device__ __forceinline__ i32x4 mma16(bf16x8 a, bf16x8 b, i32x4 c) { return __builtin_amdgcn_mfma_i32_16x16x64_i8(__builtin_bit_cast(i32x4, a), __builtin_bit_cast(i32x4, b), c, 0, 0, 0); }
template <class Epi, class Sched, bool ALIGN_EPI = false, bool SP2 = false>
__device__ __forceinline__ void gemm_phase(PG8_LAS unsigned char* lds, const Gemm g, const Sched& S, const Epi& E) {
    const int tid = threadIdx.x, wid = __builtin_amdgcn_readfirstlane(tid >> 6), lane = tid & 63, wr = wid >> 2, wc = wid & 3, fr = lane & 15, fq = lane >> 4;
    const int K = g.K, nt = K / BK;
    constexpr bool TILED = Epi::TILED;
    const int ldE = TILED ? BK : K;
    unsigned voffA[2], voffB[2];
#pragma unroll
    for (int i = 0; i < 2; ++i) { int R, C; stage_rc(tid * 16 + i * 8192, R, C); const int Rb = Epi::PERM ? ((R & ~31) + perm32(R & 31)) : R;
        voffA[i] = (unsigned)(R * ldE + C) * 2u; voffB[i] = (unsigned)(Rb * ldE + C) * 2u; }
    const size_t kstepA = TILED ? (size_t)g.M * BK * 2 : (size_t)(BK * 2);
    const size_t kstepB = TILED ? (size_t)g.N * BK * 2 : (size_t)(BK * 2);
    const size_t hstep = (size_t)HALF * ldE * 2;
    const size_t tstep = 2 * hstep;
    const unsigned ldsw = (unsigned)wid * 1024u;
    const int aoff = lds_byte(wr * 64 + fr, fq * 8), boff = lds_byte(wc * 32 + fr, fq * 8);
#define PG8_SA(b, h) (((b) * 2 + (h)) * HTB)
#define PG8_SB(b, h) ((4 + (b) * 2 + (h)) * HTB)
#define PG8_STAGE(bufoff, gbase, voff) do { _Pragma("unroll") for (int _i = 0; _i < 2; ++_i) \
        __builtin_amdgcn_global_load_lds((const unsigned*)((const char*)(gbase) + (voff)[_i]), (PG8_LAS unsigned*)(lds + (bufoff) + ldsw + _i * 8192), 16, 0, 0); } while (0)
#define PG8_LDA(dst, b, h) do { _Pragma("unroll") for (int m = 0; m < 4; ++m) _Pragma("unroll") for (int k = 0; k < 2; ++k) dst[m][k] = *(const PG8_LAS bf16x8*)(lds + PG8_SA(b, h) + aoff + m * 2048 + k * 1024); } while (0)
#define PG8_LDB(dst, b, h) do { _Pragma("unroll") for (int n = 0; n < 2; ++n) _Pragma("unroll") for (int k = 0; k < 2; ++k) dst[n][k] = *(const PG8_LAS bf16x8*)(lds + PG8_SB(b, h) + boff + n * 2048 + k * 1024); } while (0)
#define PG8_MMA(ai, bj, At, Bt) do { __builtin_amdgcn_s_setprio(1); _Pragma("unroll") for (int m = 0; m < 4; ++m) _Pragma("unroll") for (int n = 0; n < 2; ++n) _Pragma("unroll") for (int k = 0; k < 2; ++k) \
        acc[ai][bj][m][n] = mma16(Bt[n][k], At[m][k], acc[ai][bj][m][n]); __builtin_amdgcn_s_setprio(0); } while (0)
#define PG8_WAIT_V(n) asm volatile("s_waitcnt vmcnt(" #n ")" ::: "memory")
#define PG8_WAIT_L(n) asm volatile("s_waitcnt lgkmcnt(" #n ")" ::: "memory")
#define PG8_BAR __builtin_amdgcn_s_barrier()
#define PG8_SCHED __builtin_amdgcn_sched_barrier(0)
    Unit cur, nxt; int ui = 0;
    if (!S.next(0, cur)) return;
    typedef typename Epi::acc_t acc_t;
    acc_t acc[2][2][4][2];
#pragma unroll
    for (int a = 0; a < 2; ++a)
#pragma unroll
        for (int b = 0; b < 2; ++b)
#pragma unroll
            for (int m = 0; m < 4; ++m)
#pragma unroll
                for (int n = 0; n < 2; ++n) acc[a][b][m][n] = (acc_t){};
    bf16x8 At[4][2], B0[2][2], B1[2][2];
    const char* cA = (const char*)g.A + (size_t)cur.pm * tstep; const char* cB = (const char*)g.Bt + (size_t)cur.pn * tstep;
    S.a_ready(cur);
    if constexpr (SP2) {
        PG8_STAGE(PG8_SB(0, 0), cB, voffB); PG8_STAGE(PG8_SB(0, 1), cB + hstep, voffB); PG8_STAGE(PG8_SA(0, 0), cA, voffA); PG8_STAGE(PG8_SA(0, 1), cA + hstep, voffA);
        if (wr == 1) PG8_BAR;
        PG8_WAIT_V(2); PG8_BAR;
        PG8_STAGE(PG8_SB(1, 0), cB + kstepB, voffB); PG8_STAGE(PG8_SA(1, 0), cA + kstepA, voffA); PG8_STAGE(PG8_SB(1, 1), cB + hstep + kstepB, voffB);
        PG8_WAIT_V(6); PG8_BAR;
    } else {
        PG8_STAGE(PG8_SB(0, 0), cB, voffB); PG8_STAGE(PG8_SA(0, 0), cA, voffA); PG8_STAGE(PG8_SB(0, 1), cB + hstep, voffB); PG8_STAGE(PG8_SA(0, 1), cA + hstep, voffA);
        if (wr == 1) PG8_BAR;
        PG8_WAIT_V(4); PG8_BAR;
        PG8_STAGE(PG8_SB(1, 0), cB + kstepB, voffB); PG8_STAGE(PG8_SA(1, 0), cA + kstepA, voffA); PG8_STAGE(PG8_SB(1, 1), cB + hstep + kstepB, voffB);
        PG8_WAIT_V(6); PG8_BAR;
    }
    for (;;) {
        const bool has_next = S.next(ui + 1, nxt);
        float rsc[2][4];
        if constexpr (Epi::MIDK) E.pre(rsc, cur, wr, fr);
        const char* nA = has_next ? (const char*)g.A + (size_t)nxt.pm * tstep : cA; const char* nB = has_next ? (const char*)g.Bt + (size_t)nxt.pn * tstep : cB;
        for (int t = 0; t < nt; t += 2) {
            const bool last = (t == nt - 2);
            const char* a1 = cA + (size_t)(t + 1) * kstepA;
            const char* a2 = last ? nA : cA + (size_t)(t + 2) * kstepA; const char* b2 = last ? nB : cB + (size_t)(t + 2) * kstepB;
            const char* a3 = a2 + kstepA; const char* b3 = b2 + kstepB;
            if (last && has_next) S.a_ready(nxt);
            if constexpr (Epi::MIDK) { if (t == nt / 2) E.mid(acc, rsc); }
            if constexpr (SP2) {
            PG8_LDB(B0, 0, 0); PG8_LDB(B1, 0, 1); PG8_SCHED; PG8_LDA(At, 0, 0); PG8_STAGE(PG8_SA(1, 1), a1 + hstep, voffA);
            PG8_WAIT_V(8); PG8_WAIT_L(0); PG8_BAR; PG8_MMA(0, 0, At, B0); PG8_MMA(0, 1, At, B1); PG8_BAR; PG8_SCHED;
            PG8_LDA(At, 0, 1); PG8_STAGE(PG8_SB(0, 0), b2, voffB); PG8_STAGE(PG8_SB(0, 1), b2 + hstep, voffB); PG8_STAGE(PG8_SA(0, 0), a2, voffA);
            PG8_WAIT_V(8); PG8_WAIT_L(0); PG8_BAR; PG8_MMA(1, 0, At, B0); PG8_MMA(1, 1, At, B1); PG8_BAR; PG8_SCHED;
            PG8_LDB(B0, 1, 0); PG8_LDB(B1, 1, 1); PG8_SCHED; PG8_LDA(At, 1, 0); PG8_STAGE(PG8_SA(0, 1), a2 + hstep, voffA);
            PG8_WAIT_V(8); PG8_WAIT_L(0); PG8_BAR; PG8_MMA(0, 0, At, B0); PG8_MMA(0, 1, At, B1); PG8_BAR; PG8_SCHED;
            PG8_LDA(At, 1, 1); PG8_STAGE(PG8_SB(1, 0), b3, voffB); PG8_STAGE(PG8_SB(1, 1), b3 + hstep, voffB); PG8_STAGE(PG8_SA(1, 0), a3, voffA);
            PG8_WAIT_V(8); PG8_WAIT_L(0); PG8_BAR; PG8_MMA(1, 0, At, B0); PG8_MMA(1, 1, At, B1); PG8_BAR; PG8_SCHED;
            } else {
            PG8_LDB(B0, 0, 0); PG8_SCHED; PG8_LDA(At, 0, 0); PG8_STAGE(PG8_SA(1, 1), a1 + hstep, voffA);
            PG8_WAIT_L(8); PG8_BAR; PG8_WAIT_L(0); PG8_MMA(0, 0, At, B0); PG8_BAR; PG8_SCHED;
            PG8_LDB(B1, 0, 1); PG8_STAGE(PG8_SB(0, 0), b2, voffB);
            PG8_BAR; PG8_WAIT_L(0); PG8_MMA(0, 1, At, B1); PG8_BAR;
            PG8_LDA(At, 0, 1); PG8_STAGE(PG8_SA(0, 0), a2, voffA);
            PG8_BAR; PG8_WAIT_L(0); PG8_MMA(1, 0, At, B0); PG8_BAR; PG8_SCHED;
            PG8_STAGE(PG8_SB(0, 1), b2 + hstep, voffB);
            PG8_WAIT_V(6); PG8_BAR; PG8_MMA(1, 1, At, B1); PG8_BAR;
            PG8_LDB(B0, 1, 0); PG8_SCHED; PG8_LDA(At, 1, 0); PG8_STAGE(PG8_SA(0, 1), a2 + hstep, voffA);
            PG8_WAIT_L(8); PG8_BAR; PG8_WAIT_L(0); PG8_MMA(0, 0, At, B0); PG8_BAR; PG8_SCHED;
            PG8_LDB(B1, 1, 1); PG8_STAGE(PG8_SB(1, 0), b3, voffB);
            PG8_BAR; PG8_WAIT_L(0); PG8_MMA(0, 1, At, B1); PG8_BAR;
            PG8_LDA(At, 1, 1); PG8_STAGE(PG8_SA(1, 0), a3, voffA);
            PG8_BAR; PG8_WAIT_L(0); PG8_MMA(1, 0, At, B0); PG8_BAR; PG8_SCHED;
            PG8_STAGE(PG8_SB(1, 1), b3 + hstep, voffB);
            PG8_WAIT_V(6); PG8_BAR; PG8_MMA(1, 1, At, B1); PG8_BAR;
            }
        }
        if constexpr (ALIGN_EPI) { if (wr == 0) PG8_BAR; }
        if constexpr (!Epi::AFTER_DRAIN) { E(acc, cur, wr, wc, fr, fq); S.done(cur); }
        if (!has_next) break;
#pragma unroll
        for (int a = 0; a < 2; ++a)
#pragma unroll
            for (int b = 0; b < 2; ++b)
#pragma unroll
                for (int m = 0; m < 4; ++m)
#pragma unroll
                    for (int n = 0; n < 2; ++n) acc[a][b][m][n] = (acc_t){};
        cur = nxt; cA = nA; cB = nB; ++ui;
        if constexpr (ALIGN_EPI) { if (wr == 1) PG8_BAR; }
    }
    PG8_WAIT_V(0);
    if constexpr (!ALIGN_EPI) { if (wr == 0) PG8_BAR; }
    PG8_BAR;
    if constexpr (Epi::AFTER_DRAIN) { E.fused(acc, cur, wr, wc, fr, fq, lds, wid, lane); S.done(cur); }
#undef PG8_SA
#undef PG8_SB
#undef PG8_STAGE
#undef PG8_LDA
#undef PG8_LDB
#undef PG8_MMA
#undef PG8_WAIT_V
#undef PG8_WAIT_L
#undef PG8_BAR
#undef PG8_SCHED
}
}
constexpr int NWAVES = 8;
constexpr int DM = 1024, MTOK = 32768, MPAD = pg8::MP_ROWS, NIN = 2304, DFF = 2816, NGU = 2 * DFF;
constexpr float LOG2E = 1.4426950408889634f;
constexpr float EPS = 1e-6f;
constexpr size_t MiB = 1u << 20;
constexpr size_t WS_CTL = 0, CTL_ZERO_BYTES = 65536;
constexpr size_t WS_SMA = 1 * MiB, WS_SMB = WS_SMA + 131072;
constexpr size_t WS_SWO = 9 * MiB + 524288 - 4096;
constexpr size_t WS_WOQ = 404 * MiB;
constexpr size_t WS_WDN = 3 * MiB;
constexpr size_t WS_R1 = 9 * MiB;
constexpr size_t WS_SX = WS_R1 + 262144, WS_SW = WS_R1 + 524288;
constexpr size_t WS_MIX = 10 * MiB;
constexpr size_t WS_X1Q = WS_MIX;
constexpr size_t WS_QKV = 74 * MiB;
constexpr size_t SZ_Q = (size_t)MPAD * 512 * 2, SZ_KB = (size_t)MPAD * 128 * 2;
constexpr size_t WS_QA = WS_QKV, WS_KA = WS_QA + SZ_Q, WS_VAT = WS_KA + SZ_Q, WS_QB = WS_VAT + SZ_Q, WS_KB = WS_QB + SZ_Q, WS_VBT = WS_KB + SZ_KB, WS_QKV_END = WS_VBT + SZ_KB;
constexpr size_t WS_H = 74 * MiB;
constexpr size_t WS_X1B = 250 * MiB;
constexpr size_t WS_XN = 314 * MiB;
constexpr size_t WS_WGQ = 405 * MiB;
constexpr size_t WS_WGU = 385 * MiB;
constexpr size_t WS_WIN = 396 * MiB;
constexpr size_t WS_WOUT = 383 * MiB;
constexpr size_t WS_END = 411 * MiB;
static_assert(WS_SMB + 131072 <= WS_WDN && WS_WDN + (size_t)DM * DFF * 2 <= WS_R1 && WS_R1 + (size_t)MPAD * 4 <= WS_SX && WS_SX + (size_t)MTOK * 4 <= WS_SWO && WS_SWO + 4096 == WS_SW && WS_SW + (size_t)NGU * 4 <= WS_MIX
              && WS_MIX + (size_t)MTOK * DM <= WS_QKV && WS_QKV_END <= WS_X1B && WS_H + (size_t)MTOK * DFF * 2 <= WS_X1B && WS_X1B + (size_t)MTOK * DM * 2 <= WS_XN
              && WS_XN + (size_t)MPAD * DM * 2 <= WS_WOUT && WS_WOUT + (size_t)DM * DM * 2 == WS_WGU && WS_WGU + (size_t)NGU * DM * 2 <= WS_WIN && WS_WIN + (size_t)NIN * DM * 2 <= WS_WOQ && WS_WOQ + (size_t)DM * DM == WS_WGQ
              && WS_WGQ + (size_t)NGU * DM <= WS_END, "d_ws map");
constexpr int CW_TMO = 0, CW_CODE = 1, CW_BAR = 4096;
constexpr int RING_OFF = 0, RING_BYTES = 131072;
constexpr int LDSCTL_OFF = 162816, MISC_OFF = LDSCTL_OFF + 320;
constexpr int LDS_BYTES = 163840;
#define GAS __attribute__((address_space(1)))
#define LAS __attribute__((address_space(3)))
typedef unsigned short bf16;
typedef unsigned v4u __attribute__((ext_vector_type(4)));
typedef float f32x4 __attribute__((ext_vector_type(4)));
typedef short bf16x8 __attribute__((ext_vector_type(8)));
typedef GAS unsigned gu32;
typedef GAS unsigned long long gu64;
#define RLX_AGENT __ATOMIC_RELAXED, __HIP_MEMORY_SCOPE_AGENT
#define LDS_WAIT() asm volatile("s_waitcnt lgkmcnt(0)" ::: "memory")
#define VM_WAIT() asm volatile("s_waitcnt vmcnt(0)" ::: "memory")
__device__ __forceinline__ unsigned long long rt() { return __builtin_amdgcn_s_memrealtime(); }
__device__ __forceinline__ unsigned f2bf(float f) { unsigned u = __builtin_bit_cast(unsigned, f); return (u + 0x7fffu + ((u >> 16) & 1u)) >> 16; }
__device__ __forceinline__ unsigned pk2(float lo, float hi) { return f2bf(lo) | (f2bf(hi) << 16); }

#define XB_TMO      128
#define XB_XCNT(j)  (256  + 64 * (j))
#define XB_XSUB(j)  (1280 + 64 * (j))
#define XB_XGEN(j)  (2304 + 64 * (j))
#define XB_TOP      3328
#define XB_TOPGEN   3392
#define XB_LSUB(j)  (3456 + 64 * (j))
#define XCD_BAR_WORDS 4480
#define XB_SPIN_CAP (1u << 18)

__device__ __forceinline__ unsigned xb_ld(unsigned* p)              { return __hip_atomic_load(p, __ATOMIC_RELAXED, __HIP_MEMORY_SCOPE_AGENT); }
__device__ __forceinline__ unsigned xb_add(unsigned* p, unsigned v) { return __hip_atomic_fetch_add(p, v, __ATOMIC_RELAXED, __HIP_MEMORY_SCOPE_AGENT); }
__device__ __forceinline__ unsigned xb_xcc_id() { return (unsigned)__builtin_amdgcn_s_getreg((3 << 11) | 20) & 0xFu; }
#define XB_SPIN(cond, bar) do { unsigned _sp = 0; while (cond) { __builtin_amdgcn_s_sleep(1); \
    if ((++_sp & 255u) == 0u) { if (xb_ld(&(bar)[XB_TMO])) break; if (_sp > XB_SPIN_CAP) { atomicAdd(&(bar)[XB_TMO], 1u); break; } } } } while (0)

struct XcdBarrier {
    unsigned* bar; unsigned x;
    volatile LAS unsigned* st;
};

__device__ __forceinline__ XcdBarrier xcd_barrier_post(unsigned* bar, volatile LAS unsigned* st) {
    XcdBarrier b; b.bar = bar; b.x = xb_xcc_id(); b.st = st;
    if (threadIdx.x == 0) st[3] = xb_add(&bar[XB_XCNT(b.x)], 1u);
    return b;
}
__device__ __forceinline__ void xcd_barrier_complete(unsigned* bar, unsigned x, unsigned& nloc, unsigned& nx, unsigned& xi) {
    const unsigned G = gridDim.x * gridDim.y * gridDim.z;
    unsigned sum, cnt, mine, below, sp = 0u;
    for (;;) {
        sum = 0u; cnt = 0u; mine = 0u; below = 0u;
#pragma unroll
        for (unsigned j = 0; j < 16; ++j) { const unsigned c = xb_ld(&bar[XB_XCNT(j)]); sum += c; cnt += (c > 0u) ? 1u : 0u; mine = (j == x) ? c : mine; below += (j < x && c > 0u) ? 1u : 0u; }
        if (sum == G) break;
        __builtin_amdgcn_s_sleep(1);
        if ((++sp & 255u) == 0u) { if (xb_ld(&bar[XB_TMO])) break; if (sp > XB_SPIN_CAP) { atomicAdd(&bar[XB_TMO], 1u); break; } }
    }
    nloc = mine > 0u ? mine : 1u; nx = cnt > 0u ? cnt : 1u; xi = below < nx ? below : nx - 1u;
}

__device__ __forceinline__ void xcd_barrier(const XcdBarrier& b) {
    asm volatile("s_waitcnt vmcnt(0)" ::: "memory");
    __syncthreads();
    if (threadIdx.x == 0) {
        unsigned* bar = b.bar;
        __builtin_amdgcn_s_waitcnt(0);
        unsigned nloc = b.st[0], nx = b.st[1];
        if (nloc == 0u) { unsigned xi; xcd_barrier_complete(bar, b.x, nloc, nx, xi); b.st[0] = nloc; b.st[1] = nx; b.st[2] = xi; }
        const unsigned old = xb_add(&bar[XB_XSUB(b.x)], 1u);
        const unsigned gen = old / nloc;
        if (old + 1u == (gen + 1u) * nloc) {
            __builtin_amdgcn_fence(__ATOMIC_RELEASE, "agent");
            asm volatile("s_waitcnt vmcnt(0)" ::: "memory");
            const unsigned og = xb_add(&bar[XB_TOP], 1u);
            const unsigned tg = og / nx;
            if (og + 1u == (tg + 1u) * nx) xb_add(&bar[XB_TOPGEN], 1u);
            else XB_SPIN(xb_ld(&bar[XB_TOPGEN]) == tg, bar);
            __builtin_amdgcn_fence(__ATOMIC_ACQUIRE, "agent");
            xb_add(&bar[XB_XGEN(b.x)], 1u);
            asm volatile("s_waitcnt vmcnt(0)" ::: "memory");
        } else {
            XB_SPIN(xb_ld(&bar[XB_XGEN(b.x)]) == gen, bar);
            __builtin_amdgcn_fence(__ATOMIC_ACQUIRE, "agent");
            asm volatile("s_waitcnt vmcnt(0)" ::: "memory");
        }
    }
    __syncthreads();
}

struct XcdEnv { int nloc, nx, xi, rank; };
__device__ __forceinline__ XcdEnv xcd_env(const XcdBarrier& b) {
    if (threadIdx.x == 0 && b.st[0] == 0u) { unsigned nloc, nx, xi; xcd_barrier_complete(b.bar, b.x, nloc, nx, xi); b.st[1] = nx; b.st[2] = xi; b.st[0] = nloc; }
    __syncthreads();
    XcdEnv e; e.nloc = __builtin_amdgcn_readfirstlane((int)b.st[0]); e.nx = __builtin_amdgcn_readfirstlane((int)b.st[1]); e.xi = __builtin_amdgcn_readfirstlane((int)b.st[2]); e.rank = __builtin_amdgcn_readfirstlane((int)b.st[3]);
    return e;
}
__device__ __forceinline__ void xcd_local_barrier(const XcdBarrier& b) {
    asm volatile("s_waitcnt vmcnt(0)" ::: "memory");
    __syncthreads();
    if (threadIdx.x == 0) {
        unsigned* bar = b.bar;
        __builtin_amdgcn_s_waitcnt(0);
        unsigned nloc = b.st[0];
        if (nloc == 0u) { unsigned nx, xi; xcd_barrier_complete(bar, b.x, nloc, nx, xi); b.st[1] = nx; b.st[2] = xi; b.st[0] = nloc; }
        const unsigned old = xb_add(&bar[XB_LSUB(b.x)], 1u);
        const unsigned target = (old / nloc + 1u) * nloc;
        XB_SPIN(xb_ld(&bar[XB_LSUB(b.x)]) < target, bar);
        __builtin_amdgcn_fence(__ATOMIC_ACQUIRE, "agent");
        asm volatile("s_waitcnt vmcnt(0)" ::: "memory");
    }
    __syncthreads();
}

static_assert((CW_BAR + 2 * XCD_BAR_WORDS) * 4 <= (int)CTL_ZERO_BYTES, "barrier words inside the memset region");
typedef float f32x16 __attribute__((ext_vector_type(16)));
typedef short s16x4 __attribute__((ext_vector_type(4)));
typedef unsigned u32x2 __attribute__((ext_vector_type(2)));
typedef unsigned u32x4 __attribute__((ext_vector_type(4)));
struct Frame {
    LAS unsigned char* lds;
    volatile LAS unsigned* MISC;
    gu32* ctl;
    int wave;
    int vcu, G;
};
__device__ __forceinline__ int fresh_lane() { int t = threadIdx.x; asm volatile("" : "+v"(t)); return t & 63; }
__device__ __forceinline__ float wave_sum(float v) {
#pragma unroll
    for (int o = 1; o < 64; o <<= 1) v += __shfl_xor(v, o);
    return v;
}
__device__ __forceinline__ unsigned q8x4(float a, float b, float c, float d, float qs) {
    const unsigned ua = __float_as_uint(__builtin_fmaf(a, qs, 12582912.0f)), ub = __float_as_uint(__builtin_fmaf(b, qs, 12582912.0f));
    const unsigned uc = __float_as_uint(__builtin_fmaf(c, qs, 12582912.0f)), ud = __float_as_uint(__builtin_fmaf(d, qs, 12582912.0f));
    const unsigned lo = __builtin_amdgcn_perm(ub, ua, 0x0c0c0400u), hi = __builtin_amdgcn_perm(ud, uc, 0x04000c0cu);
    return lo | hi;
}
constexpr int NBT_LD = 1028;
__device__ __forceinline__ void p0_nblock_task(const float* W, int N, int n0, const float* g, signed char* dstq, float* scl, int drow0, LAS float* T, int wave, int lane, int nrows) {
    const int kq = lane >> 3, c4 = lane & 7;
#pragma unroll
    for (int kb2 = 0; kb2 < 2; ++kb2) { const int k0 = 64 * (2 * wave + kb2);
        f32x4 v[8];
#pragma unroll
        for (int i = 0; i < 8; ++i) v[i] = __builtin_nontemporal_load((const GAS f32x4*)(W + (size_t)(k0 + 8 * i + kq) * N + n0 + 4 * c4));
        if (g) {
#pragma unroll
            for (int i = 0; i < 8; ++i) v[i] = v[i] * g[k0 + 8 * i + kq]; }
#pragma unroll
        for (int i = 0; i < 8; ++i) { LAS float* d = T + (4 * c4) * NBT_LD + k0 + 8 * i + kq; d[0] = v[i].x; d[NBT_LD] = v[i].y; d[2 * NBT_LD] = v[i].z; d[3 * NBT_LD] = v[i].w; } }
    LDS_WAIT(); __syncthreads();
#pragma unroll
    for (int c = 0; c < 4; ++c) { const int ch = 4 * wave + c; const LAS f32x4* rp = (const LAS f32x4*)(T + ch * NBT_LD + 16 * lane);
        const f32x4 a = rp[0], b = rp[1], cc = rp[2], d = rp[3];
        float am = fmaxf(fmaxf(fmaxf(fabsf(a[0]), fabsf(a[1])), fmaxf(fabsf(a[2]), fabsf(a[3]))), fmaxf(fmaxf(fabsf(b[0]), fabsf(b[1])), fmaxf(fabsf(b[2]), fabsf(b[3]))));
        am = fmaxf(am, fmaxf(fmaxf(fmaxf(fabsf(cc[0]), fabsf(cc[1])), fmaxf(fabsf(cc[2]), fabsf(cc[3]))), fmaxf(fmaxf(fabsf(d[0]), fabsf(d[1])), fmaxf(fabsf(d[2]), fabsf(d[3])))));
#pragma unroll
        for (int o = 1; o < 64; o <<= 1) am = fmaxf(am, __shfl_xor(am, o));
        const float qs = am > 0.f ? 127.0f / am : 0.f;
        v4u q; q.x = q8x4(a[0], a[1], a[2], a[3], qs); q.y = q8x4(b[0], b[1], b[2], b[3], qs); q.z = q8x4(cc[0], cc[1], cc[2], cc[3], qs); q.w = q8x4(d[0], d[1], d[2], d[3], qs);
        *(GAS v4u*)(dstq + ((size_t)(lane >> 3) * nrows + drow0 + ch) * 128 + (lane & 7) * 16) = q;
        if (lane == 0) scl[drow0 + ch] = am > 0.f ? am * (1.0f / 127.0f) : 1.0f; }
    LDS_WAIT(); __syncthreads();
}
constexpr int P0_NTASKS = DM / 32 + 2 * (DFF / 32);
__device__ __forceinline__ void p0_weight_tasks(Frame& F, const float* w_out, const float* g2, const float* w_gate, const float* w_up, signed char* WOQ, float* SWO, signed char* WGQ, float* SW, int wg, int nwg) {
    LAS float* T = (LAS float*)(F.lds + RING_OFF);
    __syncthreads();
    for (int t = wg; t < P0_NTASKS; t += nwg) {
        if (t < DM / 32) { p0_nblock_task(w_out, DM, 32 * t, nullptr, WOQ, SWO, 32 * t, T, F.wave, fresh_lane(), DM); continue; }
        const int r = t - DM / 32; const bool up = r >= DFF / 32; const int n0 = 32 * (up ? r - DFF / 32 : r);
        p0_nblock_task(up ? w_up : w_gate, DFF, n0, g2, WGQ, SW, 256 * (n0 >> 7) + (up ? 128 : 0) + (n0 & 127), T, F.wave, fresh_lane(), NGU);
    }
}
__device__ __forceinline__ void p0_transpose_item(const float* W, int K, int N, bf16* WT, int k0, int n0, int drow, const float* g, LAS float* scr, int lane, int tiled_rows = 0) {
    f32x4 v[8]; const int kq = lane >> 3, c4 = lane & 7;
#pragma unroll
    for (int i = 0; i < 8; ++i) v[i] = __builtin_nontemporal_load((const GAS f32x4*)(W + (size_t)(k0 + 8 * i + kq) * N + n0 + 4 * c4));
    if (g) {
#pragma unroll
        for (int i = 0; i < 8; ++i) v[i] = v[i] * g[k0 + 8 * i + kq]; }
#pragma unroll
    for (int i = 0; i < 8; ++i) { LAS float* d = scr + (8 * i + kq) * 33 + 4 * c4; d[0] = v[i].x; d[1] = v[i].y; d[2] = v[i].z; d[3] = v[i].w; }
    LDS_WAIT(); asm volatile("" ::: "memory");
    const int c = lane & 7;
#pragma unroll
    for (int j = 0; j < 4; ++j) { const int n = (lane >> 3) + 8 * j; const LAS float* s = scr + (8 * c) * 33 + n;
        v4u o; o.x = pk2(s[0 * 33], s[1 * 33]); o.y = pk2(s[2 * 33], s[3 * 33]); o.z = pk2(s[4 * 33], s[5 * 33]); o.w = pk2(s[6 * 33], s[7 * 33]);
        *(GAS v4u*)(WT + (tiled_rows ? ((size_t)(k0 >> 6) * tiled_rows + drow + n) * 64 + 8 * c : (size_t)(drow + n) * K + k0 + 8 * c)) = o; }
    LDS_WAIT(); asm volatile("" ::: "memory");
}
constexpr int P0_I_IN = (DM / 64) * (NIN / 32), P0_I_DN = (DFF / 64) * (DM / 32), P0_NITEMS = P0_I_IN + P0_I_DN;
__device__ __forceinline__ void p0_weight_items(Frame& F, const float* g1, const float* w_in, const float* w_down, bf16* WIN, bf16* WDN, LAS float* scr, int lo, int hi, int worker, int nworkers) {
    constexpr int I_IN = P0_I_IN;
    for (int it = lo + worker; it < hi; it += nworkers) {
        int r = it;
        if (r < I_IN) { const int nb = r % (NIN / 32), kb = r / (NIN / 32), n0 = 32 * nb, g = n0 >> 6;
            const int drow = 256 * (g >> 2) + 128 * ((n0 & 63) >> 5) + 32 * (g & 3);
            p0_transpose_item(w_in, DM, NIN, WIN, 64 * kb, n0, drow, g1, scr, fresh_lane()); continue; } r -= I_IN;
        { const int nb = r % (DM / 32), kb = r / (DM / 32); p0_transpose_item(w_down, DFF, DM, WDN, 64 * kb, 32 * nb, 32 * nb, nullptr, scr, fresh_lane(), DM); }
    }
}
__device__ __forceinline__ void p0_prologue(Frame& F, const float* xp, const float* xs, const float* meta, const float* g1, const float* w_in, const float* w_out, const float* g2, const float* w_gate, const float* w_up, const float* w_down,
        bf16* WIN, signed char* WOQ, float* SWO, signed char* WGQ, float* SW, bf16* WDN, bf16* XN, float* R1, bool defer) {
    LAS float* scr = (LAS float*)(F.lds + RING_OFF + F.wave * 16384);
    const int lane_ = fresh_lane();
    const int gw = F.vcu * NWAVES + F.wave, NGW = F.G * NWAVES;
    constexpr int I_IN = (DM / 64) * (NIN / 32);
    p0_weight_items(F, g1, w_in, w_down, WIN, WDN, scr, 0, defer ? I_IN : P0_NITEMS, gw, NGW);
    if (!defer) p0_weight_tasks(F, w_out, g2, w_gate, w_up, WOQ, SWO, WGQ, SW, F.vcu, F.G);
    for (int m0 = gw; m0 < MPAD; m0 += 4 * NGW) {
        f32x4 v[4][4];
#pragma unroll
        for (int b = 0; b < 4; ++b) { const int m = m0 + b * NGW;
            if (m < MTOK + 16) { const float* xrow = m < 16384 ? xp + (size_t)m * DM : (m < MTOK ? xs + (size_t)(m - 16384) * DM : meta + (size_t)(m - MTOK) * DM);
                const GAS f32x4* xr = (const GAS f32x4*)xrow + lane_;
#pragma unroll
                for (int j = 0; j < 4; ++j) v[b][j] = __builtin_nontemporal_load(xr + 64 * j); }
            else {
#pragma unroll
                for (int j = 0; j < 4; ++j) v[b][j] = (f32x4){0.f, 0.f, 0.f, 0.f}; } }
#pragma unroll
        for (int b = 0; b < 4; ++b) { const int m = m0 + b * NGW; if (m >= MPAD) continue;
            float sq = 0.f;
#pragma unroll
            for (int j = 0; j < 4; ++j) sq += (v[b][j].x * v[b][j].x + v[b][j].y * v[b][j].y) + (v[b][j].z * v[b][j].z + v[b][j].w * v[b][j].w);
            const float rstd = __builtin_amdgcn_rsqf(wave_sum(sq) * (1.f / DM) + EPS);
            if (lane_ == 0) R1[m] = rstd;
            GAS unsigned long long* o8 = (GAS unsigned long long*)(XN + (size_t)m * DM) + lane_;
#pragma unroll
            for (int j = 0; j < 4; ++j) { const f32x4 y = v[b][j];
                o8[64 * j] = (unsigned long long)pk2(y.x, y.y) | ((unsigned long long)pk2(y.z, y.w) << 32); } }
    }
}
__device__ __forceinline__ unsigned cvtpk(float lo, float hi) { return pg8::cvt_pk_bf16(lo, hi); }
__device__ __forceinline__ void attn_load_kv(bf16x8 (&kf)[4], bf16x8 (&vf)[2][2], const bf16* krow, const bf16* vcol) {
#pragma unroll
    for (int s = 0; s < 4; ++s) kf[s] = *(const bf16x8*)(krow + 16 * s);
#pragma unroll
    for (int db = 0; db < 2; ++db)
#pragma unroll
        for (int s = 0; s < 2; ++s) { const bf16* p = vcol + (size_t)(32 * db) * MPAD + 16 * s;
            const s16x4 lo = *(const s16x4*)p, hi = *(const s16x4*)(p + 8);
            vf[db][s] = (bf16x8){lo[0], lo[1], lo[2], lo[3], hi[0], hi[1], hi[2], hi[3]}; }
}
__device__ __forceinline__ void attn_load_k(bf16x8 (&kf)[4], const bf16* kt) {
#pragma unroll
    for (int s = 0; s < 4; ++s) kf[s] = *(const bf16x8*)(kt + 512 * s);
}
__device__ __forceinline__ void attn_load_v(bf16x8 (&vf)[2][2], const bf16* vt) {
#pragma unroll
    for (int db = 0; db < 2; ++db)
#pragma unroll
        for (int s = 0; s < 2; ++s) vf[db][s] = *(const bf16x8*)(vt + 512 * (2 * db + s));
}
__device__ __forceinline__ f32x16 attn_qk(const bf16x8 (&kf)[4], const LAS bf16x8* qf, f32x16 S = (f32x16){}) {
#pragma unroll
    for (int s = 0; s < 4; ++s) S = __builtin_amdgcn_mfma_f32_32x32x16_bf16(kf[s], qf[64 * s], S, 0, 0, 0);
    return S;
}
__device__ __forceinline__ void attn_pv_half(f32x16 (&O)[2], const float (&p)[8], const bf16x8 (&vf)[2][2], int s) {
    u32x4 pw; pw.x = cvtpk(p[0], p[1]); pw.y = cvtpk(p[2], p[3]); pw.z = cvtpk(p[4], p[5]); pw.w = cvtpk(p[6], p[7]);
    const bf16x8 pb = __builtin_bit_cast(bf16x8, pw);
#pragma unroll
    for (int db = 0; db < 2; ++db) O[db] = __builtin_amdgcn_mfma_f32_32x32x16_bf16(vf[db][s], pb, O[db], 0, 0, 0);
}
__device__ __forceinline__ f32x16 attn_tab16(const LAS float* tab4, int cstride, int I) {
    const int a = I & 3; const LAS f32x4* p = (const LAS f32x4*)(tab4 + a * cstride + (I - a));
    const f32x4 v0 = p[0], v1 = p[2], v2 = p[4], v3 = p[6];
    return (f32x16){v0[0], v0[1], v0[2], v0[3], v1[0], v1[1], v1[2], v1[3], v2[0], v2[1], v2[2], v2[3], v3[0], v3[1], v3[2], v3[3]};
}
constexpr int TA_CS = 608, TB_CS = 324, TM_CS = 132;
template <bool ISB, int CB>
__device__ __forceinline__ void attn_win_tile(f32x16 (&O)[2][2], float (&l)[2], const bf16x8 (&kf)[4], const bf16x8 (&vf)[2][2], const LAS bf16x8* qf,
                                              const LAS float* tabAB, const LAS float* tabM, int wt, int rowoff, int jlo, int q, int h) {
#pragma unroll
    for (int qb = 0; qb < 2; ++qb) {
        if (ISB) { const int j = jlo + wt; if ((qb == 0 && j == 9) || (qb == 1 && j == 0)) continue; }
        constexpr int cb = CB;
        f32x16 C, Bv = (f32x16){};
        if (!ISB) {
            const int c = 32 * qb + q; int cs = c - 8; cs = cs < 0 ? 0 : (cs > 48 ? 48 : cs);
            const int kcb = 32 * cb + 4 * h;
            C = attn_tab16(tabM, TM_CS, 63 + kcb - cs);
            Bv = attn_tab16(tabAB, TA_CS, rowoff + 63 + kcb - c);
        } else {
            C = attn_tab16(tabAB, TB_CS, 32 * (jlo + wt) - 128 - 32 * qb - q + 4 * h + 160);
        }
        const f32x16 S = attn_qk(kf, qf + 256 * qb, C);
        float ls0 = 0.f, ls1 = 0.f;
#pragma unroll
        for (int s2 = 0; s2 < 2; ++s2) {
            if (!ISB && qb != cb && s2 == cb) continue;
            float p[8];
#pragma unroll
            for (int j = 0; j < 8; ++j) { const int rg = 8 * s2 + j;
                float x = S[rg]; if (!ISB) x += Bv[rg];
                p[j] = __builtin_amdgcn_exp2f(x); }
            ls0 += (p[0] + p[1]) + (p[2] + p[3]); ls1 += (p[4] + p[5]) + (p[6] + p[7]);
            attn_pv_half(O[qb], p, vf, s2);
        }
        l[qb] += ls0 + ls1;
        __builtin_amdgcn_sched_barrier(0);
    }
}
struct AttnPtrs { const bf16 *QA, *KA, *VAT, *QB, *KB, *VBT; unsigned char* MIX; float *SMA, *SMB; const float *ona, *onb; };
template <bool ISB>
__device__ __forceinline__ void attn_unit(Frame& F, const AttnPtrs& T, int t0, const LAS float* tabAB, const LAS float* tabM, float sinkexp, LAS float* ssx, LAS bf16x8* qlds) {
    const int lane = fresh_lane(), w = F.wave, q = lane & 31, h = lane >> 5;
    int sb, N; if (t0 < 16384) { sb = t0 & ~8191; N = 8192; } else { sb = 16384 + ((t0 - 16384) & ~4095); N = 4096; }
    const int q0 = t0 - sb;
    constexpr int NT = MPAD / 32;
    const bf16* Qp = (ISB ? T.QB : T.QA) + ((size_t)w * NT + (t0 >> 5)) * 2048 + lane * 8;
    const int khead = ISB ? (w >> 2) : w;
    const bf16* Kp = (ISB ? T.KB : T.KA) + (size_t)khead * NT * 2048 + lane * 8;
    const bf16* Vp = (ISB ? T.VBT : T.VAT) + (size_t)khead * NT * 2048 + lane * 8;
    int nw, jlo = 0, tbase0, rs = 0, rq = 0;
    if (!ISB) { const int rows = N >> 6; rq = q0 >> 6; rs = rq - 4; rs = rs < 0 ? 0 : (rs > rows - 8 ? rows - 8 : rs); nw = 16; tbase0 = sb + 64 * rs; }
    else { jlo = q0 >= 128 ? 0 : (128 - q0) >> 5; int jhi = (N - q0 + 128) >> 5; jhi = jhi > 10 ? 10 : jhi; nw = jhi - jlo; tbase0 = sb + q0 - 128 + 32 * jlo; }
#define ATT_KROW(wt_) (rs + ((((wt_) >> 1) - rs) & 7))
#define ATT_TB(wt_) (ISB ? tbase0 + 32 * (wt_) : sb + 64 * ATT_KROW(wt_) + 32 * ((wt_) & 1))
    bf16x8 kfX[4], kfY[4], vfX[2][2], vfY[2][2];
    attn_load_k(kfX, Kp + (size_t)(MTOK >> 5) * 2048); attn_load_v(vfX, Vp + (size_t)(MTOK >> 5) * 2048);
    { const int tb = ATT_TB(0); attn_load_k(kfY, Kp + (size_t)(tb >> 5) * 2048); attn_load_v(vfY, Vp + (size_t)(tb >> 5) * 2048); }
    LAS bf16x8* qf = qlds + lane;
#pragma unroll
    for (int qb = 0; qb < 2; ++qb)
#pragma unroll
        for (int s = 0; s < 4; ++s) qf[256 * qb + 64 * s] = __builtin_nontemporal_load((const bf16x8*)(Qp + 2048 * qb + 512 * s));
    f32x16 O[2][2]; float l[2] = {0.f, 0.f};
#pragma unroll
    for (int qb = 0; qb < 2; ++qb)
#pragma unroll
        for (int db = 0; db < 2; ++db) O[qb][db] = (f32x16){};
#pragma unroll
    for (int qb = 0; qb < 2; ++qb) {
        const f32x16 S = attn_qk(kfX, qf + 256 * qb); float ls = 0.f;
        const int ib = 144 - q0 - 32 * qb - q + 4 * h;
        float p[8];
#pragma unroll
        for (int r = 0; r < 8; ++r) { float b = 0.f; if (ISB) { int idx = ib + (r & 3) + 8 * (r >> 2); idx = idx < 32 ? 32 : idx; b = tabAB[idx]; }
            p[r] = __builtin_amdgcn_exp2f(S[r] + b); ls += p[r]; }
        l[qb] += ls; attn_pv_half(O[qb], p, vfX, 0);
        __builtin_amdgcn_sched_barrier(0);
    }
#pragma unroll 1
    for (int wt = 0; wt < nw; wt += 2) {
        { const int tb = ATT_TB(wt + 1); attn_load_k(kfX, Kp + (size_t)(tb >> 5) * 2048); attn_load_v(vfX, Vp + (size_t)(tb >> 5) * 2048); }
        attn_win_tile<ISB, 0>(O, l, kfY, vfY, qf, tabAB, tabM, wt, ISB ? 0 : (ATT_KROW(wt) - rq + 7) * 32, jlo, q, h);
        { const int wn = wt + 2 < nw ? wt + 2 : wt; const int tb = ATT_TB(wn); attn_load_k(kfY, Kp + (size_t)(tb >> 5) * 2048); attn_load_v(vfY, Vp + (size_t)(tb >> 5) * 2048); }
        attn_win_tile<ISB, 1>(O, l, kfX, vfX, qf, tabAB, tabM, wt + 1, ISB ? 0 : (ATT_KROW(wt + 1) - rq + 7) * 32, jlo, q, h);
    }
#undef ATT_KROW
#undef ATT_TB
    f32x4 gvv[2][4];
    { const float* gain = (ISB ? T.onb : T.ona) + w * 64 + 4 * h;
#pragma unroll
      for (int db = 0; db < 2; ++db)
#pragma unroll
          for (int g = 0; g < 4; ++g) gvv[db][g] = *(const f32x4*)(gain + 32 * db + 8 * g); }
    float inv[2];
    LAS float* amx = ssx + 16896;
#pragma unroll
    for (int qb = 0; qb < 2; ++qb) { float lt = l[qb] + __shfl_xor(l[qb], 32); if (ISB) lt += sinkexp; inv[qb] = __builtin_amdgcn_rcpf(lt);
        float ss = 0.f, am = 0.f;
#pragma unroll
        for (int db = 0; db < 2; ++db)
#pragma unroll
            for (int rg = 0; rg < 16; ++rg) { const float o = O[qb][db][rg] * inv[qb]; ss += o * o; const float og = o * gvv[db][rg >> 2][rg & 3]; O[qb][db][rg] = og; am = fmaxf(am, fabsf(og)); }
        ss += __shfl_xor(ss, 32); am = fmaxf(am, __shfl_xor(am, 32));
        if (h == 0) { ssx[(32 * qb + q) * 8 + w] = ss; amx[(32 * qb + q) * 8 + w] = am; } }
    LDS_WAIT(); __syncthreads();
    unsigned char* Mp = T.MIX + ((size_t)((ISB ? 4 : 0) + (w >> 1)) * MTOK + (t0 + q)) * 128 + (w & 1) * 64 + 8 * h;
#pragma unroll
    for (int qb = 0; qb < 2; ++qb) {
        const f32x4 s0 = *(const LAS f32x4*)(ssx + (32 * qb + q) * 8), s1 = *(const LAS f32x4*)(ssx + (32 * qb + q) * 8 + 4);
        const f32x4 a0 = *(const LAS f32x4*)(amx + (32 * qb + q) * 8), a1 = *(const LAS f32x4*)(amx + (32 * qb + q) * 8 + 4);
        const float tot = ((s0[0] + s0[1]) + (s0[2] + s0[3])) + ((s1[0] + s1[1]) + (s1[2] + s1[3]));
        const float amax = fmaxf(fmaxf(fmaxf(a0[0], a0[1]), fmaxf(a0[2], a0[3])), fmaxf(fmaxf(a1[0], a1[1]), fmaxf(a1[2], a1[3])));
        const float rn = __builtin_amdgcn_rsqf(tot * (1.0f / 512.0f) + EPS);
        const float qs = amax > 0.f ? 127.0f / amax : 0.f;
        if (w == 0 && h == 0) (ISB ? T.SMB : T.SMA)[t0 + 32 * qb + q] = amax > 0.f ? amax * rn * (1.0f / 127.0f) : 1.0f;
#pragma unroll
        for (int db = 0; db < 2; ++db)
#pragma unroll
            for (int gp = 0; gp < 2; ++gp) {
                const unsigned a = q8x4(O[qb][db][8 * gp + 0], O[qb][db][8 * gp + 1], O[qb][db][8 * gp + 2], O[qb][db][8 * gp + 3], qs), b = q8x4(O[qb][db][8 * gp + 4], O[qb][db][8 * gp + 5], O[qb][db][8 * gp + 6], O[qb][db][8 * gp + 7], qs);
                const u32x2 r = __builtin_amdgcn_permlane32_swap(a, b, false, false);
                *(u32x2*)(Mp + (size_t)(32 * qb) * 128 + 32 * db + 16 * gp) = r; }
    }
    LDS_WAIT(); __syncthreads();
}
__device__ __forceinline__ f32x16 attn_qk_r(const bf16x8 (&kf)[4], const bf16x8 (&qf)[4], f32x16 S) {
#pragma unroll
    for (int s = 0; s < 4; ++s) S = __builtin_amdgcn_mfma_f32_32x32x16_bf16(kf[s], qf[s], S, 0, 0, 0);
    return S;
}
template <int I> struct AWin { static constexpr int W0 = I == 0 ? 0 : (I == 1 ? 8 : (I == 2 ? 24 : 32)); };
__device__ __forceinline__ void attn_a_load_k(bf16x8 (&kf)[4], const bf16* kp) {
#pragma unroll
    for (int s = 0; s < 4; ++s) kf[s] = *(const bf16x8*)(kp + 512 * s);
}
template <int I>
__device__ __forceinline__ void attn_a_load_v(bf16x8 (&vf)[2][2], const bf16* vp) {
    constexpr int W0 = AWin<I>::W0;
#pragma unroll
    for (int db = 0; db < 2; ++db)
#pragma unroll
        for (int s = 0; s < 2; ++s) {
            constexpr int dummy = 0; (void)dummy;
            const int c0 = W0 + 16 * s, c1 = W0 + 16 * s + 8;
            const s16x4 lo = *(const s16x4*)(vp + (c0 >> 5) * 2048 + (2 * db + ((c0 & 31) >> 4)) * 512 + (((c0 & 31) >> 3) & 1) * 4);
            const s16x4 hi = *(const s16x4*)(vp + (c1 >> 5) * 2048 + (2 * db + ((c1 & 31) >> 4)) * 512 + (((c1 & 31) >> 3) & 1) * 4);
            vf[db][s] = (bf16x8){lo[0], lo[1], lo[2], lo[3], hi[0], hi[1], hi[2], hi[3]}; }
}
__device__ __forceinline__ void attn_a_step(f32x16 (&O)[2], float& l, const bf16x8 (&kf)[4], const bf16x8 (&vf)[2][2], const bf16x8 (&qf)[4], const f32x16& C, const f32x16& Bv) {
    const f32x16 S = attn_qk_r(kf, qf, C);
    float ls0 = 0.f, ls1 = 0.f;
#pragma unroll
    for (int s2 = 0; s2 < 2; ++s2) {
        float p[8];
#pragma unroll
        for (int j = 0; j < 8; ++j) p[j] = __builtin_amdgcn_exp2f(S[8 * s2 + j] + Bv[8 * s2 + j]);
        ls0 += (p[0] + p[1]) + (p[2] + p[3]); ls1 += (p[4] + p[5]) + (p[6] + p[7]);
        attn_pv_half(O, p, vf, s2);
    }
    l += ls0 + ls1;
    __builtin_amdgcn_sched_barrier(0);
}
template <int I>
__device__ __forceinline__ void attn_a_block(Frame& F, const AttnPtrs& T, int t0, int sb, int r0, int rows, const LAS float* tabA4, const LAS float* tabM4, LAS float* ssx) {
    constexpr int W0 = AWin<I>::W0; constexpr int NT = MPAD / 32;
    const int lane = fresh_lane(), w = F.wave, n = lane & 31, h = lane >> 5;
    const int qrow = r0 + (n >> 4), qcol = 16 * I + (n & 15), tq = 64 * (n >> 4) + qcol;
    int rsq = qrow - 4; rsq = rsq < 0 ? 0 : (rsq > rows - 8 ? rows - 8 : rsq);
    int rs0 = r0 - 4; rs0 = rs0 < 0 ? 0 : (rs0 > rows - 8 ? rows - 8 : rs0);
    int rs1 = r0 - 3; rs1 = rs1 < 0 ? 0 : (rs1 > rows - 8 ? rows - 8 : rs1);
    const int nk = rs1 + 8 - rs0;
    int cs = qcol - 8; cs = cs < 0 ? 0 : (cs > 48 ? 48 : cs);
    const int imv = 63 + W0 + 4 * h - cs;
    const int ibb = 63 + W0 + 4 * h - qcol - 32 * qrow + 32 * 7;
    const int colk = W0 + n;
    const bf16* Kp = T.KA + (size_t)w * NT * 2048 + (size_t)(colk >> 5) * 2048 + (32 * h + (colk & 31)) * 8;
    const bf16* Vp = T.VAT + (size_t)w * NT * 2048 + (32 * h + n) * 8;
    const bf16* Qp = T.QA + ((size_t)w * NT + ((t0 + tq) >> 5)) * 2048 + (32 * h + ((t0 + tq) & 31)) * 8;
    bf16x8 kfX[4], kfY[4], vfX[2][2], vfY[2][2], qf[4];
    attn_load_k(kfX, T.KA + (size_t)w * NT * 2048 + (size_t)(MTOK >> 5) * 2048 + lane * 8); attn_load_v(vfX, T.VAT + (size_t)w * NT * 2048 + (size_t)(MTOK >> 5) * 2048 + lane * 8);
    { const size_t to = (size_t)((sb + 64 * rs0) >> 5) * 2048; attn_a_load_k(kfY, Kp + to); attn_a_load_v<I>(vfY, Vp + to); }
#pragma unroll
    for (int s = 0; s < 4; ++s) qf[s] = __builtin_nontemporal_load((const bf16x8*)(Qp + 512 * s));
    f32x16 O[2]; O[0] = (f32x16){}; O[1] = (f32x16){}; float l = 0.f;
    f32x16 Cc = attn_tab16(tabM4, TM_CS, ((unsigned)(rs0 - rsq) < 8u) ? imv : 96), Bc = attn_tab16(tabA4, TA_CS, ibb + 32 * rs0);
    { const f32x16 S = attn_qk_r(kfX, qf, (f32x16){}); float p[8], ls = 0.f;
#pragma unroll
      for (int r = 0; r < 8; ++r) { p[r] = __builtin_amdgcn_exp2f(S[r]); ls += p[r]; }
      l += ls; attn_pv_half(O, p, vfX, 0);
      __builtin_amdgcn_sched_barrier(0); }
#pragma unroll 1
    for (int k = 0; k + 1 < nk; k += 2) {
        { const int kr = rs0 + k + 1; const size_t to = (size_t)((sb + 64 * kr) >> 5) * 2048; attn_a_load_k(kfX, Kp + to); attn_a_load_v<I>(vfX, Vp + to); }
        const f32x16 Cn = attn_tab16(tabM4, TM_CS, ((unsigned)(rs0 + k + 1 - rsq) < 8u) ? imv : 96), Bn = attn_tab16(tabA4, TA_CS, ibb + 32 * (rs0 + k + 1));
        attn_a_step(O, l, kfY, vfY, qf, Cc, Bc);
        { const int kn = k + 2 < nk ? k + 2 : nk - 1; const int kr = rs0 + kn; const size_t to = (size_t)((sb + 64 * kr) >> 5) * 2048; attn_a_load_k(kfY, Kp + to); attn_a_load_v<I>(vfY, Vp + to);
          Cc = attn_tab16(tabM4, TM_CS, ((unsigned)(kr - rsq) < 8u) ? imv : 96); Bc = attn_tab16(tabA4, TA_CS, ibb + 32 * kr); }
        attn_a_step(O, l, kfX, vfX, qf, Cn, Bn);
    }
    if (nk & 1) attn_a_step(O, l, kfY, vfY, qf, Cc, Bc);
    f32x4 gvv[2][4];
    { const float* gain = T.ona + w * 64 + 4 * h;
#pragma unroll
      for (int db = 0; db < 2; ++db)
#pragma unroll
          for (int g = 0; g < 4; ++g) gvv[db][g] = *(const f32x4*)(gain + 32 * db + 8 * g); }
    { const float lt = l + __shfl_xor(l, 32); const float inv = __builtin_amdgcn_rcpf(lt);
      float ss = 0.f, am = 0.f;
#pragma unroll
      for (int db = 0; db < 2; ++db)
#pragma unroll
          for (int rg = 0; rg < 16; ++rg) { const float o = O[db][rg] * inv; ss += o * o; const float og = o * gvv[db][rg >> 2][rg & 3]; O[db][rg] = og; am = fmaxf(am, fabsf(og)); }
      ss += __shfl_xor(ss, 32); am = fmaxf(am, __shfl_xor(am, 32));
      if (h == 0) { ssx[n * 8 + w] = ss; (ssx + 16896)[n * 8 + w] = am; } }
    LDS_WAIT(); __syncthreads();
    { unsigned char* Mp = T.MIX + ((size_t)(w >> 1) * MTOK + (t0 + tq)) * 128 + (w & 1) * 64 + 8 * h;
      const LAS float* amx = ssx + 16896;
      const f32x4 s0 = *(const LAS f32x4*)(ssx + n * 8), s1 = *(const LAS f32x4*)(ssx + n * 8 + 4);
      const f32x4 a0 = *(const LAS f32x4*)(amx + n * 8), a1 = *(const LAS f32x4*)(amx + n * 8 + 4);
      const float tot = ((s0[0] + s0[1]) + (s0[2] + s0[3])) + ((s1[0] + s1[1]) + (s1[2] + s1[3]));
      const float amax = fmaxf(fmaxf(fmaxf(a0[0], a0[1]), fmaxf(a0[2], a0[3])), fmaxf(fmaxf(a1[0], a1[1]), fmaxf(a1[2], a1[3])));
      const float rn = __builtin_amdgcn_rsqf(tot * (1.0f / 512.0f) + EPS);
      const float qs = amax > 0.f ? 127.0f / amax : 0.f;
      if (w == 0 && h == 0) T.SMA[t0 + tq] = amax > 0.f ? amax * rn * (1.0f / 127.0f) : 1.0f;
#pragma unroll
      for (int db = 0; db < 2; ++db)
#pragma unroll
          for (int gp = 0; gp < 2; ++gp) {
              const unsigned a = q8x4(O[db][8 * gp + 0], O[db][8 * gp + 1], O[db][8 * gp + 2], O[db][8 * gp + 3], qs), b = q8x4(O[db][8 * gp + 4], O[db][8 * gp + 5], O[db][8 * gp + 6], O[db][8 * gp + 7], qs);
              const u32x2 r = __builtin_amdgcn_permlane32_swap(a, b, false, false);
              *(u32x2*)(Mp + 32 * db + 16 * gp) = r; } }
    LDS_WAIT(); __syncthreads();
}
__device__ __forceinline__ void attn_a_unit(Frame& F, const AttnPtrs& T, int t0, const LAS float* tabA4, const LAS float* tabM4, LAS float* ssx) {
    int sb, N; if (t0 < 16384) { sb = t0 & ~8191; N = 8192; } else { sb = 16384 + ((t0 - 16384) & ~4095); N = 4096; }
    const int r0 = (t0 - sb) >> 6, rows = N >> 6;
    attn_a_block<0>(F, T, t0, sb, r0, rows, tabA4, tabM4, ssx);
    attn_a_block<1>(F, T, t0, sb, r0, rows, tabA4, tabM4, ssx);
    attn_a_block<2>(F, T, t0, sb, r0, rows, tabA4, tabM4, ssx);
    attn_a_block<3>(F, T, t0, sb, r0, rows, tabA4, tabM4, ssx);
}
__device__ __forceinline__ void attn_phase(Frame& F, const AttnPtrs& T, const float* rpb, const float* t5, const float* sink) {
    const int lane = fresh_lane(), w = F.wave;
    LAS float* tabAB = (LAS float*)(F.lds + RING_OFF + w * 10240);
    LAS float* tabM = (LAS float*)(F.lds + RING_OFF + 81920);
    LAS float* ssx = (LAS float*)(F.lds + RING_OFF + 84480);
    LAS bf16x8* qlds = (LAS bf16x8*)(F.lds + RING_OFF + 86528 + w * 8192);
    for (int i = lane; i < 4 * TA_CS; i += 64) tabAB[i] = 0.f;
#pragma unroll
    for (int k = 0; k < 8; ++k) { int i = lane + 64 * k; i = i < 465 ? i : 464; const int dr = i / 31, dc = i - 31 * dr; const float v = rpb[w * 465 + i] * LOG2E; const int pos = 48 + 32 * dr + dc;
#pragma unroll
        for (int a = 0; a < 4; ++a) tabAB[a * TA_CS + pos - a] = v; }
    if (w == 0) for (int i = lane; i < TM_CS; i += 64) { const float v = (i >= 63 && i < 79) ? 0.f : -INFINITY;
#pragma unroll
        for (int a = 0; a < 4; ++a) if (i - a >= 0) tabM[a * TM_CS + i - a] = v; }
    const float sinkexp = __builtin_amdgcn_exp2f(sink[w] * LOG2E);
    LDS_WAIT(); __syncthreads();
#pragma unroll 1
    for (int u = F.vcu; u < 256; u += F.G) attn_a_unit(F, T, u * 128, tabAB, tabM, ssx);
#pragma unroll
    for (int k = 0; k < 6; ++k) { int i = lane + 64 * k; i = i < TB_CS ? i : TB_CS - 1; const int rel = i - 160; int n = rel < 0 ? -rel : rel; const bool ok = n <= 128; n = ok ? n : 128;
        const int lg = n < 8 ? n : (33 - __clz(n * n)); const int bk = (rel > 0 ? 16 : 0) + (lg > 15 ? 15 : lg); float v = t5[bk * 8 + w] * LOG2E; v = ok ? v : -INFINITY;
#pragma unroll
        for (int a = 0; a < 4; ++a) if (i - a >= 0) tabAB[a * TB_CS + i - a] = v; }
    LDS_WAIT(); asm volatile("" ::: "memory");
#pragma unroll 1
    for (int u = F.vcu; u < 512; u += F.G) attn_unit<true>(F, T, u * 64, tabAB, tabM, sinkexp, ssx, qlds);
}
template <bool NORM>
__device__ __forceinline__ void quant_rows(const bf16* src, signed char* dstq, float* scl, int row0, int nrows, int worker, int nworkers) {
    const int lane = threadIdx.x & 63;
    for (int m0 = worker; m0 < nrows; m0 += 4 * nworkers) {
        v4u v[4][2];
#pragma unroll
        for (int b = 0; b < 4; ++b) { int m = m0 + b * nworkers; m = m < nrows ? m : nrows - 1; const bf16* sp = src + (size_t)(row0 + m) * DM;
            v[b][0] = *(const GAS v4u*)(sp + lane * 16); v[b][1] = *(const GAS v4u*)(sp + lane * 16 + 8); }
#pragma unroll
        for (int b = 0; b < 4; ++b) { const int m = m0 + b * nworkers; if (m >= nrows) continue;
            float x[16];
#pragma unroll
            for (int k = 0; k < 2; ++k) { const v4u w = v[b][k];
                x[8 * k + 0] = __uint_as_float(w.x << 16); x[8 * k + 1] = __uint_as_float(w.x & 0xffff0000u); x[8 * k + 2] = __uint_as_float(w.y << 16); x[8 * k + 3] = __uint_as_float(w.y & 0xffff0000u);
                x[8 * k + 4] = __uint_as_float(w.z << 16); x[8 * k + 5] = __uint_as_float(w.z & 0xffff0000u); x[8 * k + 6] = __uint_as_float(w.w << 16); x[8 * k + 7] = __uint_as_float(w.w & 0xffff0000u); }
            float am = 0.f, ss = 0.f;
#pragma unroll
            for (int i = 0; i < 16; ++i) { am = fmaxf(am, fabsf(x[i])); ss += x[i] * x[i]; }
#pragma unroll
            for (int o = 1; o < 64; o <<= 1) { am = fmaxf(am, __shfl_xor(am, o)); if (NORM) ss += __shfl_xor(ss, o); }
            const float sc = am > 0.f ? am * (1.0f / 127.0f) : 1.0f, qs = am > 0.f ? 127.0f / am : 0.f;
            v4u q; q.x = q8x4(x[0], x[1], x[2], x[3], qs); q.y = q8x4(x[4], x[5], x[6], x[7], qs); q.z = q8x4(x[8], x[9], x[10], x[11], qs); q.w = q8x4(x[12], x[13], x[14], x[15], qs);
            *(GAS v4u*)(dstq + ((size_t)(lane >> 3) * MTOK + row0 + m) * 128 + (lane & 7) * 16) = q;
            if (lane == 0) scl[row0 + m] = NORM ? sc * __builtin_amdgcn_rsqf(ss * (1.0f / 1024.0f) + EPS) : sc;
        }
    }
}
#ifndef PROBE_PHASE
#define PROBE_PHASE -1
#endif
#ifndef MK_N_LAUNCHES
#define MK_N_LAUNCHES 1
#endif
constexpr int N_LAUNCHES = MK_N_LAUNCHES;
constexpr int PER_PHASE = 7;
struct Args { const float* in[19]; float* out; unsigned char* ws; int ph_lo, ph_hi, li, pad; };
__global__ void __launch_bounds__(NWAVES * 64, 2) hybrid_fwd(Args args_by_value) {
    __shared__ __attribute__((aligned(16))) unsigned char lds[LDS_BYTES];
    typedef const __attribute__((address_space(4))) Args* KArgs;
#define ENV() KArgs ap_ = (KArgs)__builtin_amdgcn_kernarg_segment_ptr(); asm volatile("" : "+s"(ap_)); \
    unsigned char* ws = ap_->ws; unsigned char* dout = (unsigned char*)ap_->out; \
    Frame F; F.lds = (LAS unsigned char*)lds; F.MISC = (volatile LAS unsigned*)(F.lds + MISC_OFF); F.wave = __builtin_amdgcn_readfirstlane((int)threadIdx.x >> 6); \
    F.G = gridDim.x; { const int bx = blockIdx.x; F.vcu = (F.G % 8 == 0) ? (bx % 8) * (F.G / 8) + bx / 8 : bx; } F.ctl = (gu32*)(ws + WS_CTL); \
    XcdBarrier bar; bar.bar = (unsigned*)(F.ctl + CW_BAR) + ap_->li * XCD_BAR_WORDS; bar.x = xb_xcc_id(); bar.st = F.MISC + 8; (void)dout; (void)bar
#define AIN(k) ((const float*)ap_->in[k])
    (void)args_by_value;
    int lo, hi;
    { ENV(); lo = ap_->ph_lo; hi = ap_->ph_hi;
      for (int u = threadIdx.x; u < (LDS_BYTES - LDSCTL_OFF) / 4; u += NWAVES * 64) ((LAS unsigned*)(F.lds + LDSCTL_OFF))[u] = 0u;
      __syncthreads();
      if (N_LAUNCHES != PER_PHASE) (void)xcd_barrier_post((unsigned*)(F.ctl + CW_BAR) + ap_->li * XCD_BAR_WORDS, F.MISC + 8); }
#define GRID_BAR() do { if (N_LAUNCHES != PER_PHASE) xcd_barrier(bar); } while (0)
#define LOCAL_BAR() do { if (N_LAUNCHES != PER_PHASE) xcd_local_barrier(bar); } while (0)
#ifndef PH_MASK
#define PH_MASK 127
#endif
#define IN(k) (((PH_MASK >> (k)) & 1) && lo <= (k) && (k) < hi)
#define BOTH(k) (IN(k) && IN((k) + 1))
#define P1_RAGGED() const int p1_units = (MPAD / 256) * (NIN / 256), p1_last = (p1_units - 1) / (int)gridDim.x, p1_busy = p1_units - p1_last * (int)gridDim.x, p1_idle = (int)gridDim.x - p1_busy; const bool defer_w = p1_idle >= 64
    if (IN(0)) { ENV(); P1_RAGGED(); p0_prologue(F, AIN(0), AIN(1), AIN(2), AIN(4), AIN(5), AIN(14), AIN(15), AIN(16), AIN(17), AIN(18),
            (bf16*)(ws + WS_WIN), (signed char*)(ws + WS_WOQ), (float*)(ws + WS_SWO), (signed char*)(ws + WS_WGQ), (float*)(ws + WS_SW), (bf16*)(ws + WS_WDN), (bf16*)(ws + WS_XN), (float*)(ws + WS_R1), defer_w); if (BOTH(0)) GRID_BAR(); }
    if (IN(1)) { ENV();
        pg8::Gemm g{(bf16*)(ws + WS_XN), (bf16*)(ws + WS_WIN), MPAD, NIN, DM}; pg8::StaticOrder S; S.init(MPAD, NIN, F.G, (int)blockIdx.x);
        pg8::EpiQKV E{ws, (PG8_LAS unsigned char*)(F.lds + RING_OFF + RING_BYTES), AIN(6), AIN(7), AIN(9), AIN(10), WS_QA, WS_KA, WS_VAT, WS_QB, WS_KB, WS_VBT, WS_R1};
        pg8::gemm_phase<pg8::EpiQKV, pg8::StaticOrder, true, true>(F.lds + RING_OFF, g, S, E);
    }
    if (IN(1)) { ENV();
        P1_RAGGED();
        if (defer_w && (int)blockIdx.x >= p1_busy) {
            p0_weight_tasks(F, AIN(14), AIN(15), AIN(16), AIN(17), (signed char*)(ws + WS_WOQ), (float*)(ws + WS_SWO), (signed char*)(ws + WS_WGQ), (float*)(ws + WS_SW), (int)blockIdx.x - p1_busy, p1_idle);
            p0_weight_items(F, AIN(4), AIN(5), AIN(18), (bf16*)(ws + WS_WIN), (bf16*)(ws + WS_WDN),
                            (LAS float*)(F.lds + RING_OFF + F.wave * 16384), P0_I_IN, P0_NITEMS, ((int)blockIdx.x - p1_busy) * NWAVES + F.wave, p1_idle * NWAVES);
        }
        if (BOTH(1)) GRID_BAR();
    }
    if (IN(2)) { ENV(); const AttnPtrs T{(bf16*)(ws + WS_QA), (bf16*)(ws + WS_KA), (bf16*)(ws + WS_VAT), (bf16*)(ws + WS_QB), (bf16*)(ws + WS_KB), (bf16*)(ws + WS_VBT), ws + WS_MIX, (float*)(ws + WS_SMA), (float*)(ws + WS_SMB), AIN(12), AIN(13)};
        attn_phase(F, T, AIN(8), AIN(3), AIN(11)); if (BOTH(2)) GRID_BAR(); }
    if (IN(3)) { ENV(); const XcdEnv xe = xcd_env(bar);
        pg8::Gemm g{(bf16*)(ws + WS_MIX), (bf16*)(ws + WS_WOQ), MTOK, DM, DM / 2}; pg8::XcdOrder S; S.init(MTOK, DM, xe.nloc, xe.rank, xe.nx, xe.xi);
        pg8::EpiOut E{(bf16*)(ws + WS_XN), (bf16*)(ws + WS_X1B), (const float*)(ws + WS_SMA), (const float*)(ws + WS_SMB), (const float*)(ws + WS_SWO)};
        pg8::gemm_phase<pg8::EpiOut, pg8::XcdOrder, true, true>(F.lds + RING_OFF, g, S, E);
        if (BOTH(3)) LOCAL_BAR();
    }
    if (IN(4)) { ENV(); const XcdEnv xe = xcd_env(bar);
        const int nM = MTOK / 256, r0 = (int)((long)xe.xi * nM / xe.nx) * 256, r1 = (int)((long)(xe.xi + 1) * nM / xe.nx) * 256;
        quant_rows<true>((const bf16*)(ws + WS_X1B), (signed char*)(ws + WS_X1Q), (float*)(ws + WS_SX), r0, r1 - r0, xe.rank * NWAVES + F.wave, xe.nloc * NWAVES);
        if (BOTH(4)) LOCAL_BAR(); }
    if (IN(5)) { ENV(); const XcdEnv xe = xcd_env(bar);
        pg8::Gemm g{(bf16*)(ws + WS_X1Q), (bf16*)(ws + WS_WGQ), MTOK, NGU, DM / 2}; pg8::XcdOrder S; S.init(MTOK, NGU, xe.nloc, xe.rank, xe.nx, xe.xi);
        pg8::EpiGU E{nullptr, (const float*)(ws + WS_SX), (const float*)(ws + WS_SW), (bf16*)(ws + WS_H)};
        pg8::gemm_phase<pg8::EpiGU, pg8::XcdOrder, true, true>(F.lds + RING_OFF, g, S, E);
        if (BOTH(5)) LOCAL_BAR();
    }
    if (IN(6)) { ENV(); const XcdEnv xe = xcd_env(bar);
        pg8::Gemm g{(bf16*)(ws + WS_H), (bf16*)(ws + WS_WDN), MTOK, DM, DFF}; pg8::XcdOrder S; S.init(MTOK, DM, xe.nloc, xe.rank, xe.nx, xe.xi);
        pg8::EpiDown E{(bf16*)(ws + WS_X1B), (float*)ap_->out};
        pg8::gemm_phase<pg8::EpiDown, pg8::XcdOrder, true, true>(F.lds + RING_OFF, g, S, E);
    }
#undef IN
#undef BOTH
}

extern "C" void kernel_launch(void* const* d_in, const int* in_sizes, int n_in, void* d_out, int out_size, void* d_ws, size_t ws_size, hipStream_t stream) {
    static int grid = 0;
    if (grid == 0) {
        if (n_in != 19 || out_size != MTOK * DM || ws_size < WS_END) { fprintf(stderr, "kernel_launch: unexpected shapes: n_in %d out %d ws %zu; nothing launched\n", n_in, out_size, ws_size); grid = -1; return; }
        int dev = 0, cus = 0;
        if (hipGetDevice(&dev) != hipSuccess || hipDeviceGetAttribute(&cus, hipDeviceAttributeMultiprocessorCount, dev) != hipSuccess) { grid = -1; return; }
        (void)hipGetLastError();
        grid = cus;
    }
    if (grid < 0) return;
    if (hipMemsetAsync((char*)d_ws + WS_CTL, 0, CTL_ZERO_BYTES, stream) != hipSuccess) { fprintf(stderr, "kernel_launch: memset failed\n"); return; }
    Args a{};
    for (int i = 0; i < 19; ++i) a.in[i] = (const float*)d_in[i];
    a.out = (float*)d_out; a.ws = (unsigned char*)d_ws;
#if PROBE_PHASE >= 0
    const int nl = 2; const int los[2] = {0, PROBE_PHASE}, his[2] = {PROBE_PHASE + 1, PER_PHASE};
#else
    const int nl = N_LAUNCHES;
#endif
    for (int li = 0; li < nl; ++li) {
#if PROBE_PHASE >= 0
        a.ph_lo = los[li]; a.ph_hi = his[li]; a.li = li;
#else
        a.ph_lo = (N_LAUNCHES == PER_PHASE) ? li : 0; a.ph_hi = (N_LAUNCHES == PER_PHASE) ? li + 1 : PER_PHASE; a.li = 0;
#endif
        hipLaunchKernelGGL(hybrid_fwd, dim3(grid), dim3(NWAVES * 64), 0, stream, a);
        const hipError_t le = hipPeekAtLastError();
        if (le != hipSuccess) { fprintf(stderr, "kernel_launch: launch %d failed: %s\n", li, hipGetErrorName(le)); break; }
    }
}
```

```cpp
#include <hip/hip_runtime.h>
#include <cstdio>
#include <cstdint>
namespace pg8 {
#define PG8_LAS __attribute__((address_space(3)))
typedef unsigned short bf16_t;
typedef short bf16x8 __attribute__((ext_vector_type(8)));
typedef float f32x4 __attribute__((ext_vector_type(4)));
typedef unsigned u32x4 __attribute__((ext_vector_type(4)));
typedef int i32x4 __attribute__((ext_vector_type(4)));
constexpr int BM = 256, BK = 64, HALF = 128, HTB = HALF * BK * 2  , STAGE_BYTES = 8 * HTB, NXCD = 8, WGM = 8;

__host__ __device__ __forceinline__ int lds_byte(int r, int c) { const int st = (r >> 4) * 2 + (c >> 5), rr = r & 15, cc = c & 31, ob = rr * 64 + cc * 2; return st * 1024 + (ob ^ (((ob >> 9) & 1) << 5)); }
__host__ __device__ __forceinline__ void stage_rc(int b, int& R, int& C) { const int st = b / 1024, sb = b % 1024, swz = sb ^ (((sb >> 9) & 1) << 5); R = (st >> 1) * 16 + swz / 64; C = (st & 1) * 32 + (swz % 64) / 2; }
__host__ __device__ __forceinline__ int perm32(int rho) { const int n = rho >> 4, i = rho & 15; return 8 * (i >> 2) + 4 * n + (i & 3); }

struct Unit { int pm, pn; };
struct Gemm { const bf16_t* A; const bf16_t* Bt; int M, N, K; };

struct StaticOrder {
    int nM, nN, nwg, G, c;
    __host__ __device__ void init(int M, int N, int G_, int c_) { nM = M / BM; nN = N / BM; nwg = nM * nN; G = G_; c = c_; }
    __host__ __device__ bool next(int i, Unit& u) const {
        const long L = (long)i * G + c; if (L >= nwg) return false;
        int wgid = (int)L; { const int q = nwg / NXCD, r = nwg % NXCD, xcd = wgid % NXCD, off = wgid / NXCD; wgid = (xcd < r ? xcd * (q + 1) : r * (q + 1) + (xcd - r) * q) + off; }
        const int nig = WGM * nN, gid = wgid / nig, fm = gid * WGM, gsz = (nM - fm) < WGM ? (nM - fm) : WGM;
        u.pm = fm + ((wgid % nig) % gsz); u.pn = (wgid % nig) / gsz; return true;
    }
    __device__ __forceinline__ void a_ready(const Unit&) const {}
    __device__ __forceinline__ void done(const Unit&) const {}
};

struct XcdOrder {
    int nN, p0, cnt, nloc, rank;
    __host__ __device__ void init(int M, int N, int nloc_, int rank_, int nx, int xi) { const int nM = M / BM; nN = N / BM; p0 = (int)((long)xi * nM / nx); const int p1 = (int)((long)(xi + 1) * nM / nx); cnt = (p1 - p0) * nN; nloc = nloc_; rank = rank_; }
    __host__ __device__ bool next(int i, Unit& u) const {
        const long L = (long)i * nloc + rank; if (L >= cnt) return false;
        const int w = (int)L, np = cnt / nN, nig = WGM * nN, gid = w / nig, fm = gid * WGM, gsz = (np - fm) < WGM ? (np - fm) : WGM;
        u.pm = p0 + fm + ((w % nig) % gsz); u.pn = (w % nig) / gsz; return true;
    }
    __device__ __forceinline__ void a_ready(const Unit&) const {}
    __device__ __forceinline__ void done(const Unit&) const {}
};
struct RevOrder {
    StaticOrder s;
    __host__ __device__ void init(int M, int N, int G_, int c_) { s.init(M, N, G_, c_); }
    __host__ __device__ bool next(int i, Unit& u) const { const bool r = s.next(i, u); u.pm = s.nM - 1 - u.pm; return r; }
    __device__ __forceinline__ void a_ready(const Unit&) const {}
    __device__ __forceinline__ void done(const Unit&) const {}
};

typedef float f32x2_t __attribute__((ext_vector_type(2))); typedef __bf16 bf16x2_t __attribute__((ext_vector_type(2)));
__device__ __forceinline__ unsigned cvt_pk_bf16(float lo, float hi) { f32x2_t v = {lo, hi}; bf16x2_t b = __builtin_convertvector(v, bf16x2_t); return __builtin_bit_cast(unsigned, b); }
constexpr int MP_ROWS = 33024, MP_TOK = 32768;
constexpr float RMS_EPS = 1e-6f;
constexpr float QSCALE = 0.125f * 1.4426950408889634f;

struct EpiQKV {
    typedef f32x4 acc_t;
    static constexpr bool PERM = true, AFTER_DRAIN = false, MIDK = false, TILED = false;
    unsigned char* ws; PG8_LAS unsigned char* vtl; const float *qna, *kna, *qnb, *knb;
    size_t oQA, oKA, oVAt, oQB, oKB, oVBt, oR1;
    __device__ __forceinline__ void operator()(const f32x4 (&acc)[2][2][4][2], const Unit& u, int wr, int wc, int fr, int fq) const {
        constexpr int NT = MP_ROWS / 32;
        const int pn = u.pn, row0 = u.pm * BM + wr * 64 + fr, sec = pn >> 1;
        bf16_t* dst; int head = 4 * (pn & 1) + wc; const float* gain = nullptr; float sc = 1.f; bool isV = false;
        const float* R1 = (const float*)(ws + oR1);
        if (sec == 0) { dst = (bf16_t*)(ws + oQA); gain = qna; sc = QSCALE; }
        else if (sec == 1) { dst = (bf16_t*)(ws + oKA); gain = kna; }
        else if (sec == 2) { dst = (bf16_t*)(ws + oVAt); isV = true; }
        else if (sec == 3) { dst = (bf16_t*)(ws + oQB); gain = qnb; sc = QSCALE; }
        else { if (wc < 2) { dst = (bf16_t*)(ws + oKB); head = wc; gain = knb; } else { dst = (bf16_t*)(ws + oVBt); head = wc - 2; isV = true; } }
        bf16_t* hbase = dst + (size_t)head * NT * 2048;
#define EPI_R1V() float r1v[2][4]; _Pragma("unroll") for (int ai = 0; ai < 2; ++ai) _Pragma("unroll") for (int m = 0; m < 4; ++m) r1v[ai][m] = R1[row0 + ai * HALF + m * 16]
        if (!isV) {
            EPI_R1V();
            f32x4 gv[2][2];
#pragma unroll
            for (int bj = 0; bj < 2; ++bj)
#pragma unroll
                for (int n = 0; n < 2; ++n) gv[bj][n] = *(const f32x4*)(gain + 32 * bj + 8 * fq + 4 * n) * sc;
#pragma unroll
            for (int ai = 0; ai < 2; ++ai)
#pragma unroll
                for (int m = 0; m < 4; ++m) {
                    float ss = 0.f;
#pragma unroll
                    for (int bj = 0; bj < 2; ++bj)
#pragma unroll
                        for (int n = 0; n < 2; ++n) { const f32x4 x = acc[ai][bj][m][n]; ss += (x[0] * x[0] + x[1] * x[1]) + (x[2] * x[2] + x[3] * x[3]); }
                    ss += __shfl_xor(ss, 16); ss += __shfl_xor(ss, 32);
                    const int row = row0 + ai * HALF + m * 16;
                    const float r1 = r1v[ai][m];
                    const float r = r1 * __builtin_amdgcn_rsqf(ss * (r1 * r1) * (1.0f / 64.0f) + RMS_EPS);
                    bf16_t* rowp = hbase + (size_t)(row >> 5) * 2048 + (fq >> 1) * 512 + ((fq & 1) * 32 + (row & 31)) * 8;
#pragma unroll
                    for (int bj = 0; bj < 2; ++bj) { const f32x4 v0 = acc[ai][bj][m][0] * r * gv[bj][0], v1 = acc[ai][bj][m][1] * r * gv[bj][1];
                        u32x4 w; w.x = cvt_pk_bf16(v0[0], v0[1]); w.y = cvt_pk_bf16(v0[2], v0[3]); w.z = cvt_pk_bf16(v1[0], v1[1]); w.w = cvt_pk_bf16(v1[2], v1[3]);
                        *(u32x4*)(rowp + bj * 1024) = w; }
                }
        } else {
            EPI_R1V();
            PG8_LAS unsigned short* vt = (PG8_LAS unsigned short*)(vtl + (wr * 4 + wc) * 2048);
            const int hh = (fr >> 2) & 1, jj = 4 * ((fr >> 3) & 1) + (fr & 3), wofs = (32 * hh + 8 * fq) * 8 + jj, ln = fq * 16 + fr;
#pragma unroll
            for (int ai = 0; ai < 2; ++ai)
#pragma unroll
                for (int m = 0; m < 4; ++m) { const int row = row0 + ai * HALF + m * 16; const float r1 = r1v[ai][m];
                    bf16_t* tb = hbase + (size_t)(row >> 5) * 2048 + (m & 1) * 512 + ln * 8;
#pragma unroll
                    for (int bj = 0; bj < 2; ++bj) { PG8_LAS unsigned short* buf = vt + bj * 512;
#pragma unroll
                        for (int n = 0; n < 2; ++n) { const f32x4 x = acc[ai][bj][m][n] * r1; const unsigned w0 = cvt_pk_bf16(x[0], x[1]), w1 = cvt_pk_bf16(x[2], x[3]);
                            buf[wofs + (4 * n + 0) * 8] = (unsigned short)(w0 & 0xffffu); buf[wofs + (4 * n + 1) * 8] = (unsigned short)(w0 >> 16);
                            buf[wofs + (4 * n + 2) * 8] = (unsigned short)(w1 & 0xffffu); buf[wofs + (4 * n + 3) * 8] = (unsigned short)(w1 >> 16); }
                        const u32x4 w = *(const PG8_LAS u32x4*)(buf + ln * 8);
                        *(u32x4*)(tb + bj * 1024) = w; }
                }
        }
    }
};
struct EpiOut {
    typedef i32x4 acc_t;
    static constexpr bool PERM = true, AFTER_DRAIN = false, MIDK = true, TILED = true;
    const bf16_t* XB; bf16_t* X1B; const float *SMA, *SMB, *SWO;
    __device__ __forceinline__ void pre(float (&rsc)[2][4], const Unit& u, int wr, int fr) const {
        const int row0 = u.pm * BM + wr * 64 + fr; float sa[2][4], sb[2][4];
#pragma unroll
        for (int ai = 0; ai < 2; ++ai)
#pragma unroll
            for (int m = 0; m < 4; ++m) { sa[ai][m] = SMA[row0 + ai * HALF + m * 16]; sb[ai][m] = SMB[row0 + ai * HALF + m * 16]; }
#pragma unroll
        for (int ai = 0; ai < 2; ++ai)
#pragma unroll
            for (int m = 0; m < 4; ++m) rsc[ai][m] = sa[ai][m] / sb[ai][m];
    }
    __device__ __forceinline__ void mid(i32x4 (&acc)[2][2][4][2], const float (&rsc)[2][4]) const {
#pragma unroll
        for (int ai = 0; ai < 2; ++ai)
#pragma unroll
            for (int bj = 0; bj < 2; ++bj)
#pragma unroll
                for (int m = 0; m < 4; ++m)
#pragma unroll
                    for (int n = 0; n < 2; ++n)
#pragma unroll
                        for (int i = 0; i < 4; ++i) acc[ai][bj][m][n][i] = (int)__builtin_rintf((float)acc[ai][bj][m][n][i] * rsc[ai][m]);
    }
    __device__ __forceinline__ void operator()(const i32x4 (&acc)[2][2][4][2], const Unit& u, int wr, int wc, int fr, int fq) const {
        const int row0 = u.pm * BM + wr * 64 + fr, colb = u.pn * BM + wc * 32 + 8 * fq;
        f32x4 swv[2][2];
#pragma unroll
        for (int bj = 0; bj < 2; ++bj)
#pragma unroll
            for (int n = 0; n < 2; ++n) swv[bj][n] = *(const f32x4*)(SWO + colb + bj * HALF + 4 * n);
#pragma unroll
        for (int ai = 0; ai < 2; ++ai) {
            u32x4 xb[4][2]; float sb[4];
#pragma unroll
            for (int m = 0; m < 4; ++m) { sb[m] = SMB[row0 + ai * HALF + m * 16];
#pragma unroll
                for (int bj = 0; bj < 2; ++bj) xb[m][bj] = __builtin_nontemporal_load((const u32x4*)(XB + (size_t)(row0 + ai * HALF + m * 16) * 1024 + colb + bj * HALF)); }
#pragma unroll
            for (int m = 0; m < 4; ++m) { const int row = row0 + ai * HALF + m * 16;
#pragma unroll
                for (int bj = 0; bj < 2; ++bj) { const u32x4 w = xb[m][bj];
                    f32x4 x0, x1; x0[0] = __uint_as_float(w.x << 16); x0[1] = __uint_as_float(w.x & 0xffff0000u); x0[2] = __uint_as_float(w.y << 16); x0[3] = __uint_as_float(w.y & 0xffff0000u);
                    x1[0] = __uint_as_float(w.z << 16); x1[1] = __uint_as_float(w.z & 0xffff0000u); x1[2] = __uint_as_float(w.w << 16); x1[3] = __uint_as_float(w.w & 0xffff0000u);
                    f32x4 v0, v1;
#pragma unroll
                    for (int i = 0; i < 4; ++i) { v0[i] = (float)acc[ai][bj][m][0][i] * (sb[m] * swv[bj][0][i]) + x0[i]; v1[i] = (float)acc[ai][bj][m][1][i] * (sb[m] * swv[bj][1][i]) + x1[i]; }
                    u32x4 o; o.x = cvt_pk_bf16(v0[0], v0[1]); o.y = cvt_pk_bf16(v0[2], v0[3]); o.z = cvt_pk_bf16(v1[0], v1[1]); o.w = cvt_pk_bf16(v1[2], v1[3]);
                    *(u32x4*)(X1B + (size_t)row * 1024 + colb + bj * HALF) = o; }
            }
        }
    }
};
struct EpiGU {
    typedef i32x4 acc_t;
    static constexpr bool PERM = true, AFTER_DRAIN = false, MIDK = false, TILED = true;
    const float *SS2, *SX, *SW; bf16_t* H;
    __device__ __forceinline__ void operator()(const i32x4 (&acc)[2][2][4][2], const Unit& u, int wr, int wc, int fr, int fq) const {
        const int row0 = u.pm * BM + wr * 64 + fr, colb = u.pn * HALF + wc * 32 + 8 * fq;
        float sx[2][4]; f32x4 swv[2][2];
#pragma unroll
        for (int ai = 0; ai < 2; ++ai)
#pragma unroll
            for (int m = 0; m < 4; ++m) sx[ai][m] = SX[row0 + ai * HALF + m * 16];
#pragma unroll
        for (int bj = 0; bj < 2; ++bj)
#pragma unroll
            for (int n = 0; n < 2; ++n) swv[bj][n] = *(const f32x4*)(SW + u.pn * BM + bj * HALF + wc * 32 + 8 * fq + 4 * n);
#pragma unroll
        for (int ai = 0; ai < 2; ++ai)
#pragma unroll
            for (int m = 0; m < 4; ++m) { const int row = row0 + ai * HALF + m * 16;
                const float r = sx[ai][m];
                float hv[8];
#pragma unroll
                for (int n = 0; n < 2; ++n)
#pragma unroll
                    for (int i = 0; i < 4; ++i) { const float g = (float)acc[ai][0][m][n][i] * (r * swv[0][n][i]), up = (float)acc[ai][1][m][n][i] * (r * swv[1][n][i]);
                        const float e = __builtin_amdgcn_exp2f(g * -1.4426950408889634f); hv[4 * n + i] = g * up * __builtin_amdgcn_rcpf(1.0f + e); }
                u32x4 w; w.x = cvt_pk_bf16(hv[0], hv[1]); w.y = cvt_pk_bf16(hv[2], hv[3]); w.z = cvt_pk_bf16(hv[4], hv[5]); w.w = cvt_pk_bf16(hv[6], hv[7]);
                *(u32x4*)(H + ((size_t)(colb >> 6) * MP_TOK + row) * 64 + (colb & 63)) = w;
            }
    }
};
struct EpiDown {
    typedef f32x4 acc_t;
    static constexpr bool PERM = true, AFTER_DRAIN = false, MIDK = false, TILED = true;
    const bf16_t* X1B; float* out;
    __device__ __forceinline__ void operator()(const f32x4 (&acc)[2][2][4][2], const Unit& u, int wr, int wc, int fr, int fq) const {
        const int row0 = u.pm * BM + wr * 64 + fr, colb = u.pn * BM + wc * 32 + 8 * fq;
        u32x4 xb[2][4][2];
#pragma unroll
        for (int ai = 0; ai < 2; ++ai)
#pragma unroll
            for (int m = 0; m < 4; ++m)
#pragma unroll
                for (int bj = 0; bj < 2; ++bj) xb[ai][m][bj] = __builtin_nontemporal_load((const u32x4*)(X1B + (size_t)(row0 + ai * HALF + m * 16) * 1024 + colb + bj * HALF));
#pragma unroll
        for (int ai = 0; ai < 2; ++ai)
#pragma unroll
            for (int m = 0; m < 4; ++m) { const size_t off = (size_t)(row0 + ai * HALF + m * 16) * 1024 + colb;
#pragma unroll
                for (int bj = 0; bj < 2; ++bj) { const u32x4 w = xb[ai][m][bj];
                    f32x4 x0, x1; x0[0] = __uint_as_float(w.x << 16); x0[1] = __uint_as_float(w.x & 0xffff0000u); x0[2] = __uint_as_float(w.y << 16); x0[3] = __uint_as_float(w.y & 0xffff0000u);
                    x1[0] = __uint_as_float(w.z << 16); x1[1] = __uint_as_float(w.z & 0xffff0000u); x1[2] = __uint_as_float(w.w << 16); x1[3] = __uint_as_float(w.w & 0xffff0000u);
                    *(f32x4*)(out + off + bj * HALF) = acc[ai][bj][m][0] + x0; *(f32x4*)(out + off + bj * HALF + 4) = acc[ai][bj][m][1] + x1; }
            }
    }
};

__device__ __forceinline__ f32x4 mma16(bf16x8 a, bf16x8 b, f32x4 c) { return __builtin_amdgcn_mfma_f32_16x16x32_bf16(a, b, c, 0, 0, 0); }
__device__ __forceinline__ i32x4 mma16(bf16x8 a, bf16x8 b, i32x4 c) { return __builtin_amdgcn_mfma_i32_16x16x64_i8(__builtin_bit_cast(i32x4, a), __builtin_bit_cast(i32x4, b), c, 0, 0, 0); }
template <class Epi, class Sched, bool ALIGN_EPI = false, bool SP2 = false>
__device__ __forceinline__ void gemm_phase(PG8_LAS unsigned char* lds, const Gemm g, const Sched& S, const Epi& E) {
    const int tid = threadIdx.x, wid = __builtin_amdgcn_readfirstlane(tid >> 6), lane = tid & 63, wr = wid >> 2, wc = wid & 3, fr = lane & 15, fq = lane >> 4;
    const int K = g.K, nt = K / BK;
    constexpr bool TILED = Epi::TILED;
    const int ldE = TILED ? BK : K;
    unsigned voffA[2], voffB[2];
#pragma unroll
    for (int i = 0; i < 2; ++i) { int R, C; stage_rc(tid * 16 + i * 8192, R, C); const int Rb = Epi::PERM ? ((R & ~31) + perm32(R & 31)) : R;
        voffA[i] = (unsigned)(R * ldE + C) * 2u; voffB[i] = (unsigned)(Rb * ldE + C) * 2u; }
    const size_t kstepA = TILED ? (size_t)g.M * BK * 2 : (size_t)(BK * 2);
    const size_t kstepB = TILED ? (size_t)g.N * BK * 2 : (size_t)(BK * 2);
    const size_t hstep = (size_t)HALF * ldE * 2;
    const size_t tstep = 2 * hstep;
    const unsigned ldsw = (unsigned)wid * 1024u;
    const int aoff = lds_byte(wr * 64 + fr, fq * 8), boff = lds_byte(wc * 32 + fr, fq * 8);
#define PG8_SA(b, h) (((b) * 2 + (h)) * HTB)
#define PG8_SB(b, h) ((4 + (b) * 2 + (h)) * HTB)
#define PG8_STAGE(bufoff, gbase, voff) do { _Pragma("unroll") for (int _i = 0; _i < 2; ++_i) \
        __builtin_amdgcn_global_load_lds((const unsigned*)((const char*)(gbase) + (voff)[_i]), (PG8_LAS unsigned*)(lds + (bufoff) + ldsw + _i * 8192), 16, 0, 0); } while (0)
#define PG8_LDA(dst, b, h) do { _Pragma("unroll") for (int m = 0; m < 4; ++m) _Pragma("unroll") for (int k = 0; k < 2; ++k) dst[m][k] = *(const PG8_LAS bf16x8*)(lds + PG8_SA(b, h) + aoff + m * 2048 + k * 1024); } while (0)
#define PG8_LDB(dst, b, h) do { _Pragma("unroll") for (int n = 0; n < 2; ++n) _Pragma("unroll") for (int k = 0; k < 2; ++k) dst[n][k] = *(const PG8_LAS bf16x8*)(lds + PG8_SB(b, h) + boff + n * 2048 + k * 1024); } while (0)
#define PG8_MMA(ai, bj, At, Bt) do { __builtin_amdgcn_s_setprio(1); _Pragma("unroll") for (int m = 0; m < 4; ++m) _Pragma("unroll") for (int n = 0; n < 2; ++n) _Pragma("unroll") for (int k = 0; k < 2; ++k) \
        acc[ai][bj][m][n] = mma16(Bt[n][k], At[m][k], acc[ai][bj][m][n]); __builtin_amdgcn_s_setprio(0); } while (0)
#define PG8_WAIT_V(n) asm volatile("s_waitcnt vmcnt(" #n ")" ::: "memory")
#define PG8_WAIT_L(n) asm volatile("s_waitcnt lgkmcnt(" #n ")" ::: "memory")
#define PG8_BAR __builtin_amdgcn_s_barrier()
#define PG8_SCHED __builtin_amdgcn_sched_barrier(0)
    Unit cur, nxt; int ui = 0;
    if (!S.next(0, cur)) return;
    typedef typename Epi::acc_t acc_t;
    acc_t acc[2][2][4][2];
#pragma unroll
    for (int a = 0; a < 2; ++a)
#pragma unroll
        for (int b = 0; b < 2; ++b)
#pragma unroll
            for (int m = 0; m < 4; ++m)
#pragma unroll
                for (int n = 0; n < 2; ++n) acc[a][b][m][n] = (acc_t){};
    bf16x8 At[4][2], B0[2][2], B1[2][2];
    const char* cA = (const char*)g.A + (size_t)cur.pm * tstep; const char* cB = (const char*)g.Bt + (size_t)cur.pn * tstep;
    S.a_ready(cur);
    if constexpr (SP2) {
        PG8_STAGE(PG8_SB(0, 0), cB, voffB); PG8_STAGE(PG8_SB(0, 1), cB + hstep, voffB); PG8_STAGE(PG8_SA(0, 0), cA, voffA); PG8_STAGE(PG8_SA(0, 1), cA + hstep, voffA);
        if (wr == 1) PG8_BAR;
        PG8_WAIT_V(2); PG8_BAR;
        PG8_STAGE(PG8_SB(1, 0), cB + kstepB, voffB); PG8_STAGE(PG8_SA(1, 0), cA + kstepA, voffA); PG8_STAGE(PG8_SB(1, 1), cB + hstep + kstepB, voffB);
        PG8_WAIT_V(6); PG8_BAR;
    } else {
        PG8_STAGE(PG8_SB(0, 0), cB, voffB); PG8_STAGE(PG8_SA(0, 0), cA, voffA); PG8_STAGE(PG8_SB(0, 1), cB + hstep, voffB); PG8_STAGE(PG8_SA(0, 1), cA + hstep, voffA);
        if (wr == 1) PG8_BAR;
        PG8_WAIT_V(4); PG8_BAR;
        PG8_STAGE(PG8_SB(1, 0), cB + kstepB, voffB); PG8_STAGE(PG8_SA(1, 0), cA + kstepA, voffA); PG8_STAGE(PG8_SB(1, 1), cB + hstep + kstepB, voffB);
        PG8_WAIT_V(6); PG8_BAR;
    }
    for (;;) {
        const bool has_next = S.next(ui + 1, nxt);
        float rsc[2][4];
        if constexpr (Epi::MIDK) E.pre(rsc, cur, wr, fr);
        const char* nA = has_next ? (const char*)g.A + (size_t)nxt.pm * tstep : cA; const char* nB = has_next ? (const char*)g.Bt + (size_t)nxt.pn * tstep : cB;
        for (int t = 0; t < nt; t += 2) {
            const bool last = (t == nt - 2);
            const char* a1 = cA + (size_t)(t + 1) * kstepA;
            const char* a2 = last ? nA : cA + (size_t)(t + 2) * kstepA; const char* b2 = last ? nB : cB + (size_t)(t + 2) * kstepB;
            const char* a3 = a2 + kstepA; const char* b3 = b2 + kstepB;
            if (last && has_next) S.a_ready(nxt);
            if constexpr (Epi::MIDK) { if (t == nt / 2) E.mid(acc, rsc); }
            if constexpr (SP2) {
            PG8_LDB(B0, 0, 0); PG8_LDB(B1, 0, 1); PG8_SCHED; PG8_LDA(At, 0, 0); PG8_STAGE(PG8_SA(1, 1), a1 + hstep, voffA);
            PG8_WAIT_V(8); PG8_WAIT_L(0); PG8_BAR; PG8_MMA(0, 0, At, B0); PG8_MMA(0, 1, At, B1); PG8_BAR; PG8_SCHED;
            PG8_LDA(At, 0, 1); PG8_STAGE(PG8_SB(0, 0), b2, voffB); PG8_STAGE(PG8_SB(0, 1), b2 + hstep, voffB); PG8_STAGE(PG8_SA(0, 0), a2, voffA);
            PG8_WAIT_V(8); PG8_WAIT_L(0); PG8_BAR; PG8_MMA(1, 0, At, B0); PG8_MMA(1, 1, At, B1); PG8_BAR; PG8_SCHED;
            PG8_LDB(B0, 1, 0); PG8_LDB(B1, 1, 1); PG8_SCHED; PG8_LDA(At, 1, 0); PG8_STAGE(PG8_SA(0, 1), a2 + hstep, voffA);
            PG8_WAIT_V(8); PG8_WAIT_L(0); PG8_BAR; PG8_MMA(0, 0, At, B0); PG8_MMA(0, 1, At, B1); PG8_BAR; PG8_SCHED;
            PG8_LDA(At, 1, 1); PG8_STAGE(PG8_SB(1, 0), b3, voffB); PG8_STAGE(PG8_SB(1, 1), b3 + hstep, voffB); PG8_STAGE(PG8_SA(1, 0), a3, voffA);
            PG8_WAIT_V(8); PG8_WAIT_L(0); PG8_BAR; PG8_MMA(1, 0, At, B0); PG8_MMA(1, 1, At, B1); PG8_BAR; PG8_SCHED;
            } else {
            PG8_LDB(B0, 0, 0); PG8_SCHED; PG8_LDA(At, 0, 0); PG8_STAGE(PG8_SA(1, 1), a1 + hstep, voffA);
            PG8_WAIT_L(8); PG8_BAR; PG8_WAIT_L(0); PG8_MMA(0, 0, At, B0); PG8_BAR; PG8_SCHED;
            PG8_LDB(B1, 0, 1); PG8_STAGE(PG8_SB(0, 0), b2, voffB);
            PG8_BAR; PG8_WAIT_L(0); PG8_MMA(0, 1, At, B1); PG8_BAR;
            PG8_LDA(At, 0, 1); PG8_STAGE(PG8_SA(0, 0), a2, voffA);
            PG8_BAR; PG8_WAIT_L(0); PG8_MMA(1, 0, At, B0); PG8_BAR; PG8_SCHED;
            PG8_STAGE(PG8_SB(0, 1), b2 + hstep, voffB);
            PG8_WAIT_V(6); PG8_BAR; PG8_MMA(1, 1, At, B1); PG8_BAR;
            PG8_LDB(B0, 1, 0); PG8_SCHED; PG8_LDA(At, 1, 0); PG8_STAGE(PG8_SA(0, 1), a2 + hstep, voffA);
            PG8_WAIT_L(8); PG8_BAR; PG8_WAIT_L(0); PG8_MMA(0, 0, At, B0); PG8_BAR; PG8_SCHED;
            PG8_LDB(B1, 1, 1); PG8_STAGE(PG8_SB(1, 0), b3, voffB);
            PG8_BAR; PG8_WAIT_L(0); PG8_MMA(0, 1, At, B1); PG8_BAR;
            PG8_LDA(At, 1, 1); PG8_STAGE(PG8_SA(1, 0), a3, voffA);
            PG8_BAR; PG8_WAIT_L(0); PG8_MMA(1, 0, At, B0); PG8_BAR; PG8_SCHED;
            PG8_STAGE(PG8_SB(1, 1), b3 + hstep, voffB);
            PG8_WAIT_V(6); PG8_BAR; PG8_MMA(1, 1, At, B1); PG8_BAR;
            }
        }
        if constexpr (ALIGN_EPI) { if (wr == 0) PG8_BAR; }
        if constexpr (!Epi::AFTER_DRAIN) { E(acc, cur, wr, wc, fr, fq); S.done(cur); }
        if (!has_next) break;
#pragma unroll
        for (int a = 0; a < 2; ++a)
#pragma unroll
            for (int b = 0; b < 2; ++b)
#pragma unroll
                for (int m = 0; m < 4; ++m)
#pragma unroll
                    for (int n = 0; n < 2; ++n) acc[a][b][m][n] = (acc_t){};
        cur = nxt; cA = nA; cB = nB; ++ui;
        if constexpr (ALIGN_EPI) { if (wr == 1) PG8_BAR; }
    }
    PG8_WAIT_V(0);
    if constexpr (!ALIGN_EPI) { if (wr == 0) PG8_BAR; }
    PG8_BAR;
    if constexpr (Epi::AFTER_DRAIN) { E.fused(acc, cur, wr, wc, fr, fq, lds, wid, lane); S.done(cur); }
#undef PG8_SA
#undef PG8_SB
#undef PG8_STAGE
#undef PG8_LDA
#undef PG8_LDB
#undef PG8_MMA
#undef PG8_WAIT_V
#undef PG8_WAIT_L
#undef PG8_BAR
#undef PG8_SCHED
}
}
constexpr int NWAVES = 8;
constexpr int DM = 1024, MTOK = 32768, MPAD = pg8::MP_ROWS, NIN = 2304, DFF = 2816, NGU = 2 * DFF;
constexpr float LOG2E = 1.4426950408889634f;
constexpr float EPS = 1e-6f;
constexpr size_t MiB = 1u << 20;
constexpr size_t WS_CTL = 0, CTL_ZERO_BYTES = 65536;
constexpr size_t WS_SMA = 1 * MiB, WS_SMB = WS_SMA + 131072;
constexpr size_t WS_SWO = 9 * MiB + 524288 - 4096;
constexpr size_t WS_WOQ = 404 * MiB;
constexpr size_t WS_WDN = 3 * MiB;
constexpr size_t WS_R1 = 9 * MiB;
constexpr size_t WS_SX = WS_R1 + 262144, WS_SW = WS_R1 + 524288;
constexpr size_t WS_MIX = 10 * MiB;
constexpr size_t WS_X1Q = WS_MIX;
constexpr size_t WS_QKV = 74 * MiB;
constexpr size_t SZ_Q = (size_t)MPAD * 512 * 2, SZ_KB = (size_t)MPAD * 128 * 2;
constexpr size_t WS_QA = WS_QKV, WS_KA = WS_QA + SZ_Q, WS_VAT = WS_KA + SZ_Q, WS_QB = WS_VAT + SZ_Q, WS_KB = WS_QB + SZ_Q, WS_VBT = WS_KB + SZ_KB, WS_QKV_END = WS_VBT + SZ_KB;
constexpr size_t WS_H = 74 * MiB;
constexpr size_t WS_X1B = 250 * MiB;
constexpr size_t WS_XN = 314 * MiB;
constexpr size_t WS_WGQ = 405 * MiB;
constexpr size_t WS_WGU = 385 * MiB;
constexpr size_t WS_WIN = 396 * MiB;
constexpr size_t WS_WOUT = 383 * MiB;
constexpr size_t WS_END = 411 * MiB;
static_assert(WS_SMB + 131072 <= WS_WDN && WS_WDN + (size_t)DM * DFF * 2 <= WS_R1 && WS_R1 + (size_t)MPAD * 4 <= WS_SX && WS_SX + (size_t)MTOK * 4 <= WS_SWO && WS_SWO + 4096 == WS_SW && WS_SW + (size_t)NGU * 4 <= WS_MIX
              && WS_MIX + (size_t)MTOK * DM <= WS_QKV && WS_QKV_END <= WS_X1B && WS_H + (size_t)MTOK * DFF * 2 <= WS_X1B && WS_X1B + (size_t)MTOK * DM * 2 <= WS_XN
              && WS_XN + (size_t)MPAD * DM * 2 <= WS_WOUT && WS_WOUT + (size_t)DM * DM * 2 == WS_WGU && WS_WGU + (size_t)NGU * DM * 2 <= WS_WIN && WS_WIN + (size_t)NIN * DM * 2 <= WS_WOQ && WS_WOQ + (size_t)DM * DM == WS_WGQ
              && WS_WGQ + (size_t)NGU * DM <= WS_END, "d_ws map");
constexpr int CW_TMO = 0, CW_CODE = 1, CW_BAR = 4096;
constexpr int RING_OFF = 0, RING_BYTES = 131072;
constexpr int LDSCTL_OFF = 162816, MISC_OFF = LDSCTL_OFF + 320;
constexpr int LDS_BYTES = 163840;
#define GAS __attribute__((address_space(1)))
#define LAS __attribute__((address_space(3)))
typedef unsigned short bf16;
typedef unsigned v4u __attribute__((ext_vector_type(4)));
typedef float f32x4 __attribute__((ext_vector_type(4)));
typedef short bf16x8 __attribute__((ext_vector_type(8)));
typedef GAS unsigned gu32;
typedef GAS unsigned long long gu64;
#define RLX_AGENT __ATOMIC_RELAXED, __HIP_MEMORY_SCOPE_AGENT
#define LDS_WAIT() asm volatile("s_waitcnt lgkmcnt(0)" ::: "memory")
#define VM_WAIT() asm volatile("s_waitcnt vmcnt(0)" ::: "memory")
__device__ __forceinline__ unsigned long long rt() { return __builtin_amdgcn_s_memrealtime(); }
__device__ __forceinline__ unsigned f2bf(float f) { unsigned u = __builtin_bit_cast(unsigned, f); return (u + 0x7fffu + ((u >> 16) & 1u)) >> 16; }
__device__ __forceinline__ unsigned pk2(float lo, float hi) { return f2bf(lo) | (f2bf(hi) << 16); }

#define XB_TMO      128
#define XB_XCNT(j)  (256  + 64 * (j))
#define XB_XSUB(j)  (1280 + 64 * (j))
#define XB_XGEN(j)  (2304 + 64 * (j))
#define XB_TOP      3328
#define XB_TOPGEN   3392
#define XB_LSUB(j)  (3456 + 64 * (j))
#define XCD_BAR_WORDS 4480
#define XB_SPIN_CAP (1u << 18)

__device__ __forceinline__ unsigned xb_ld(unsigned* p)              { return __hip_atomic_load(p, __ATOMIC_RELAXED, __HIP_MEMORY_SCOPE_AGENT); }
__device__ __forceinline__ unsigned xb_add(unsigned* p, unsigned v) { return __hip_atomic_fetch_add(p, v, __ATOMIC_RELAXED, __HIP_MEMORY_SCOPE_AGENT); }
__device__ __forceinline__ unsigned xb_xcc_id() { return (unsigned)__builtin_amdgcn_s_getreg((3 << 11) | 20) & 0xFu; }
#define XB_SPIN(cond, bar) do { unsigned _sp = 0; while (cond) { __builtin_amdgcn_s_sleep(1); \
    if ((++_sp & 255u) == 0u) { if (xb_ld(&(bar)[XB_TMO])) break; if (_sp > XB_SPIN_CAP) { atomicAdd(&(bar)[XB_TMO], 1u); break; } } } } while (0)

struct XcdBarrier {
    unsigned* bar; unsigned x;
    volatile LAS unsigned* st;
};

__device__ __forceinline__ XcdBarrier xcd_barrier_post(unsigned* bar, volatile LAS unsigned* st) {
    XcdBarrier b; b.bar = bar; b.x = xb_xcc_id(); b.st = st;
    if (threadIdx.x == 0) st[3] = xb_add(&bar[XB_XCNT(b.x)], 1u);
    return b;
}
__device__ __forceinline__ void xcd_barrier_complete(unsigned* bar, unsigned x, unsigned& nloc, unsigned& nx, unsigned& xi) {
    const unsigned G = gridDim.x * gridDim.y * gridDim.z;
    unsigned sum, cnt, mine, below, sp = 0u;
    for (;;) {
        sum = 0u; cnt = 0u; mine = 0u; below = 0u;
#pragma unroll
        for (unsigned j = 0; j < 16; ++j) { const unsigned c = xb_ld(&bar[XB_XCNT(j)]); sum += c; cnt += (c > 0u) ? 1u : 0u; mine = (j == x) ? c : mine; below += (j < x && c > 0u) ? 1u : 0u; }
        if (sum == G) break;
        __builtin_amdgcn_s_sleep(1);
        if ((++sp & 255u) == 0u) { if (xb_ld(&bar[XB_TMO])) break; if (sp > XB_SPIN_CAP) { atomicAdd(&bar[XB_TMO], 1u); break; } }
    }
    nloc = mine > 0u ? mine : 1u; nx = cnt > 0u ? cnt : 1u; xi = below < nx ? below : nx - 1u;
}

__device__ __forceinline__ void xcd_barrier(const XcdBarrier& b) {
    asm volatile("s_waitcnt vmcnt(0)" ::: "memory");
    __syncthreads();
    if (threadIdx.x == 0) {
        unsigned* bar = b.bar;
        __builtin_amdgcn_s_waitcnt(0);
        unsigned nloc = b.st[0], nx = b.st[1];
        if (nloc == 0u) { unsigned xi; xcd_barrier_complete(bar, b.x, nloc, nx, xi); b.st[0] = nloc; b.st[1] = nx; b.st[2] = xi; }
        const unsigned old = xb_add(&bar[XB_XSUB(b.x)], 1u);
        const unsigned gen = old / nloc;
        if (old + 1u == (gen + 1u) * nloc) {
            __builtin_amdgcn_fence(__ATOMIC_RELEASE, "agent");
            asm volatile("s_waitcnt vmcnt(0)" ::: "memory");
            const unsigned og = xb_add(&bar[XB_TOP], 1u);
            const unsigned tg = og / nx;
            if (og + 1u == (tg + 1u) * nx) xb_add(&bar[XB_TOPGEN], 1u);
            else XB_SPIN(xb_ld(&bar[XB_TOPGEN]) == tg, bar);
            asm volatile("s_waitcnt vmcnt(0)" ::: "memory");
        } else {
            XB_SPIN(xb_ld(&bar[XB_TOPGEN]) == gen, bar);
            asm volatile("s_waitcnt vmcnt(0)" ::: "memory");
        }
    }
    __syncthreads();
}

struct XcdEnv { int nloc, nx, xi, rank; };
__device__ __forceinline__ XcdEnv xcd_env(const XcdBarrier& b) {
    if (threadIdx.x == 0 && b.st[0] == 0u) { unsigned nloc, nx, xi; xcd_barrier_complete(b.bar, b.x, nloc, nx, xi); b.st[1] = nx; b.st[2] = xi; b.st[0] = nloc; }
    __syncthreads();
    XcdEnv e; e.nloc = __builtin_amdgcn_readfirstlane((int)b.st[0]); e.nx = __builtin_amdgcn_readfirstlane((int)b.st[1]); e.xi = __builtin_amdgcn_readfirstlane((int)b.st[2]); e.rank = __builtin_amdgcn_readfirstlane((int)b.st[3]);
    return e;
}
template <bool ACQ> __device__ __forceinline__ void xcd_local_barrier(const XcdBarrier& b) {
    asm volatile("s_waitcnt vmcnt(0)" ::: "memory");
    __syncthreads();
    if (ACQ && threadIdx.x == 64) { __builtin_amdgcn_fence(__ATOMIC_ACQUIRE, "agent"); asm volatile("s_waitcnt vmcnt(0)" ::: "memory"); }
    if (threadIdx.x == 0) {
        unsigned* bar = b.bar;
        __builtin_amdgcn_s_waitcnt(0);
        unsigned nloc = b.st[0];
        if (nloc == 0u) { unsigned nx, xi; xcd_barrier_complete(bar, b.x, nloc, nx, xi); b.st[1] = nx; b.st[2] = xi; b.st[0] = nloc; }
        const unsigned lg = b.st[5]; b.st[5] = lg + 1u;
        const unsigned target = (lg + 1u) * nloc;
        (void)__hip_atomic_fetch_add(&bar[XB_LSUB(b.x)], 1u, __ATOMIC_RELAXED, __HIP_MEMORY_SCOPE_AGENT);
        XB_SPIN(xb_ld(&bar[XB_LSUB(b.x)]) < target, bar);
        asm volatile("s_waitcnt vmcnt(0)" ::: "memory");
    }
    __syncthreads();
}

static_assert((CW_BAR + 2 * XCD_BAR_WORDS) * 4 <= (int)CTL_ZERO_BYTES, "barrier words inside the control region");
constexpr int CTL_READY = 16384;
constexpr unsigned RDY_T1 = 0x13572468u, RDY_T2 = 0x2468ace1u;
typedef float f32x16 __attribute__((ext_vector_type(16)));
typedef short s16x4 __attribute__((ext_vector_type(4)));
typedef unsigned u32x2 __attribute__((ext_vector_type(2)));
typedef unsigned u32x4 __attribute__((ext_vector_type(4)));
struct Frame {
    LAS unsigned char* lds;
    volatile LAS unsigned* MISC;
    gu32* ctl;
    int wave;
    int vcu, G;
};
__device__ __forceinline__ int fresh_lane() { int t = threadIdx.x; asm volatile("" : "+v"(t)); return t & 63; }
__device__ __forceinline__ float wave_sum(float v) {
#pragma unroll
    for (int o = 1; o < 64; o <<= 1) v += __shfl_xor(v, o);
    return v;
}
__device__ __forceinline__ unsigned q8x4(float a, float b, float c, float d, float qs) {
    const unsigned ua = __float_as_uint(__builtin_fmaf(a, qs, 12582912.0f)), ub = __float_as_uint(__builtin_fmaf(b, qs, 12582912.0f));
    const unsigned uc = __float_as_uint(__builtin_fmaf(c, qs, 12582912.0f)), ud = __float_as_uint(__builtin_fmaf(d, qs, 12582912.0f));
    const unsigned lo = __builtin_amdgcn_perm(ub, ua, 0x0c0c0400u), hi = __builtin_amdgcn_perm(ud, uc, 0x04000c0cu);
    return lo | hi;
}
constexpr int NBT_LD = 1028;
__device__ __forceinline__ void p0_nblock_task(const float* W, int N, int n0, const float* g, signed char* dstq, float* scl, int drow0, LAS float* T, int wave, int lane, int nrows) {
    const int kq = lane >> 3, c4 = lane & 7;
#pragma unroll
    for (int kb2 = 0; kb2 < 2; ++kb2) { const int k0 = 64 * (2 * wave + kb2);
        f32x4 v[8];
#pragma unroll
        for (int i = 0; i < 8; ++i) v[i] = __builtin_nontemporal_load((const GAS f32x4*)(W + (size_t)(k0 + 8 * i + kq) * N + n0 + 4 * c4));
        if (g) {
#pragma unroll
            for (int i = 0; i < 8; ++i) v[i] = v[i] * g[k0 + 8 * i + kq]; }
#pragma unroll
        for (int i = 0; i < 8; ++i) { LAS float* d = T + (4 * c4) * NBT_LD + k0 + 8 * i + kq; d[0] = v[i].x; d[NBT_LD] = v[i].y; d[2 * NBT_LD] = v[i].z; d[3 * NBT_LD] = v[i].w; } }
    LDS_WAIT(); __syncthreads();
#pragma unroll
    for (int c = 0; c < 4; ++c) { const int ch = 4 * wave + c; const LAS f32x4* rp = (const LAS f32x4*)(T + ch * NBT_LD + 16 * lane);
        const f32x4 a = rp[0], b = rp[1], cc = rp[2], d = rp[3];
        float am = fmaxf(fmaxf(fmaxf(fabsf(a[0]), fabsf(a[1])), fmaxf(fabsf(a[2]), fabsf(a[3]))), fmaxf(fmaxf(fabsf(b[0]), fabsf(b[1])), fmaxf(fabsf(b[2]), fabsf(b[3]))));
        am = fmaxf(am, fmaxf(fmaxf(fmaxf(fabsf(cc[0]), fabsf(cc[1])), fmaxf(fabsf(cc[2]), fabsf(cc[3]))), fmaxf(fmaxf(fabsf(d[0]), fabsf(d[1])), fmaxf(fabsf(d[2]), fabsf(d[3])))));
#pragma unroll
        for (int o = 1; o < 64; o <<= 1) am = fmaxf(am, __shfl_xor(am, o));
        const float qs = am > 0.f ? 127.0f / am : 0.f;
        v4u q; q.x = q8x4(a[0], a[1], a[2], a[3], qs); q.y = q8x4(b[0], b[1], b[2], b[3], qs); q.z = q8x4(cc[0], cc[1], cc[2], cc[3], qs); q.w = q8x4(d[0], d[1], d[2], d[3], qs);
        *(GAS v4u*)(dstq + ((size_t)(lane >> 3) * nrows + drow0 + ch) * 128 + (lane & 7) * 16) = q;
        if (lane == 0) scl[drow0 + ch] = am > 0.f ? am * (1.0f / 127.0f) : 1.0f; }
    LDS_WAIT(); __syncthreads();
}
constexpr int P0_NTASKS = DM / 32 + 2 * (DFF / 32);
__device__ __forceinline__ void p0_weight_tasks(Frame& F, const float* w_out, const float* g2, const float* w_gate, const float* w_up, signed char* WOQ, float* SWO, signed char* WGQ, float* SW, int wg, int nwg) {
    LAS float* T = (LAS float*)(F.lds + RING_OFF);
    __syncthreads();
    for (int t = wg; t < P0_NTASKS; t += nwg) {
        if (t < DM / 32) { p0_nblock_task(w_out, DM, 32 * t, nullptr, WOQ, SWO, 32 * t, T, F.wave, fresh_lane(), DM); continue; }
        const int r = t - DM / 32; const bool up = r >= DFF / 32; const int n0 = 32 * (up ? r - DFF / 32 : r);
        p0_nblock_task(up ? w_up : w_gate, DFF, n0, g2, WGQ, SW, 256 * (n0 >> 7) + (up ? 128 : 0) + (n0 & 127), T, F.wave, fresh_lane(), NGU);
    }
}
__device__ __forceinline__ void p0_transpose_item(const float* W, int K, int N, bf16* WT, int k0, int n0, int drow, const float* g, LAS float* scr, int lane, int tiled_rows = 0) {
    f32x4 v[8]; const int kq = lane >> 3, c4 = lane & 7;
#pragma unroll
    for (int i = 0; i < 8; ++i) v[i] = __builtin_nontemporal_load((const GAS f32x4*)(W + (size_t)(k0 + 8 * i + kq) * N + n0 + 4 * c4));
    if (g) {
#pragma unroll
        for (int i = 0; i < 8; ++i) v[i] = v[i] * g[k0 + 8 * i + kq]; }
#pragma unroll
    for (int i = 0; i < 8; ++i) { LAS float* d = scr + (8 * i + kq) * 33 + 4 * c4; d[0] = v[i].x; d[1] = v[i].y; d[2] = v[i].z; d[3] = v[i].w; }
    LDS_WAIT(); asm volatile("" ::: "memory");
    const int c = lane & 7;
#pragma unroll
    for (int j = 0; j < 4; ++j) { const int n = (lane >> 3) + 8 * j; const LAS float* s = scr + (8 * c) * 33 + n;
        v4u o; o.x = pk2(s[0 * 33], s[1 * 33]); o.y = pk2(s[2 * 33], s[3 * 33]); o.z = pk2(s[4 * 33], s[5 * 33]); o.w = pk2(s[6 * 33], s[7 * 33]);
        *(GAS v4u*)(WT + (tiled_rows ? ((size_t)(k0 >> 6) * tiled_rows + drow + n) * 64 + 8 * c : (size_t)(drow + n) * K + k0 + 8 * c)) = o; }
    LDS_WAIT(); asm volatile("" ::: "memory");
}
constexpr int P0_I_IN = (DM / 64) * (NIN / 32), P0_I_DN = (DFF / 64) * (DM / 32), P0_NITEMS = P0_I_IN + P0_I_DN;
__device__ __forceinline__ void p0_weight_items(Frame& F, const float* g1, const float* w_in, const float* w_down, bf16* WIN, bf16* WDN, LAS float* scr, int lo, int hi, int worker, int nworkers) {
    constexpr int I_IN = P0_I_IN;
    for (int it = lo + worker; it < hi; it += nworkers) {
        int r = it;
        if (r < I_IN) { const int nb = r % (NIN / 32), kb = r / (NIN / 32), n0 = 32 * nb, g = n0 >> 6;
            const int drow = 256 * (g >> 2) + 128 * ((n0 & 63) >> 5) + 32 * (g & 3);
            p0_transpose_item(w_in, DM, NIN, WIN, 64 * kb, n0, drow, g1, scr, fresh_lane()); continue; } r -= I_IN;
        { const int nb = r % (DM / 32), kb = r / (DM / 32); p0_transpose_item(w_down, DFF, DM, WDN, 64 * kb, 32 * nb, 32 * nb, nullptr, scr, fresh_lane(), DM); }
    }
}
__device__ __forceinline__ void p0_prologue(Frame& F, const float* xp, const float* xs, const float* meta, const float* g1, const float* w_in, const float* w_out, const float* g2, const float* w_gate, const float* w_up, const float* w_down,
        bf16* WIN, signed char* WOQ, float* SWO, signed char* WGQ, float* SW, bf16* WDN, bf16* XN, float* R1, bool defer) {
    LAS float* scr = (LAS float*)(F.lds + RING_OFF + F.wave * 16384);
    const int lane_ = fresh_lane();
    const int gw = F.vcu * NWAVES + F.wave, NGW = F.G * NWAVES;
    constexpr int I_IN = (DM / 64) * (NIN / 32);
    p0_weight_items(F, g1, w_in, w_down, WIN, WDN, scr, 0, defer ? I_IN : P0_NITEMS, gw, NGW);
    if (!defer) p0_weight_tasks(F, w_out, g2, w_gate, w_up, WOQ, SWO, WGQ, SW, F.vcu, F.G);
    for (int m0 = gw; m0 < MPAD; m0 += 4 * NGW) {
        f32x4 v[4][4];
#pragma unroll
        for (int b = 0; b < 4; ++b) { const int m = m0 + b * NGW;
            if (m < MTOK + 16) { const float* xrow = m < 16384 ? xp + (size_t)m * DM : (m < MTOK ? xs + (size_t)(m - 16384) * DM : meta + (size_t)(m - MTOK) * DM);
                const GAS f32x4* xr = (const GAS f32x4*)xrow + lane_;
#pragma unroll
                for (int j = 0; j < 4; ++j) v[b][j] = __builtin_nontemporal_load(xr + 64 * j); }
            else {
#pragma unroll
                for (int j = 0; j < 4; ++j) v[b][j] = (f32x4){0.f, 0.f, 0.f, 0.f}; } }
#pragma unroll
        for (int b = 0; b < 4; ++b) { const int m = m0 + b * NGW; if (m >= MPAD) continue;
            float sq = 0.f;
#pragma unroll
            for (int j = 0; j < 4; ++j) sq += (v[b][j].x * v[b][j].x + v[b][j].y * v[b][j].y) + (v[b][j].z * v[b][j].z + v[b][j].w * v[b][j].w);
            const float rstd = __builtin_amdgcn_rsqf(wave_sum(sq) * (1.f / DM) + EPS);
            if (lane_ == 0) R1[m] = rstd;
            GAS unsigned long long* o8 = (GAS unsigned long long*)(XN + (size_t)m * DM) + lane_;
#pragma unroll
            for (int j = 0; j < 4; ++j) { const f32x4 y = v[b][j];
                o8[64 * j] = (unsigned long long)pk2(y.x, y.y) | ((unsigned long long)pk2(y.z, y.w) << 32); } }
    }
}
__device__ __forceinline__ unsigned cvtpk(float lo, float hi) { return pg8::cvt_pk_bf16(lo, hi); }
__device__ __forceinline__ void attn_load_kv(bf16x8 (&kf)[4], bf16x8 (&vf)[2][2], const bf16* krow, const bf16* vcol) {
#pragma unroll
    for (int s = 0; s < 4; ++s) kf[s] = *(const bf16x8*)(krow + 16 * s);
#pragma unroll
    for (int db = 0; db < 2; ++db)
#pragma unroll
        for (int s = 0; s < 2; ++s) { const bf16* p = vcol + (size_t)(32 * db) * MPAD + 16 * s;
            const s16x4 lo = *(const s16x4*)p, hi = *(const s16x4*)(p + 8);
            vf[db][s] = (bf16x8){lo[0], lo[1], lo[2], lo[3], hi[0], hi[1], hi[2], hi[3]}; }
}
__device__ __forceinline__ void attn_load_k(bf16x8 (&kf)[4], const bf16* kt) {
#pragma unroll
    for (int s = 0; s < 4; ++s) kf[s] = *(const bf16x8*)(kt + 512 * s);
}
__device__ __forceinline__ void attn_load_v(bf16x8 (&vf)[2][2], const bf16* vt) {
#pragma unroll
    for (int db = 0; db < 2; ++db)
#pragma unroll
        for (int s = 0; s < 2; ++s) vf[db][s] = *(const bf16x8*)(vt + 512 * (2 * db + s));
}
__device__ __forceinline__ f32x16 attn_qk(const bf16x8 (&kf)[4], const LAS bf16x8* qf, f32x16 S = (f32x16){}) {
#pragma unroll
    for (int s = 0; s < 4; ++s) S = __builtin_amdgcn_mfma_f32_32x32x16_bf16(kf[s], qf[64 * s], S, 0, 0, 0);
    return S;
}
__device__ __forceinline__ void attn_pv_half(f32x16 (&O)[2], const float (&p)[8], const bf16x8 (&vf)[2][2], int s) {
    u32x4 pw; pw.x = cvtpk(p[0], p[1]); pw.y = cvtpk(p[2], p[3]); pw.z = cvtpk(p[4], p[5]); pw.w = cvtpk(p[6], p[7]);
    const bf16x8 pb = __builtin_bit_cast(bf16x8, pw);
#pragma unroll
    for (int db = 0; db < 2; ++db) O[db] = __builtin_amdgcn_mfma_f32_32x32x16_bf16(vf[db][s], pb, O[db], 0, 0, 0);
}
__device__ __forceinline__ f32x16 attn_tab16(const LAS float* tab4, int cstride, int I) {
    const int a = I & 3; const LAS f32x4* p = (const LAS f32x4*)(tab4 + a * cstride + (I - a));
    const f32x4 v0 = p[0], v1 = p[2], v2 = p[4], v3 = p[6];
    return (f32x16){v0[0], v0[1], v0[2], v0[3], v1[0], v1[1], v1[2], v1[3], v2[0], v2[1], v2[2], v2[3], v3[0], v3[1], v3[2], v3[3]};
}
constexpr int TA_CS = 608, TB_CS = 324, TM_CS = 132;
template <bool ISB, int CB>
__device__ __forceinline__ void attn_win_tile(f32x16 (&O)[2][2], float (&l)[2], const bf16x8 (&kf)[4], const bf16x8 (&vf)[2][2], const LAS bf16x8* qf,
                                              const LAS float* tabAB, const LAS float* tabM, int wt, int rowoff, int jlo, int q, int h) {
#pragma unroll
    for (int qb = 0; qb < 2; ++qb) {
        if (ISB) { const int j = jlo + wt; if ((qb == 0 && j == 9) || (qb == 1 && j == 0)) continue; }
        constexpr int cb = CB;
        f32x16 C, Bv = (f32x16){};
        if (!ISB) {
            const int c = 32 * qb + q; int cs = c - 8; cs = cs < 0 ? 0 : (cs > 48 ? 48 : cs);
            const int kcb = 32 * cb + 4 * h;
            C = attn_tab16(tabM, TM_CS, 63 + kcb - cs);
            Bv = attn_tab16(tabAB, TA_CS, rowoff + 63 + kcb - c);
        } else {
            C = attn_tab16(tabAB, TB_CS, 32 * (jlo + wt) - 128 - 32 * qb - q + 4 * h + 160);
        }
        const f32x16 S = attn_qk(kf, qf + 256 * qb, C);
        float ls0 = 0.f, ls1 = 0.f;
#pragma unroll
        for (int s2 = 0; s2 < 2; ++s2) {
            if (!ISB && qb != cb && s2 == cb) continue;
            float p[8];
#pragma unroll
            for (int j = 0; j < 8; ++j) { const int rg = 8 * s2 + j;
                float x = S[rg]; if (!ISB) x += Bv[rg];
                p[j] = __builtin_amdgcn_exp2f(x); }
            ls0 += (p[0] + p[1]) + (p[2] + p[3]); ls1 += (p[4] + p[5]) + (p[6] + p[7]);
            attn_pv_half(O[qb], p, vf, s2);
        }
        l[qb] += ls0 + ls1;
        __builtin_amdgcn_sched_barrier(0);
    }
}
struct AttnPtrs { const bf16 *QA, *KA, *VAT, *QB, *KB, *VBT; unsigned char* MIX; float *SMA, *SMB; const float *ona, *onb; };
template <bool ISB>
__device__ __forceinline__ void attn_unit(Frame& F, const AttnPtrs& T, int t0, const LAS float* tabAB, const LAS float* tabM, float sinkexp, LAS float* ssx, LAS bf16x8* qlds) {
    const int lane = fresh_lane(), w = F.wave, q = lane & 31, h = lane >> 5;
    int sb, N; if (t0 < 16384) { sb = t0 & ~8191; N = 8192; } else { sb = 16384 + ((t0 - 16384) & ~4095); N = 4096; }
    const int q0 = t0 - sb;
    constexpr int NT = MPAD / 32;
    const bf16* Qp = (ISB ? T.QB : T.QA) + ((size_t)w * NT + (t0 >> 5)) * 2048 + lane * 8;
    const int khead = ISB ? (w >> 2) : w;
    const bf16* Kp = (ISB ? T.KB : T.KA) + (size_t)khead * NT * 2048 + lane * 8;
    const bf16* Vp = (ISB ? T.VBT : T.VAT) + (size_t)khead * NT * 2048 + lane * 8;
    int nw, jlo = 0, tbase0, rs = 0, rq = 0;
    if (!ISB) { const int rows = N >> 6; rq = q0 >> 6; rs = rq - 4; rs = rs < 0 ? 0 : (rs > rows - 8 ? rows - 8 : rs); nw = 16; tbase0 = sb + 64 * rs; }
    else { jlo = q0 >= 128 ? 0 : (128 - q0) >> 5; int jhi = (N - q0 + 128) >> 5; jhi = jhi > 10 ? 10 : jhi; nw = jhi - jlo; tbase0 = sb + q0 - 128 + 32 * jlo; }
#define ATT_KROW(wt_) (rs + ((((wt_) >> 1) - rs) & 7))
#define ATT_TB(wt_) (ISB ? tbase0 + 32 * (wt_) : sb + 64 * ATT_KROW(wt_) + 32 * ((wt_) & 1))
    bf16x8 kfX[4], kfY[4], vfX[2][2], vfY[2][2];
    attn_load_k(kfX, Kp + (size_t)(MTOK >> 5) * 2048); attn_load_v(vfX, Vp + (size_t)(MTOK >> 5) * 2048);
    { const int tb = ATT_TB(0); attn_load_k(kfY, Kp + (size_t)(tb >> 5) * 2048); attn_load_v(vfY, Vp + (size_t)(tb >> 5) * 2048); }
    LAS bf16x8* qf = qlds + lane;
#pragma unroll
    for (int qb = 0; qb < 2; ++qb)
#pragma unroll
        for (int s = 0; s < 4; ++s) qf[256 * qb + 64 * s] = __builtin_nontemporal_load((const bf16x8*)(Qp + 2048 * qb + 512 * s));
    f32x16 O[2][2]; float l[2] = {0.f, 0.f};
#pragma unroll
    for (int qb = 0; qb < 2; ++qb)
#pragma unroll
        for (int db = 0; db < 2; ++db) O[qb][db] = (f32x16){};
#pragma unroll
    for (int qb = 0; qb < 2; ++qb) {
        const f32x16 S = attn_qk(kfX, qf + 256 * qb); float ls = 0.f;
        const int ib = 144 - q0 - 32 * qb - q + 4 * h;
        float p[8];
#pragma unroll
        for (int r = 0; r < 8; ++r) { float b = 0.f; if (ISB) { int idx = ib + (r & 3) + 8 * (r >> 2); idx = idx < 32 ? 32 : idx; b = tabAB[idx]; }
            p[r] = __builtin_amdgcn_exp2f(S[r] + b); ls += p[r]; }
        l[qb] += ls; attn_pv_half(O[qb], p, vfX, 0);
        __builtin_amdgcn_sched_barrier(0);
    }
#pragma unroll 1
    for (int wt = 0; wt < nw; wt += 2) {
        { const int tb = ATT_TB(wt + 1); attn_load_k(kfX, Kp + (size_t)(tb >> 5) * 2048); attn_load_v(vfX, Vp + (size_t)(tb >> 5) * 2048); }
        attn_win_tile<ISB, 0>(O, l, kfY, vfY, qf, tabAB, tabM, wt, ISB ? 0 : (ATT_KROW(wt) - rq + 7) * 32, jlo, q, h);
        { const int wn = wt + 2 < nw ? wt + 2 : wt; const int tb = ATT_TB(wn); attn_load_k(kfY, Kp + (size_t)(tb >> 5) * 2048); attn_load_v(vfY, Vp + (size_t)(tb >> 5) * 2048); }
        attn_win_tile<ISB, 1>(O, l, kfX, vfX, qf, tabAB, tabM, wt + 1, ISB ? 0 : (ATT_KROW(wt + 1) - rq + 7) * 32, jlo, q, h);
    }
#undef ATT_KROW
#undef ATT_TB
    f32x4 gvv[2][4];
    { const float* gain = (ISB ? T.onb : T.ona) + w * 64 + 4 * h;
#pragma unroll
      for (int db = 0; db < 2; ++db)
#pragma unroll
          for (int g = 0; g < 4; ++g) gvv[db][g] = *(const f32x4*)(gain + 32 * db + 8 * g); }
    float inv[2];
    LAS float* amx = ssx + 16896;
#pragma unroll
    for (int qb = 0; qb < 2; ++qb) { float lt = l[qb] + __shfl_xor(l[qb], 32); if (ISB) lt += sinkexp; inv[qb] = __builtin_amdgcn_rcpf(lt);
        float ss = 0.f, am = 0.f;
#pragma unroll
        for (int db = 0; db < 2; ++db)
#pragma unroll
            for (int rg = 0; rg < 16; ++rg) { const float o = O[qb][db][rg] * inv[qb]; ss += o * o; const float og = o * gvv[db][rg >> 2][rg & 3]; O[qb][db][rg] = og; am = fmaxf(am, fabsf(og)); }
        ss += __shfl_xor(ss, 32); am = fmaxf(am, __shfl_xor(am, 32));
        if (h == 0) { ssx[(32 * qb + q) * 8 + w] = ss; amx[(32 * qb + q) * 8 + w] = am; } }
    LDS_WAIT(); __syncthreads();
    unsigned char* Mp = T.MIX + ((size_t)((ISB ? 4 : 0) + (w >> 1)) * MTOK + (t0 + q)) * 128 + (w & 1) * 64 + 8 * h;
#pragma unroll
    for (int qb = 0; qb < 2; ++qb) {
        const f32x4 s0 = *(const LAS f32x4*)(ssx + (32 * qb + q) * 8), s1 = *(const LAS f32x4*)(ssx + (32 * qb + q) * 8 + 4);
        const f32x4 a0 = *(const LAS f32x4*)(amx + (32 * qb + q) * 8), a1 = *(const LAS f32x4*)(amx + (32 * qb + q) * 8 + 4);
        const float tot = ((s0[0] + s0[1]) + (s0[2] + s0[3])) + ((s1[0] + s1[1]) + (s1[2] + s1[3]));
        const float amax = fmaxf(fmaxf(fmaxf(a0[0], a0[1]), fmaxf(a0[2], a0[3])), fmaxf(fmaxf(a1[0], a1[1]), fmaxf(a1[2], a1[3])));
        const float rn = __builtin_amdgcn_rsqf(tot * (1.0f / 512.0f) + EPS);
        const float qs = amax > 0.f ? 127.0f / amax : 0.f;
        if (w == 0 && h == 0) (ISB ? T.SMB : T.SMA)[t0 + 32 * qb + q] = amax > 0.f ? amax * rn * (1.0f / 127.0f) : 1.0f;
#pragma unroll
        for (int db = 0; db < 2; ++db)
#pragma unroll
            for (int gp = 0; gp < 2; ++gp) {
                const unsigned a = q8x4(O[qb][db][8 * gp + 0], O[qb][db][8 * gp + 1], O[qb][db][8 * gp + 2], O[qb][db][8 * gp + 3], qs), b = q8x4(O[qb][db][8 * gp + 4], O[qb][db][8 * gp + 5], O[qb][db][8 * gp + 6], O[qb][db][8 * gp + 7], qs);
                const u32x2 r = __builtin_amdgcn_permlane32_swap(a, b, false, false);
                *(u32x2*)(Mp + (size_t)(32 * qb) * 128 + 32 * db + 16 * gp) = r; }
    }
    LDS_WAIT(); __syncthreads();
}
__device__ __forceinline__ f32x16 attn_qk_r(const bf16x8 (&kf)[4], const bf16x8 (&qf)[4], f32x16 S) {
#pragma unroll
    for (int s = 0; s < 4; ++s) S = __builtin_amdgcn_mfma_f32_32x32x16_bf16(kf[s], qf[s], S, 0, 0, 0);
    return S;
}
template <int I> struct AWin { static constexpr int W0 = I == 0 ? 0 : (I == 1 ? 8 : (I == 2 ? 24 : 32)); };
__device__ __forceinline__ void attn_a_load_k(bf16x8 (&kf)[4], const bf16* kp) {
#pragma unroll
    for (int s = 0; s < 4; ++s) kf[s] = *(const bf16x8*)(kp + 512 * s);
}
template <int I>
__device__ __forceinline__ void attn_a_load_v(bf16x8 (&vf)[2][2], const bf16* vp) {
    constexpr int W0 = AWin<I>::W0;
#pragma unroll
    for (int db = 0; db < 2; ++db)
#pragma unroll
        for (int s = 0; s < 2; ++s) {
            constexpr int dummy = 0; (void)dummy;
            const int c0 = W0 + 16 * s, c1 = W0 + 16 * s + 8;
            const s16x4 lo = *(const s16x4*)(vp + (c0 >> 5) * 2048 + (2 * db + ((c0 & 31) >> 4)) * 512 + (((c0 & 31) >> 3) & 1) * 4);
            const s16x4 hi = *(const s16x4*)(vp + (c1 >> 5) * 2048 + (2 * db + ((c1 & 31) >> 4)) * 512 + (((c1 & 31) >> 3) & 1) * 4);
            vf[db][s] = (bf16x8){lo[0], lo[1], lo[2], lo[3], hi[0], hi[1], hi[2], hi[3]}; }
}
__device__ __forceinline__ void attn_a_step(f32x16 (&O)[2], float& l, const bf16x8 (&kf)[4], const bf16x8 (&vf)[2][2], const bf16x8 (&qf)[4], const f32x16& C, const f32x16& Bv) {
    const f32x16 S = attn_qk_r(kf, qf, C);
    float ls0 = 0.f, ls1 = 0.f;
#pragma unroll
    for (int s2 = 0; s2 < 2; ++s2) {
        float p[8];
#pragma unroll
        for (int j = 0; j < 8; ++j) p[j] = __builtin_amdgcn_exp2f(S[8 * s2 + j] + Bv[8 * s2 + j]);
        ls0 += (p[0] + p[1]) + (p[2] + p[3]); ls1 += (p[4] + p[5]) + (p[6] + p[7]);
        attn_pv_half(O, p, vf, s2);
    }
    l += ls0 + ls1;
    __builtin_amdgcn_sched_barrier(0);
}
template <int I>
__device__ __forceinline__ void attn_a_block(Frame& F, const AttnPtrs& T, int t0, int sb, int r0, int rows, const LAS float* tabA4, const LAS float* tabM4, LAS float* ssx) {
    constexpr int W0 = AWin<I>::W0; constexpr int NT = MPAD / 32;
    const int lane = fresh_lane(), w = F.wave, n = lane & 31, h = lane >> 5;
    const int qrow = r0 + (n >> 4), qcol = 16 * I + (n & 15), tq = 64 * (n >> 4) + qcol;
    int rsq = qrow - 4; rsq = rsq < 0 ? 0 : (rsq > rows - 8 ? rows - 8 : rsq);
    int rs0 = r0 - 4; rs0 = rs0 < 0 ? 0 : (rs0 > rows - 8 ? rows - 8 : rs0);
    int rs1 = r0 - 3; rs1 = rs1 < 0 ? 0 : (rs1 > rows - 8 ? rows - 8 : rs1);
    const int nk = rs1 + 8 - rs0;
    int cs = qcol - 8; cs = cs < 0 ? 0 : (cs > 48 ? 48 : cs);
    const int imv = 63 + W0 + 4 * h - cs;
    const int ibb = 63 + W0 + 4 * h - qcol - 32 * qrow + 32 * 7;
    const int colk = W0 + n;
    const bf16* Kp = T.KA + (size_t)w * NT * 2048 + (size_t)(colk >> 5) * 2048 + (32 * h + (colk & 31)) * 8;
    const bf16* Vp = T.VAT + (size_t)w * NT * 2048 + (32 * h + n) * 8;
    const bf16* Qp = T.QA + ((size_t)w * NT + ((t0 + tq) >> 5)) * 2048 + (32 * h + ((t0 + tq) & 31)) * 8;
    bf16x8 kfX[4], kfY[4], vfX[2][2], vfY[2][2], qf[4];
    attn_load_k(kfX, T.KA + (size_t)w * NT * 2048 + (size_t)(MTOK >> 5) * 2048 + lane * 8); attn_load_v(vfX, T.VAT + (size_t)w * NT * 2048 + (size_t)(MTOK >> 5) * 2048 + lane * 8);
#define AKR(k_) ((k_) < 8 ? rs0 + (((k_) - rs0) & 7) : rs0 + 8)
    { const size_t to = (size_t)((sb + 64 * AKR(0)) >> 5) * 2048; attn_a_load_k(kfY, Kp + to); attn_a_load_v<I>(vfY, Vp + to); }
#pragma unroll
    for (int s = 0; s < 4; ++s) qf[s] = __builtin_nontemporal_load((const bf16x8*)(Qp + 512 * s));
    f32x16 O[2]; O[0] = (f32x16){}; O[1] = (f32x16){}; float l = 0.f;
    f32x16 Cc = attn_tab16(tabM4, TM_CS, ((unsigned)(AKR(0) - rsq) < 8u) ? imv : 96), Bc = attn_tab16(tabA4, TA_CS, ibb + 32 * AKR(0));
    { const f32x16 S = attn_qk_r(kfX, qf, (f32x16){}); float p[8], ls = 0.f;
#pragma unroll
      for (int r = 0; r < 8; ++r) { p[r] = __builtin_amdgcn_exp2f(S[r]); ls += p[r]; }
      l += ls; attn_pv_half(O, p, vfX, 0);
      __builtin_amdgcn_sched_barrier(0); }
#pragma unroll 1
    for (int k = 0; k + 1 < nk; k += 2) {
        { const int kr = AKR(k + 1); const size_t to = (size_t)((sb + 64 * kr) >> 5) * 2048; attn_a_load_k(kfX, Kp + to); attn_a_load_v<I>(vfX, Vp + to); }
        const f32x16 Cn = attn_tab16(tabM4, TM_CS, ((unsigned)(AKR(k + 1) - rsq) < 8u) ? imv : 96), Bn = attn_tab16(tabA4, TA_CS, ibb + 32 * AKR(k + 1));
        attn_a_step(O, l, kfY, vfY, qf, Cc, Bc);
        { const int kn = k + 2 < nk ? k + 2 : nk - 1; const int kr = AKR(kn); const size_t to = (size_t)((sb + 64 * kr) >> 5) * 2048; attn_a_load_k(kfY, Kp + to); attn_a_load_v<I>(vfY, Vp + to);
          Cc = attn_tab16(tabM4, TM_CS, ((unsigned)(kr - rsq) < 8u) ? imv : 96); Bc = attn_tab16(tabA4, TA_CS, ibb + 32 * kr); }
        attn_a_step(O, l, kfX, vfX, qf, Cn, Bn);
    }
    if (nk & 1) attn_a_step(O, l, kfY, vfY, qf, Cc, Bc);
#undef AKR
    f32x4 gvv[2][4];
    { const float* gain = T.ona + w * 64 + 4 * h;
#pragma unroll
      for (int db = 0; db < 2; ++db)
#pragma unroll
          for (int g = 0; g < 4; ++g) gvv[db][g] = *(const f32x4*)(gain + 32 * db + 8 * g); }
    { const float lt = l + __shfl_xor(l, 32); const float inv = __builtin_amdgcn_rcpf(lt);
      float ss = 0.f, am = 0.f;
#pragma unroll
      for (int db = 0; db < 2; ++db)
#pragma unroll
          for (int rg = 0; rg < 16; ++rg) { const float o = O[db][rg] * inv; ss += o * o; const float og = o * gvv[db][rg >> 2][rg & 3]; O[db][rg] = og; am = fmaxf(am, fabsf(og)); }
      ss += __shfl_xor(ss, 32); am = fmaxf(am, __shfl_xor(am, 32));
      if (h == 0) { ssx[n * 8 + w] = ss; (ssx + 16896)[n * 8 + w] = am; } }
    LDS_WAIT(); __syncthreads();
    { unsigned char* Mp = T.MIX + ((size_t)(w >> 1) * MTOK + (t0 + tq)) * 128 + (w & 1) * 64 + 8 * h;
      const LAS float* amx = ssx + 16896;
      const f32x4 s0 = *(const LAS f32x4*)(ssx + n * 8), s1 = *(const LAS f32x4*)(ssx + n * 8 + 4);
      const f32x4 a0 = *(const LAS f32x4*)(amx + n * 8), a1 = *(const LAS f32x4*)(amx + n * 8 + 4);
      const float tot = ((s0[0] + s0[1]) + (s0[2] + s0[3])) + ((s1[0] + s1[1]) + (s1[2] + s1[3]));
      const float amax = fmaxf(fmaxf(fmaxf(a0[0], a0[1]), fmaxf(a0[2], a0[3])), fmaxf(fmaxf(a1[0], a1[1]), fmaxf(a1[2], a1[3])));
      const float rn = __builtin_amdgcn_rsqf(tot * (1.0f / 512.0f) + EPS);
      const float qs = amax > 0.f ? 127.0f / amax : 0.f;
      if (w == 0 && h == 0) T.SMA[t0 + tq] = amax > 0.f ? amax * rn * (1.0f / 127.0f) : 1.0f;
#pragma unroll
      for (int db = 0; db < 2; ++db)
#pragma unroll
          for (int gp = 0; gp < 2; ++gp) {
              const unsigned a = q8x4(O[db][8 * gp + 0], O[db][8 * gp + 1], O[db][8 * gp + 2], O[db][8 * gp + 3], qs), b = q8x4(O[db][8 * gp + 4], O[db][8 * gp + 5], O[db][8 * gp + 6], O[db][8 * gp + 7], qs);
              const u32x2 r = __builtin_amdgcn_permlane32_swap(a, b, false, false);
              *(u32x2*)(Mp + 32 * db + 16 * gp) = r; } }
    LDS_WAIT(); __syncthreads();
}
__device__ __forceinline__ void attn_a_unit(Frame& F, const AttnPtrs& T, int t0, const LAS float* tabA4, const LAS float* tabM4, LAS float* ssx) {
    int sb, N; if (t0 < 16384) { sb = t0 & ~8191; N = 8192; } else { sb = 16384 + ((t0 - 16384) & ~4095); N = 4096; }
    const int r0 = (t0 - sb) >> 6, rows = N >> 6;
    attn_a_block<0>(F, T, t0, sb, r0, rows, tabA4, tabM4, ssx);
    attn_a_block<1>(F, T, t0, sb, r0, rows, tabA4, tabM4, ssx);
    attn_a_block<2>(F, T, t0, sb, r0, rows, tabA4, tabM4, ssx);
    attn_a_block<3>(F, T, t0, sb, r0, rows, tabA4, tabM4, ssx);
}
__device__ __forceinline__ void attn_phase(Frame& F, const AttnPtrs& T, const float* rpb, const float* t5, const float* sink) {
    const int lane = fresh_lane(), w = F.wave;
    LAS float* tabAB = (LAS float*)(F.lds + RING_OFF + w * 10240);
    LAS float* tabM = (LAS float*)(F.lds + RING_OFF + 81920);
    LAS float* ssx = (LAS float*)(F.lds + RING_OFF + 84480);
    LAS bf16x8* qlds = (LAS bf16x8*)(F.lds + RING_OFF + 86528 + w * 8192);
    for (int i = lane; i < 4 * TA_CS; i += 64) tabAB[i] = 0.f;
#pragma unroll
    for (int k = 0; k < 8; ++k) { int i = lane + 64 * k; i = i < 465 ? i : 464; const int dr = i / 31, dc = i - 31 * dr; const float v = rpb[w * 465 + i] * LOG2E; const int pos = 48 + 32 * dr + dc;
#pragma unroll
        for (int a = 0; a < 4; ++a) tabAB[a * TA_CS + pos - a] = v; }
    if (w == 0) for (int i = lane; i < TM_CS; i += 64) { const float v = (i >= 63 && i < 79) ? 0.f : -INFINITY;
#pragma unroll
        for (int a = 0; a < 4; ++a) if (i - a >= 0) tabM[a * TM_CS + i - a] = v; }
    const float sinkexp = __builtin_amdgcn_exp2f(sink[w] * LOG2E);
    LDS_WAIT(); __syncthreads();
#pragma unroll 1
    for (int u = F.vcu; u < 256; u += F.G) attn_a_unit(F, T, u * 128, tabAB, tabM, ssx);
#pragma unroll
    for (int k = 0; k < 6; ++k) { int i = lane + 64 * k; i = i < TB_CS ? i : TB_CS - 1; const int rel = i - 160; int n = rel < 0 ? -rel : rel; const bool ok = n <= 128; n = ok ? n : 128;
        const int lg = n < 8 ? n : (33 - __clz(n * n)); const int bk = (rel > 0 ? 16 : 0) + (lg > 15 ? 15 : lg); float v = t5[bk * 8 + w] * LOG2E; v = ok ? v : -INFINITY;
#pragma unroll
        for (int a = 0; a < 4; ++a) if (i - a >= 0) tabAB[a * TB_CS + i - a] = v; }
    LDS_WAIT(); asm volatile("" ::: "memory");
#pragma unroll 1
    for (int u = F.vcu; u < 512; u += F.G) attn_unit<true>(F, T, u * 64, tabAB, tabM, sinkexp, ssx, qlds);
}
template <bool NORM>
__device__ __forceinline__ void quant_rows(const bf16* src, signed char* dstq, float* scl, int row0, int nrows, int worker, int nworkers) {
    const int lane = threadIdx.x & 63;
    for (int m0 = worker; m0 < nrows; m0 += 4 * nworkers) {
        v4u v[4][2];
#pragma unroll
        for (int b = 0; b < 4; ++b) { int m = m0 + b * nworkers; m = m < nrows ? m : nrows - 1; const bf16* sp = src + (size_t)(row0 + m) * DM;
            v[b][0] = *(const GAS v4u*)(sp + lane * 16); v[b][1] = *(const GAS v4u*)(sp + lane * 16 + 8); }
#pragma unroll
        for (int b = 0; b < 4; ++b) { const int m = m0 + b * nworkers; if (m >= nrows) continue;
            float x[16];
#pragma unroll
            for (int k = 0; k < 2; ++k) { const v4u w = v[b][k];
                x[8 * k + 0] = __uint_as_float(w.x << 16); x[8 * k + 1] = __uint_as_float(w.x & 0xffff0000u); x[8 * k + 2] = __uint_as_float(w.y << 16); x[8 * k + 3] = __uint_as_float(w.y & 0xffff0000u);
                x[8 * k + 4] = __uint_as_float(w.z << 16); x[8 * k + 5] = __uint_as_float(w.z & 0xffff0000u); x[8 * k + 6] = __uint_as_float(w.w << 16); x[8 * k + 7] = __uint_as_float(w.w & 0xffff0000u); }
            float am = 0.f, ss = 0.f;
#pragma unroll
            for (int i = 0; i < 16; ++i) { am = fmaxf(am, fabsf(x[i])); ss += x[i] * x[i]; }
#pragma unroll
            for (int o = 1; o < 64; o <<= 1) { am = fmaxf(am, __shfl_xor(am, o)); if (NORM) ss += __shfl_xor(ss, o); }
            const float sc = am > 0.f ? am * (1.0f / 127.0f) : 1.0f, qs = am > 0.f ? 127.0f / am : 0.f;
            v4u q; q.x = q8x4(x[0], x[1], x[2], x[3], qs); q.y = q8x4(x[4], x[5], x[6], x[7], qs); q.z = q8x4(x[8], x[9], x[10], x[11], qs); q.w = q8x4(x[12], x[13], x[14], x[15], qs);
            *(GAS v4u*)(dstq + ((size_t)(lane >> 3) * MTOK + row0 + m) * 128 + (lane & 7) * 16) = q;
            if (lane == 0) scl[row0 + m] = NORM ? sc * __builtin_amdgcn_rsqf(ss * (1.0f / 1024.0f) + EPS) : sc;
        }
    }
}
#ifndef PROBE_PHASE
#define PROBE_PHASE -1
#endif
#ifndef MK_N_LAUNCHES
#define MK_N_LAUNCHES 1
#endif
constexpr int N_LAUNCHES = MK_N_LAUNCHES;
constexpr int PER_PHASE = 7;
struct Args { const float* in[19]; float* out; unsigned char* ws; int ph_lo, ph_hi, li, pad; };
__global__ void __launch_bounds__(NWAVES * 64, 2) hybrid_fwd(Args args_by_value) {
    __shared__ __attribute__((aligned(16))) unsigned char lds[LDS_BYTES];
    typedef const __attribute__((address_space(4))) Args* KArgs;
#define ENV() KArgs ap_ = (KArgs)__builtin_amdgcn_kernarg_segment_ptr(); asm volatile("" : "+s"(ap_)); \
    unsigned char* ws = ap_->ws; unsigned char* dout = (unsigned char*)ap_->out; \
    Frame F; F.lds = (LAS unsigned char*)lds; F.MISC = (volatile LAS unsigned*)(F.lds + MISC_OFF); F.wave = __builtin_amdgcn_readfirstlane((int)threadIdx.x >> 6); \
    F.G = gridDim.x; { const int bx = blockIdx.x; F.vcu = (F.G % 8 == 0) ? (bx % 8) * (F.G / 8) + bx / 8 : bx; } F.ctl = (gu32*)(ws + WS_CTL); \
    XcdBarrier bar; bar.bar = (unsigned*)(F.ctl + CW_BAR) + ap_->li * XCD_BAR_WORDS; bar.x = xb_xcc_id(); bar.st = F.MISC + 8; (void)dout; (void)bar
#define AIN(k) ((const float*)ap_->in[k])
    (void)args_by_value;
    int lo, hi;
    { ENV(); lo = ap_->ph_lo; hi = ap_->ph_hi;
      for (int u = threadIdx.x; u < (LDS_BYTES - LDSCTL_OFF) / 4; u += NWAVES * 64) ((LAS unsigned*)(F.lds + LDSCTL_OFF))[u] = 0u;
      __syncthreads();
      if (N_LAUNCHES != PER_PHASE && blockIdx.x == 0 && threadIdx.x < 64) {
          unsigned* bw = (unsigned*)(F.ctl + CW_BAR) + ap_->li * XCD_BAR_WORDS;
          for (int w = threadIdx.x; w < XCD_BAR_WORDS / 64; w += 64) (void)__hip_atomic_exchange(bw + 64 * w, 0u, __ATOMIC_RELAXED, __HIP_MEMORY_SCOPE_AGENT);
          asm volatile("s_waitcnt vmcnt(0)" ::: "memory");
          if (threadIdx.x == 0) __hip_atomic_store((unsigned*)F.ctl + CTL_READY, RDY_T1, __ATOMIC_RELAXED, __HIP_MEMORY_SCOPE_AGENT);
      } }
#define GRID_BAR() do { if (N_LAUNCHES != PER_PHASE) xcd_barrier(bar); } while (0)
#define LOCAL_BAR(ACQ) do { if (N_LAUNCHES != PER_PHASE) xcd_local_barrier<ACQ>(bar); } while (0)
#ifndef PH_MASK
#define PH_MASK 127
#endif
#define IN(k) (((PH_MASK >> (k)) & 1) && lo <= (k) && (k) < hi)
#define BOTH(k) (IN(k) && IN((k) + 1))
#define P1_RAGGED() const int p1_units = (MPAD / 256) * (NIN / 256), p1_last = (p1_units - 1) / (int)gridDim.x, p1_busy = p1_units - p1_last * (int)gridDim.x, p1_idle = (int)gridDim.x - p1_busy; const bool defer_w = p1_idle >= 64
    if (IN(0)) { ENV(); P1_RAGGED(); p0_prologue(F, AIN(0), AIN(1), AIN(2), AIN(4), AIN(5), AIN(14), AIN(15), AIN(16), AIN(17), AIN(18),
            (bf16*)(ws + WS_WIN), (signed char*)(ws + WS_WOQ), (float*)(ws + WS_SWO), (signed char*)(ws + WS_WGQ), (float*)(ws + WS_SW), (bf16*)(ws + WS_WDN), (bf16*)(ws + WS_XN), (float*)(ws + WS_R1), defer_w);
        if (BOTH(0) && N_LAUNCHES != PER_PHASE) {
            if (threadIdx.x == 0) { unsigned sp = 0; while (xb_ld((unsigned*)F.ctl + CTL_READY) != RDY_T1) { __builtin_amdgcn_s_sleep(1); if (++sp > XB_SPIN_CAP) break; } }
            (void)xcd_barrier_post((unsigned*)(F.ctl + CW_BAR) + ap_->li * XCD_BAR_WORDS, F.MISC + 8);
            GRID_BAR();
            if (blockIdx.x == 0 && threadIdx.x == 0) __hip_atomic_store((unsigned*)F.ctl + CTL_READY, RDY_T2, __ATOMIC_RELAXED, __HIP_MEMORY_SCOPE_AGENT);
        } }
    if (IN(1)) { ENV();
        pg8::Gemm g{(bf16*)(ws + WS_XN), (bf16*)(ws + WS_WIN), MPAD, NIN, DM}; pg8::StaticOrder S; S.init(MPAD, NIN, F.G, (int)blockIdx.x);
        pg8::EpiQKV E{ws, (PG8_LAS unsigned char*)(F.lds + RING_OFF + RING_BYTES), AIN(6), AIN(7), AIN(9), AIN(10), WS_QA, WS_KA, WS_VAT, WS_QB, WS_KB, WS_VBT, WS_R1};
        pg8::gemm_phase<pg8::EpiQKV, pg8::StaticOrder, true, true>(F.lds + RING_OFF, g, S, E);
    }
    if (IN(1)) { ENV();
        P1_RAGGED();
        if (defer_w && (int)blockIdx.x >= p1_busy) {
            p0_weight_tasks(F, AIN(14), AIN(15), AIN(16), AIN(17), (signed char*)(ws + WS_WOQ), (float*)(ws + WS_SWO), (signed char*)(ws + WS_WGQ), (float*)(ws + WS_SW), (int)blockIdx.x - p1_busy, p1_idle);
            p0_weight_items(F, AIN(4), AIN(5), AIN(18), (bf16*)(ws + WS_WIN), (bf16*)(ws + WS_WDN),
                            (LAS float*)(F.lds + RING_OFF + F.wave * 16384), P0_I_IN, P0_NITEMS, ((int)blockIdx.x - p1_busy) * NWAVES + F.wave, p1_idle * NWAVES);
        }
        if (BOTH(1)) GRID_BAR();
    }
    if (IN(2)) { ENV(); const AttnPtrs T{(bf16*)(ws + WS_QA), (bf16*)(ws + WS_KA), (bf16*)(ws + WS_VAT), (bf16*)(ws + WS_QB), (bf16*)(ws + WS_KB), (bf16*)(ws + WS_VBT), ws + WS_MIX, (float*)(ws + WS_SMA), (float*)(ws + WS_SMB), AIN(12), AIN(13)};
        attn_phase(F, T, AIN(8), AIN(3), AIN(11)); if (BOTH(2)) GRID_BAR(); }
    if (IN(3)) { ENV(); const XcdEnv xe = xcd_env(bar);
        pg8::Gemm g{(bf16*)(ws + WS_MIX), (bf16*)(ws + WS_WOQ), MTOK, DM, DM / 2}; pg8::XcdOrder S; S.init(MTOK, DM, xe.nloc, xe.rank, xe.nx, xe.xi);
        pg8::EpiOut E{(bf16*)(ws + WS_XN), (bf16*)(ws + WS_X1B), (const float*)(ws + WS_SMA), (const float*)(ws + WS_SMB), (const float*)(ws + WS_SWO)};
        pg8::gemm_phase<pg8::EpiOut, pg8::XcdOrder, true, true>(F.lds + RING_OFF, g, S, E);
        if (BOTH(3)) LOCAL_BAR(true);
    }
    if (IN(4)) { ENV(); const XcdEnv xe = xcd_env(bar);
        const int nM = MTOK / 256, r0 = (int)((long)xe.xi * nM / xe.nx) * 256, r1 = (int)((long)(xe.xi + 1) * nM / xe.nx) * 256;
        quant_rows<true>((const bf16*)(ws + WS_X1B), (signed char*)(ws + WS_X1Q), (float*)(ws + WS_SX), r0, r1 - r0, xe.rank * NWAVES + F.wave, xe.nloc * NWAVES);
        if (BOTH(4)) LOCAL_BAR(false); }
    if (IN(5)) { ENV(); const XcdEnv xe = xcd_env(bar);
        pg8::Gemm g{(bf16*)(ws + WS_X1Q), (bf16*)(ws + WS_WGQ), MTOK, NGU, DM / 2}; pg8::XcdOrder S; S.init(MTOK, NGU, xe.nloc, xe.rank, xe.nx, xe.xi);
        pg8::EpiGU E{nullptr, (const float*)(ws + WS_SX), (const float*)(ws + WS_SW), (bf16*)(ws + WS_H)};
        pg8::gemm_phase<pg8::EpiGU, pg8::XcdOrder, true, true>(F.lds + RING_OFF, g, S, E);
        if (BOTH(5)) LOCAL_BAR(false);
    }
    if (IN(6)) { ENV(); const XcdEnv xe = xcd_env(bar);
        pg8::Gemm g{(bf16*)(ws + WS_H), (bf16*)(ws + WS_WDN), MTOK, DM, DFF}; pg8::XcdOrder S; S.init(MTOK, DM, xe.nloc, xe.rank, xe.nx, xe.xi);
        pg8::EpiDown E{(bf16*)(ws + WS_X1B), (float*)ap_->out};
        pg8::gemm_phase<pg8::EpiDown, pg8::XcdOrder, true, true>(F.lds + RING_OFF, g, S, E);
    }
#undef IN
#undef BOTH
}

extern "C" void kernel_launch(void* const* d_in, const int* in_sizes, int n_in, void* d_out, int out_size, void* d_ws, size_t ws_size, hipStream_t stream) {
    static int grid = 0;
    if (grid == 0) {
        if (n_in != 19 || out_size != MTOK * DM || ws_size < WS_END) { fprintf(stderr, "kernel_launch: unexpected shapes: n_in %d out %d ws %zu; nothing launched\n", n_in, out_size, ws_size); grid = -1; return; }
        int dev = 0, cus = 0;
        if (hipGetDevice(&dev) != hipSuccess || hipDeviceGetAttribute(&cus, hipDeviceAttributeMultiprocessorCount, dev) != hipSuccess) { grid = -1; return; }
        (void)hipGetLastError();
        grid = cus;
    }
    if (grid < 0) return;
    Args a{};
    for (int i = 0; i < 19; ++i) a.in[i] = (const float*)d_in[i];
    a.out = (float*)d_out; a.ws = (unsigned char*)d_ws;
#if PROBE_PHASE >= 0
    const int nl = 2; const int los[2] = {0, PROBE_PHASE}, his[2] = {PROBE_PHASE + 1, PER_PHASE};
#else
    const int nl = N_LAUNCHES;
#endif
    for (int li = 0; li < nl; ++li) {
#if PROBE_PHASE >= 0
        a.ph_lo = los[li]; a.ph_hi = his[li]; a.li = li;
#else
        a.ph_lo = (N_LAUNCHES == PER_PHASE) ? li : 0; a.ph_hi = (N_LAUNCHES == PER_PHASE) ? li + 1 : PER_PHASE; a.li = 0;
#endif
        hipLaunchKernelGGL(hybrid_fwd, dim3(grid), dim3(NWAVES * 64), 0, stream, a);
        const hipError_t le = hipPeekAtLastError();
        if (le != hipSuccess) { fprintf(stderr, "kernel_launch: launch %d failed: %s\n", li, hipGetErrorName(le)); break; }
    }
}
```
